# Optimizing an MI355X kernel written in HIP

```python
import math
import jax, jax.numpy as jnp
from jax import lax
import numpy as np

D_MODEL = 2048
BATCH = 2
SEQ = 4096
DEPTH = 1

CHUNK = 64
Q_BLOCK = 128
D_DIFF = D_MODEL // 2
D_MLSTM = D_MODEL - D_DIFF
DIFF_HEAD_DIM = 64
N_DIFF_HEADS = D_DIFF // (2 * DIFF_HEAD_DIM)
DIFF_V_DIM = 2 * DIFF_HEAD_DIM
MLSTM_HEAD_DIM = 128
N_MLSTM_HEADS = D_MLSTM // MLSTM_HEAD_DIM
CONV_WIDTH = 4
N_BUCKETS = 32
MAX_DISTANCE = 128
N_GROUPS = 4
EXPERTS_PER_GROUP = 8
TOP_K_INNER = 2
D_EXPERT = D_MODEL // 4
EPS = 1e-6
PROJ_SIZES = (D_DIFF, D_DIFF, D_DIFF,
              D_MLSTM, D_MLSTM, D_MLSTM, D_MLSTM,
              N_MLSTM_HEADS, N_MLSTM_HEADS)
PROJ_DIM = sum(PROJ_SIZES)
PROJ_SPLITS = tuple(int(v) for v in np.cumsum(PROJ_SIZES)[:-1])

kernel_name = "hymba_diffattn_mlstm_hmoe"


def rmsnorm(x, g):
    xf = x.astype(jnp.float32)
    y = xf * lax.rsqrt(jnp.mean(xf * xf, axis=-1, keepdims=True) + EPS)
    return (y * g.astype(jnp.float32)).astype(x.dtype)


def head_rmsnorm(x, g):
    H, dh = x.shape[-2], x.shape[-1]
    return rmsnorm(x, g.reshape(H, dh))


def t5_bucket(rel):
    half = N_BUCKETS // 2
    max_exact = half // 2
    ret = jnp.where(rel > 0, half, 0)
    n = jnp.abs(rel)
    nf = jnp.maximum(n, 1).astype(jnp.float32)
    large = max_exact + (jnp.log(nf / max_exact) / math.log(MAX_DISTANCE / max_exact)
                         * (half - max_exact)).astype(jnp.int32)
    large = jnp.minimum(large, half - 1)
    return ret + jnp.where(n < max_exact, n, large)


def causal_conv(u, w, b):
    C = u.shape[-1]
    y = lax.conv_general_dilated(u, w[:, None, :].astype(u.dtype), window_strides=(1,),
                                 padding=((CONV_WIDTH - 1, 0),),
                                 dimension_numbers=('NWC', 'WIO', 'NWC'),
                                 feature_group_count=C)
    return y + b.astype(u.dtype)


def diff_attention(q1, q2, k1, k2, v, lam, rel_bias):
    B, H, S, dk = q1.shape
    nqb = S // Q_BLOCK
    scale = dk ** -0.5
    key_pos = jnp.arange(S, dtype=jnp.int32)

    def block(args):
        qb1, qb2, qi = args
        q_pos = qi * Q_BLOCK + jnp.arange(Q_BLOCK, dtype=jnp.int32)
        bias = rel_bias[t5_bucket(key_pos[None, :] - q_pos[:, None])]
        bias = jnp.transpose(bias, (2, 0, 1)).astype(jnp.float32)
        mask = (key_pos[None, :] // CHUNK) <= (q_pos[:, None] // CHUNK)

        def probs(qb, k):
            s = jnp.einsum('bhqd,bhkd->bhqk', qb, k).astype(jnp.float32) * scale + bias
            return jax.nn.softmax(jnp.where(mask, s, -jnp.inf), axis=-1)

        p = probs(qb1, k1) - lam * probs(qb2, k2)
        return jnp.einsum('bhqk,bhkd->bhqd', p.astype(v.dtype), v)

    def to_blocks(q):
        return jnp.transpose(q.reshape(B, H, nqb, Q_BLOCK, dk), (2, 0, 1, 3, 4))

    out = lax.map(block, (to_blocks(q1), to_blocks(q2), jnp.arange(nqb, dtype=jnp.int32)))
    return jnp.transpose(out, (1, 2, 0, 3, 4)).reshape(B, H, S, v.shape[-1])


def mlstm_chunkwise(q, k, v, i_pre, f_pre):
    B, H, S, dh = q.shape
    nc, L = S // CHUNK, CHUNK
    q = q.reshape(B, H, nc, L, dh)
    k = k.reshape(B, H, nc, L, dh)
    v = v.reshape(B, H, nc, L, dh)
    log_i = i_pre.reshape(B, H, nc, L)
    log_f = jax.nn.log_sigmoid(f_pre).reshape(B, H, nc, L)
    b = jnp.cumsum(log_f, axis=-1)
    g = b[..., -1]
    w = g[..., None] - b + log_i

    def step(carry, xs):
        C, n, m = carry
        k_c, v_c, g_c, w_c = xs
        m_new = jnp.maximum(g_c + m, jnp.max(w_c, axis=-1))
        decay = jnp.exp(g_c + m - m_new)
        wt = jnp.exp(w_c - m_new[..., None])
        C_new = decay[..., None, None] * C + jnp.einsum('bhl,bhld,bhle->bhde', wt, v_c, k_c)
        n_new = decay[..., None] * n + jnp.einsum('bhl,bhle->bhe', wt, k_c)
        return (C_new, n_new, m_new), (C, n, m)

    init = (jnp.zeros((B, H, dh, dh), jnp.float32), jnp.zeros((B, H, dh), jnp.float32),
            jnp.zeros((B, H), jnp.float32))
    xs = (jnp.moveaxis(k, 2, 0), jnp.moveaxis(v, 2, 0), jnp.moveaxis(g, 2, 0), jnp.moveaxis(w, 2, 0))
    _, (C_prev, n_prev, m_prev) = lax.scan(step, init, xs)
    C_prev = jnp.moveaxis(C_prev, 0, 2)
    n_prev = jnp.moveaxis(n_prev, 0, 2)
    m_prev = jnp.moveaxis(m_prev, 0, 2)

    causal = jnp.tril(jnp.ones((L, L), dtype=bool))
    D = jnp.where(causal, b[..., :, None] - b[..., None, :] + log_i[..., None, :], -jnp.inf)
    m_inter = b + m_prev[..., None]
    m_t = jnp.maximum(jnp.max(D, axis=-1), m_inter)
    Wts = jnp.exp(D - m_t[..., None])
    inter = jnp.exp(m_inter - m_t)
    s_qk = jnp.einsum('bhctd,bhcsd->bhcts', q, k) * Wts
    num = (jnp.einsum('bhcts,bhcsd->bhctd', s_qk, v)
           + inter[..., None] * jnp.einsum('bhcde,bhcte->bhctd', C_prev, q))
    den = jnp.sum(s_qk, axis=-1) + inter * jnp.einsum('bhce,bhcte->bhct', n_prev, q)
    h = num / jnp.maximum(jnp.abs(den), jnp.exp(-m_t))[..., None]
    return h.reshape(B, H, S, dh)


def hier_moe(x, w_group, b_group, w_router, b_router, w_gate, w_up, w_down):
    gl = (x @ w_group).astype(jnp.float32) + b_group.astype(jnp.float32)
    gp = jax.nn.softmax(gl, axis=-1)
    _, gsel = lax.top_k(gl, 1)
    gmask = jax.nn.one_hot(gsel[:, 0], N_GROUPS, dtype=jnp.float32)
    gw = jnp.sum(gp * gmask, axis=-1)
    el = (jnp.einsum('td,gde->tge', x, w_router).astype(jnp.float32)
          + b_router.astype(jnp.float32))
    el_sel = jnp.einsum('tge,tg->te', el, gmask)
    top_v, top_i = lax.top_k(el_sel, TOP_K_INNER)
    top_w = jax.nn.softmax(top_v, axis=-1)
    ew = jnp.sum(jax.nn.one_hot(top_i, EXPERTS_PER_GROUP, dtype=jnp.float32) * top_w[..., None], axis=1)
    comb = (gw[:, None, None] * gmask[:, :, None] * ew[:, None, :]).astype(x.dtype)
    out = jnp.zeros_like(x)
    for gi in range(N_GROUPS):
        hid = (jax.nn.silu(jnp.einsum('td,edf->tef', x, w_gate[gi]))
               * jnp.einsum('td,edf->tef', x, w_up[gi]) * comb[:, gi, :, None])
        out = out + jnp.einsum('tef,efd->td', hid, w_down[gi])
    return out


def setup_inputs(seed: int = 0) -> dict:
    key = jax.random.key(seed)
    ks = jax.random.split(key, 24)
    f32 = jnp.float32

    def nrm(k, shape, scale):
        return jax.random.normal(k, shape, f32) * scale

    L, D = DEPTH, D_MODEL
    G, E, F = N_GROUPS, EXPERTS_PER_GROUP, D_EXPERT
    return {
        "x": nrm(ks[0], (BATCH, SEQ, D), 1.0),
        "rel_bias": nrm(ks[1], (N_BUCKETS, N_DIFF_HEADS), 0.1),
        "ln_mix_g": 1.0 + nrm(ks[2], (L, D), 0.02),
        "w_in": nrm(ks[3], (L, D, PROJ_DIM), D ** -0.5),
        "conv_w": nrm(ks[4], (L, CONV_WIDTH, 2 * D_MLSTM), CONV_WIDTH ** -0.5),
        "conv_b": nrm(ks[5], (L, 2 * D_MLSTM), 0.02),
        "b_i": nrm(ks[6], (L, N_MLSTM_HEADS), 0.1),
        "b_f": 3.0 + nrm(ks[7], (L, N_MLSTM_HEADS), 0.1),
        "lam_q1": nrm(ks[8], (L, DIFF_HEAD_DIM), 0.1),
        "lam_k1": nrm(ks[9], (L, DIFF_HEAD_DIM), 0.1),
        "lam_q2": nrm(ks[10], (L, DIFF_HEAD_DIM), 0.1),
        "lam_k2": nrm(ks[11], (L, DIFF_HEAD_DIM), 0.1),
        "diff_norm_g": 1.0 + nrm(ks[12], (L, D_DIFF), 0.02),
        "mlstm_norm_g": 1.0 + nrm(ks[13], (L, D_MLSTM), 0.02),
        "w_out": nrm(ks[14], (L, D_DIFF + D_MLSTM, D), (D_DIFF + D_MLSTM) ** -0.5),
        "ln_ffn_g": 1.0 + nrm(ks[15], (L, D), 0.02),
        "w_group": nrm(ks[16], (L, D, G), D ** -0.5),
        "b_group": nrm(ks[17], (L, G), 0.01),
        "w_router": nrm(ks[18], (L, G, D, E), D ** -0.5),
        "b_router": nrm(ks[19], (L, G, E), 0.01),
        "w_gate": nrm(ks[20], (L, G, E, D, F), D ** -0.5),
        "w_up": nrm(ks[21], (L, G, E, D, F), D ** -0.5),
        "w_down": nrm(ks[22], (L, G, E, F, D), F ** -0.5),
        "ln_f_g": 1.0 + nrm(ks[23], (D,), 0.02),
    }


def reference(x, rel_bias, ln_mix_g, w_in, conv_w, conv_b, b_i, b_f, lam_q1, lam_k1, lam_q2,
              lam_k2, diff_norm_g, mlstm_norm_g, w_out, ln_ffn_g, w_group, b_group, w_router,
              b_router, w_gate, w_up, w_down, ln_f_g):
    B, S, D = x.shape
    f32 = jnp.float32
    for l in range(DEPTH):
        lambda_init = 0.8 - 0.6 * math.exp(-0.3 * l)
        h = rmsnorm(x, ln_mix_g[l])
        proj = h @ w_in[l]
        q_d, k_d, v_d, q_m, k_m, v_m, o_m, i_m, f_m = jnp.split(proj, PROJ_SPLITS, axis=-1)

        q_d = jnp.transpose(q_d.reshape(B, S, N_DIFF_HEADS, 2, DIFF_HEAD_DIM), (0, 2, 3, 1, 4))
        k_d = jnp.transpose(k_d.reshape(B, S, N_DIFF_HEADS, 2, DIFF_HEAD_DIM), (0, 2, 3, 1, 4))
        v_d = jnp.transpose(v_d.reshape(B, S, N_DIFF_HEADS, DIFF_V_DIM), (0, 2, 1, 3))
        lam = (jnp.exp(jnp.sum(lam_q1[l].astype(f32) * lam_k1[l].astype(f32)))
               - jnp.exp(jnp.sum(lam_q2[l].astype(f32) * lam_k2[l].astype(f32))) + lambda_init)
        a = diff_attention(q_d[:, :, 0], q_d[:, :, 1], k_d[:, :, 0], k_d[:, :, 1], v_d, lam, rel_bias)
        a = head_rmsnorm(jnp.transpose(a, (0, 2, 1, 3)), diff_norm_g[l]) * (1.0 - lambda_init)
        a = a.reshape(B, S, D_DIFF)

        qk = jax.nn.silu(causal_conv(jnp.concatenate([q_m, k_m], axis=-1), conv_w[l], conv_b[l]))
        q_m, k_m = jnp.split(qk, 2, axis=-1)

        def heads(t):
            return jnp.transpose(t.reshape(B, S, N_MLSTM_HEADS, MLSTM_HEAD_DIM), (0, 2, 1, 3)).astype(f32)

        i_pre = jnp.transpose(i_m.astype(f32) + b_i[l].astype(f32), (0, 2, 1))
        f_pre = jnp.transpose(f_m.astype(f32) + b_f[l].astype(f32), (0, 2, 1))
        hm = mlstm_chunkwise(heads(q_m), heads(k_m) * MLSTM_HEAD_DIM ** -0.5, heads(v_m), i_pre, f_pre)
        hm = head_rmsnorm(jnp.transpose(hm, (0, 2, 1, 3)).astype(x.dtype), mlstm_norm_g[l])
        hm = (hm * jax.nn.sigmoid(o_m).reshape(B, S, N_MLSTM_HEADS, MLSTM_HEAD_DIM)).reshape(B, S, D_MLSTM)

        x = x + jnp.concatenate([a, hm], axis=-1) @ w_out[l]

        h = rmsnorm(x, ln_ffn_g[l]).reshape(B * S, D)
        x = x + hier_moe(h, w_group[l], b_group[l], w_router[l], b_router[l],
                         w_gate[l], w_up[l], w_down[l]).reshape(B, S, D)
    return rmsnorm(x, ln_f_g)
```

```cpp
#include <hip/hip_runtime.h>
#include <cstdio>
#include <cstdint>
#include <cmath>
namespace pg8 {
#define PG8_LAS __attribute__((address_space(3)))
typedef unsigned short bf16_t;
typedef short bf16x8 __attribute__((ext_vector_type(8)));
typedef float f32x4 __attribute__((ext_vector_type(4)));
typedef unsigned u32x4 __attribute__((ext_vector_type(4)));
constexpr int BM = 256, BK = 64, HALF = 128, HTB = HALF * BK * 2  , STAGE_BYTES = 8 * HTB, NXCD = 8, WGM = 8;

__host__ __device__ __forceinline__ int lds_byte(int r, int c) { const int st = (r >> 4) * 2 + (c >> 5), rr = r & 15, cc = c & 31, ob = rr * 64 + cc * 2; return st * 1024 + (ob ^ (((ob >> 9) & 1) << 5)); }
__host__ __device__ __forceinline__ void stage_rc(int b, int& R, int& C) { const int st = b / 1024, sb = b % 1024, swz = sb ^ (((sb >> 9) & 1) << 5); R = (st >> 1) * 16 + swz / 64; C = (st & 1) * 32 + (swz % 64) / 2; }
__host__ __device__ __forceinline__ int perm32(int rho) { const int n = rho >> 4, i = rho & 15; return 8 * (i >> 2) + 4 * n + (i & 3); }

struct Unit { int pm, pn; };
struct Gemm { const bf16_t* A; const bf16_t* Bt; int M, N, K; };

struct StaticOrder {
    int nM, nN, nwg, G, c;
    __host__ __device__ void init(int M, int N, int G_, int c_) { nM = M / BM; nN = N / BM; nwg = nM * nN; G = G_; c = c_; }
    __host__ __device__ bool next(int i, Unit& u) const {
        const long L = (long)i * G + c; if (L >= nwg) return false;
        int wgid = (int)L; { const int q = nwg / NXCD, r = nwg % NXCD, xcd = wgid % NXCD, off = wgid / NXCD; wgid = (xcd < r ? xcd * (q + 1) : r * (q + 1) + (xcd - r) * q) + off; }
        const int nig = WGM * nN, gid = wgid / nig, fm = gid * WGM, gsz = (nM - fm) < WGM ? (nM - fm) : WGM;
        u.pm = fm + ((wgid % nig) % gsz); u.pn = (wgid % nig) / gsz; return true;
    }
    __device__ __forceinline__ void a_ready(const Unit&) const {}
    __device__ __forceinline__ void done(const Unit&) const {}
};

__device__ __forceinline__ unsigned cvt_pk_bf16(float lo, float hi) { unsigned r; asm volatile("v_cvt_pk_bf16_f32 %0, %1, %2" : "=v"(r) : "v"(lo), "v"(hi)); return r; }
typedef float f32x2 __attribute__((ext_vector_type(2)));
constexpr int kT = 8192;
struct MoeSched {
    const int* tab; int nN, G, c;
    __device__ __forceinline__ bool next(int i, Unit& u) const {
        const int MT = tab[0]; const long L = (long)i * G + c; if (L >= (long)MT * nN) return false;
        const int mt = (int)(L / nN), pn = (int)(L % nN); u.pm = mt; u.pn = tab[1 + mt] * nN + pn; return true;
    }
    __device__ __forceinline__ void a_ready(const Unit&) const {}
    __device__ __forceinline__ void done(const Unit&) const {}
};
__device__ __forceinline__ u32x4 pack8(const f32x4 v0, const f32x4 v1) { u32x4 w; w.x = cvt_pk_bf16(v0[0], v0[1]); w.y = cvt_pk_bf16(v0[2], v0[3]); w.z = cvt_pk_bf16(v1[0], v1[1]); w.w = cvt_pk_bf16(v1[2], v1[3]); return w; }
struct EpiInProj {
    static constexpr bool PERM = true, AFTER_DRAIN = false;
    bf16_t* seg; float* gates; const float* b_i; const float* b_f; float qscale;
    __device__ __forceinline__ void operator()(const f32x4 (&acc)[2][2][4][2], const Unit& u, int wr, int wc, int fr, int fq) const {
        const int row0 = u.pm * BM + wr * 64 + fr;
        if (u.pn < 28) {
            const int s = u.pn >> 2; bf16_t* base = seg + (size_t)s * ((size_t)kT * 1024); const float sc = (s == 0) ? qscale : 1.f;
            const int col0 = (u.pn & 3) * BM + wc * 32 + 8 * fq;
#pragma unroll
            for (int ai = 0; ai < 2; ++ai)
#pragma unroll
                for (int m = 0; m < 4; ++m) { bf16_t* rowp = base + (size_t)(row0 + ai * HALF + m * 16) * 1024 + col0;
#pragma unroll
                    for (int bj = 0; bj < 2; ++bj) *(u32x4*)(rowp + bj * HALF) = pack8(acc[ai][bj][m][0] * sc, acc[ai][bj][m][1] * sc); }
        } else if (wc == 0 && fq < 2) {
#pragma unroll
            for (int ai = 0; ai < 2; ++ai)
#pragma unroll
                for (int m = 0; m < 4; ++m) { const int r = row0 + ai * HALF + m * 16;
#pragma unroll
                    for (int n = 0; n < 2; ++n)
#pragma unroll
                        for (int i = 0; i < 4; ++i) { const int col = 8 * fq + 4 * n + i; gates[(size_t)r * 16 + col] = acc[ai][0][m][n][i] + (col < 8 ? b_i[col] : b_f[col - 8]); } }
        }
    }
};
struct EpiOutProj {
    static constexpr bool PERM = false, AFTER_DRAIN = false;
    const float* x; float* x1;
    __device__ __forceinline__ void operator()(const f32x4 (&acc)[2][2][4][2], const Unit& u, int wr, int wc, int fr, int fq) const {
        const int col0 = u.pn * BM + wc * 32 + 4 * fq;
#pragma unroll
        for (int ai = 0; ai < 2; ++ai)
#pragma unroll
            for (int m = 0; m < 4; ++m) { const size_t off = (size_t)(u.pm * BM + ai * HALF + wr * 64 + m * 16 + fr) * 2048 + col0;
#pragma unroll
                for (int bj = 0; bj < 2; ++bj)
#pragma unroll
                    for (int n = 0; n < 2; ++n) { const f32x4 o = acc[ai][bj][m][n] + *(const f32x4*)(x + off + bj * HALF + n * 16); *(f32x4*)(x1 + off + bj * HALF + n * 16) = o; } }
    }
};
__device__ __forceinline__ float silu_f(float g) { return g / (1.f + __expf(-g)); }
struct EpiGU {
    static constexpr bool PERM = true, AFTER_DRAIN = false;
    bf16_t* hid; const float* roww;
    __device__ __forceinline__ void operator()(const f32x4 (&acc)[2][2][4][2], const Unit& u, int wr, int wc, int fr, int fq) const {
        const int pnl = u.pn & 3, row0 = u.pm * BM + wr * 64 + fr, col0 = pnl * 128 + wc * 32 + 8 * fq;
#pragma unroll
        for (int ai = 0; ai < 2; ++ai)
#pragma unroll
            for (int m = 0; m < 4; ++m) { const int r = row0 + ai * HALF + m * 16; const float w = roww[r]; f32x4 h0, h1;
#pragma unroll
                for (int i = 0; i < 4; ++i) { h0[i] = silu_f(acc[ai][0][m][0][i]) * acc[ai][1][m][0][i] * w; h1[i] = silu_f(acc[ai][0][m][1][i]) * acc[ai][1][m][1][i] * w; }
                *(u32x4*)(hid + (size_t)r * 512 + col0) = pack8(h0, h1); }
    }
};
struct EpiDown {
    static constexpr bool PERM = true, AFTER_DRAIN = false;
    bf16_t* y; const int* rowtok; size_t slot_stride;
    __device__ __forceinline__ void operator()(const f32x4 (&acc)[2][2][4][2], const Unit& u, int wr, int wc, int fr, int fq) const {
        const int pnl = u.pn & 7, row0 = u.pm * BM + wr * 64 + fr, col0 = pnl * BM + wc * 32 + 8 * fq;
#pragma unroll
        for (int ai = 0; ai < 2; ++ai)
#pragma unroll
            for (int m = 0; m < 4; ++m) { const int r = row0 + ai * HALF + m * 16; const int ts = rowtok[r];
                if (ts >= 0) { bf16_t* dst = y + (size_t)(ts & 1) * slot_stride + (size_t)(ts >> 1) * 2048 + col0;
#pragma unroll
                    for (int bj = 0; bj < 2; ++bj) *(u32x4*)(dst + bj * HALF) = pack8(acc[ai][bj][m][0], acc[ai][bj][m][1]); } }
    }
};
template <class Epi, class Sched, bool ALIGN_EPI = false, bool SP2 = false>
__device__ __forceinline__ void gemm_phase(PG8_LAS unsigned char* lds, const Gemm g, const Sched& S, const Epi& E) {
    const int tid = threadIdx.x, wid = __builtin_amdgcn_readfirstlane(tid >> 6), lane = tid & 63, wr = wid >> 2, wc = wid & 3, fr = lane & 15, fq = lane >> 4;
    const int K = g.K, nt = K / BK;
    unsigned voffA[2], voffB[2];
#pragma unroll
    for (int i = 0; i < 2; ++i) { int R, C; stage_rc(tid * 16 + i * 8192, R, C); const int Rb = Epi::PERM ? ((R & ~31) + perm32(R & 31)) : R;
        voffA[i] = (unsigned)(R * K + C) * 2u; voffB[i] = (unsigned)(Rb * K + C) * 2u; }
    const size_t kstep = (size_t)(BK * 2);
    const size_t hstep = (size_t)HALF * K * 2;
    const size_t tstep = 2 * hstep;
    const unsigned ldsw = (unsigned)wid * 1024u;
    const int aoff = lds_byte(wr * 64 + fr, fq * 8), boff = lds_byte(wc * 32 + fr, fq * 8);
#define PG8_SA(b, h) (((b) * 2 + (h)) * HTB)
#define PG8_SB(b, h) ((4 + (b) * 2 + (h)) * HTB)
#define PG8_STAGE(bufoff, gbase, voff) do { _Pragma("unroll") for (int _i = 0; _i < 2; ++_i) \
        __builtin_amdgcn_global_load_lds((const unsigned*)((const char*)(gbase) + (voff)[_i]), (PG8_LAS unsigned*)(lds + (bufoff) + ldsw + _i * 8192), 16, 0, 0); } while (0)
#define PG8_LDA(dst, b, h) do { _Pragma("unroll") for (int m = 0; m < 4; ++m) _Pragma("unroll") for (int k = 0; k < 2; ++k) dst[m][k] = *(const PG8_LAS bf16x8*)(lds + PG8_SA(b, h) + aoff + m * 2048 + k * 1024); } while (0)
#define PG8_LDB(dst, b, h) do { _Pragma("unroll") for (int n = 0; n < 2; ++n) _Pragma("unroll") for (int k = 0; k < 2; ++k) dst[n][k] = *(const PG8_LAS bf16x8*)(lds + PG8_SB(b, h) + boff + n * 2048 + k * 1024); } while (0)
#define PG8_MMA(ai, bj, At, Bt) do { __builtin_amdgcn_s_setprio(1); _Pragma("unroll") for (int m = 0; m < 4; ++m) _Pragma("unroll") for (int n = 0; n < 2; ++n) _Pragma("unroll") for (int k = 0; k < 2; ++k) \
        acc[ai][bj][m][n] = __builtin_amdgcn_mfma_f32_16x16x32_bf16(Bt[n][k], At[m][k], acc[ai][bj][m][n], 0, 0, 0); __builtin_amdgcn_s_setprio(0); } while (0)
#define PG8_WAIT_V(n) asm volatile("s_waitcnt vmcnt(" #n ")" ::: "memory")
#define PG8_WAIT_L(n) asm volatile("s_waitcnt lgkmcnt(" #n ")" ::: "memory")
#define PG8_BAR __builtin_amdgcn_s_barrier()
#define PG8_SCHED __builtin_amdgcn_sched_barrier(0)
    Unit cur, nxt; int ui = 0;
    if (!S.next(0, cur)) return;
    f32x4 acc[2][2][4][2];
#pragma unroll
    for (int a = 0; a < 2; ++a)
#pragma unroll
        for (int b = 0; b < 2; ++b)
#pragma unroll
            for (int m = 0; m < 4; ++m)
#pragma unroll
                for (int n = 0; n < 2; ++n) acc[a][b][m][n] = (f32x4){0.f, 0.f, 0.f, 0.f};
    bf16x8 At[4][2], B0[2][2], B1[2][2];
    const char* cA = (const char*)g.A + (size_t)cur.pm * tstep; const char* cB = (const char*)g.Bt + (size_t)cur.pn * tstep;
    S.a_ready(cur);
    if constexpr (SP2) {
        PG8_STAGE(PG8_SB(0, 0), cB, voffB); PG8_STAGE(PG8_SB(0, 1), cB + hstep, voffB); PG8_STAGE(PG8_SA(0, 0), cA, voffA); PG8_STAGE(PG8_SA(0, 1), cA + hstep, voffA);
        if (wr == 1) PG8_BAR;
        PG8_WAIT_V(2); PG8_BAR;
        PG8_STAGE(PG8_SB(1, 0), cB + kstep, voffB); PG8_STAGE(PG8_SA(1, 0), cA + kstep, voffA); PG8_STAGE(PG8_SB(1, 1), cB + hstep + kstep, voffB);
        PG8_WAIT_V(6); PG8_BAR;
    } else {
        PG8_STAGE(PG8_SB(0, 0), cB, voffB); PG8_STAGE(PG8_SA(0, 0), cA, voffA); PG8_STAGE(PG8_SB(0, 1), cB + hstep, voffB); PG8_STAGE(PG8_SA(0, 1), cA + hstep, voffA);
        if (wr == 1) PG8_BAR;
        PG8_WAIT_V(4); PG8_BAR;
        PG8_STAGE(PG8_SB(1, 0), cB + kstep, voffB); PG8_STAGE(PG8_SA(1, 0), cA + kstep, voffA); PG8_STAGE(PG8_SB(1, 1), cB + hstep + kstep, voffB);
        PG8_WAIT_V(6); PG8_BAR;
    }
    for (;;) {
        const bool has_next = S.next(ui + 1, nxt);
        const char* nA = has_next ? (const char*)g.A + (size_t)nxt.pm * tstep : cA; const char* nB = has_next ? (const char*)g.Bt + (size_t)nxt.pn * tstep : cB;
        for (int t = 0; t < nt; t += 2) {
            const bool last = (t == nt - 2);
            const char* a1 = cA + (size_t)(t + 1) * kstep;
            const char* a2 = last ? nA : cA + (size_t)(t + 2) * kstep; const char* b2 = last ? nB : cB + (size_t)(t + 2) * kstep;
            const char* a3 = a2 + kstep; const char* b3 = b2 + kstep;
            if (last && has_next) S.a_ready(nxt);
            if constexpr (SP2) {
            PG8_LDB(B0, 0, 0); PG8_LDB(B1, 0, 1); PG8_SCHED; PG8_LDA(At, 0, 0); PG8_STAGE(PG8_SA(1, 1), a1 + hstep, voffA);
            PG8_WAIT_V(8); PG8_WAIT_L(0); PG8_BAR; PG8_MMA(0, 0, At, B0); PG8_MMA(0, 1, At, B1); PG8_BAR; PG8_SCHED;
            PG8_LDA(At, 0, 1); PG8_STAGE(PG8_SB(0, 0), b2, voffB); PG8_STAGE(PG8_SB(0, 1), b2 + hstep, voffB); PG8_STAGE(PG8_SA(0, 0), a2, voffA);
            PG8_WAIT_V(8); PG8_WAIT_L(0); PG8_BAR; PG8_MMA(1, 0, At, B0); PG8_MMA(1, 1, At, B1); PG8_BAR; PG8_SCHED;
            PG8_LDB(B0, 1, 0); PG8_LDB(B1, 1, 1); PG8_SCHED; PG8_LDA(At, 1, 0); PG8_STAGE(PG8_SA(0, 1), a2 + hstep, voffA);
            PG8_WAIT_V(8); PG8_WAIT_L(0); PG8_BAR; PG8_MMA(0, 0, At, B0); PG8_MMA(0, 1, At, B1); PG8_BAR; PG8_SCHED;
            PG8_LDA(At, 1, 1); PG8_STAGE(PG8_SB(1, 0), b3, voffB); PG8_STAGE(PG8_SB(1, 1), b3 + hstep, voffB); PG8_STAGE(PG8_SA(1, 0), a3, voffA);
            PG8_WAIT_V(8); PG8_WAIT_L(0); PG8_BAR; PG8_MMA(1, 0, At, B0); PG8_MMA(1, 1, At, B1); PG8_BAR; PG8_SCHED;
            } else {
            PG8_LDB(B0, 0, 0); PG8_SCHED; PG8_LDA(At, 0, 0); PG8_STAGE(PG8_SA(1, 1), a1 + hstep, voffA);
            PG8_WAIT_L(8); PG8_BAR; PG8_WAIT_L(0); PG8_MMA(0, 0, At, B0); PG8_BAR; PG8_SCHED;
            PG8_LDB(B1, 0, 1); PG8_STAGE(PG8_SB(0, 0), b2, voffB);
            PG8_BAR; PG8_WAIT_L(0); PG8_MMA(0, 1, At, B1); PG8_BAR;
            PG8_LDA(At, 0, 1); PG8_STAGE(PG8_SA(0, 0), a2, voffA);
            PG8_BAR; PG8_WAIT_L(0); PG8_MMA(1, 0, At, B0); PG8_BAR; PG8_SCHED;
            PG8_STAGE(PG8_SB(0, 1), b2 + hstep, voffB);
            PG8_WAIT_V(6); PG8_BAR; PG8_MMA(1, 1, At, B1); PG8_BAR;
            PG8_LDB(B0, 1, 0); PG8_SCHED; PG8_LDA(At, 1, 0); PG8_STAGE(PG8_SA(0, 1), a2 + hstep, voffA);
            PG8_WAIT_L(8); PG8_BAR; PG8_WAIT_L(0); PG8_MMA(0, 0, At, B0); PG8_BAR; PG8_SCHED;
            PG8_LDB(B1, 1, 1); PG8_STAGE(PG8_SB(1, 0), b3, voffB);
            PG8_BAR; PG8_WAIT_L(0); PG8_MMA(0, 1, At, B1); PG8_BAR;
            PG8_LDA(At, 1, 1); PG8_STAGE(PG8_SA(1, 0), a3, voffA);
            PG8_BAR; PG8_WAIT_L(0); PG8_MMA(1, 0, At, B0); PG8_BAR; PG8_SCHED;
            PG8_STAGE(PG8_SB(1, 1), b3 + hstep, voffB);
            PG8_WAIT_V(6); PG8_BAR; PG8_MMA(1, 1, At, B1); PG8_BAR;
            }
        }
        if constexpr (ALIGN_EPI) { if (wr == 0) PG8_BAR; }
        if constexpr (!Epi::AFTER_DRAIN) { E(acc, cur, wr, wc, fr, fq); S.done(cur); }
        if (!has_next) break;
#pragma unroll
        for (int a = 0; a < 2; ++a)
#pragma unroll
            for (int b = 0; b < 2; ++b)
#pragma unroll
                for (int m = 0; m < 4; ++m)
#pragma unroll
                    for (int n = 0; n < 2; ++n) acc[a][b][m][n] = (f32x4){0.f, 0.f, 0.f, 0.f};
        cur = nxt; cA = nA; cB = nB; ++ui;
        if constexpr (ALIGN_EPI) { if (wr == 1) PG8_BAR; }
    }
    PG8_WAIT_V(0);
    if constexpr (!ALIGN_EPI) { if (wr == 0) PG8_BAR; }
    PG8_BAR;
    if constexpr (Epi::AFTER_DRAIN) { E.fused(acc, cur, wr, wc, fr, fq, lds, wid, lane); S.done(cur); }
#undef PG8_SA
#undef PG8_SB
#undef PG8_STAGE
#undef PG8_LDA
#undef PG8_LDB
#undef PG8_MMA
#undef PG8_WAIT_V
#undef PG8_WAIT_L
#undef PG8_BAR
#undef PG8_SCHED
}
}
#define GAS __attribute__((address_space(1)))
#define LAS __attribute__((address_space(3)))
typedef unsigned short bf16;
typedef unsigned v4u __attribute__((ext_vector_type(4)));
typedef float f32x4 __attribute__((ext_vector_type(4)));
typedef short bf16x8 __attribute__((ext_vector_type(8)));
typedef GAS unsigned gu32;
typedef GAS unsigned long long gu64;
#define RLX_AGENT __ATOMIC_RELAXED, __HIP_MEMORY_SCOPE_AGENT
#define LDS_WAIT() asm volatile("s_waitcnt lgkmcnt(0)" ::: "memory")
#define VM_WAIT() asm volatile("s_waitcnt vmcnt(0)" ::: "memory")
__device__ __forceinline__ unsigned long long rt() { return __builtin_amdgcn_s_memrealtime(); }
__device__ __forceinline__ unsigned f2bf(float f) { unsigned u = __builtin_bit_cast(unsigned, f); return (u + 0x7fffu + ((u >> 16) & 1u)) >> 16; }
__device__ __forceinline__ unsigned pk2(float lo, float hi) { return f2bf(lo) | (f2bf(hi) << 16); }

#define XB_TMO      128
#define XB_XCNT(j)  (256  + 64 * (j))
#define XB_XSUB(j)  (1280 + 64 * (j))
#define XB_XGEN(j)  (2304 + 64 * (j))
#define XB_TOP      3328
#define XB_TOPGEN   3392
#define XCD_BAR_WORDS 3456
#define XB_SPIN_CAP (1u << 18)

__device__ __forceinline__ unsigned xb_ld(unsigned* p)              { return __hip_atomic_load(p, __ATOMIC_RELAXED, __HIP_MEMORY_SCOPE_AGENT); }
__device__ __forceinline__ unsigned xb_add(unsigned* p, unsigned v) { return __hip_atomic_fetch_add(p, v, __ATOMIC_RELAXED, __HIP_MEMORY_SCOPE_AGENT); }
__device__ __forceinline__ unsigned xb_xcc_id() { return (unsigned)__builtin_amdgcn_s_getreg((3 << 11) | 20) & 0xFu; }
#define XB_SPIN(cond, bar) do { unsigned _sp = 0; while (cond) { __builtin_amdgcn_s_sleep(1); \
    if ((++_sp & 255u) == 0u) { if (xb_ld(&(bar)[XB_TMO])) break; if (_sp > XB_SPIN_CAP) { atomicAdd(&(bar)[XB_TMO], 1u); break; } } } } while (0)

struct XcdBarrier {
    unsigned* bar; unsigned x;
    volatile LAS unsigned* st;
};

__device__ __forceinline__ XcdBarrier xcd_barrier_post(unsigned* bar, volatile LAS unsigned* st) {
    XcdBarrier b; b.bar = bar; b.x = xb_xcc_id(); b.st = st;
    if (threadIdx.x == 0) (void)xb_add(&bar[XB_XCNT(b.x)], 1u);
    return b;
}
__device__ __forceinline__ void xcd_barrier_complete(unsigned* bar, unsigned x, unsigned& nloc, unsigned& nx) {
    const unsigned G = gridDim.x * gridDim.y * gridDim.z;
    unsigned sum, cnt, mine, sp = 0u;
    for (;;) {
        sum = 0u; cnt = 0u; mine = 0u;
#pragma unroll
        for (unsigned j = 0; j < 16; ++j) { const unsigned c = xb_ld(&bar[XB_XCNT(j)]); sum += c; cnt += (c > 0u) ? 1u : 0u; mine = (j == x) ? c : mine; }
        if (sum == G) break;
        __builtin_amdgcn_s_sleep(1);
        if ((++sp & 255u) == 0u) { if (xb_ld(&bar[XB_TMO])) break; if (sp > XB_SPIN_CAP) { atomicAdd(&bar[XB_TMO], 1u); break; } }
    }
    nloc = mine > 0u ? mine : 1u; nx = cnt > 0u ? cnt : 1u;
}

__device__ __forceinline__ void xcd_barrier(const XcdBarrier& b) {
    asm volatile("s_waitcnt vmcnt(0)" ::: "memory");
    __syncthreads();
    if (threadIdx.x == 0) {
        unsigned* bar = b.bar;
        __builtin_amdgcn_s_waitcnt(0);
        unsigned nloc = b.st[0], nx = b.st[1];
        if (nloc == 0u) { xcd_barrier_complete(bar, b.x, nloc, nx); b.st[0] = nloc; b.st[1] = nx; }
        const unsigned old = xb_add(&bar[XB_XSUB(b.x)], 1u);
        const unsigned gen = old / nloc;
        if (old + 1u == (gen + 1u) * nloc) {
            __builtin_amdgcn_fence(__ATOMIC_RELEASE, "agent");
            asm volatile("s_waitcnt vmcnt(0)" ::: "memory");
            const unsigned og = xb_add(&bar[XB_TOP], 1u);
            const unsigned tg = og / nx;
            if (og + 1u == (tg + 1u) * nx) xb_add(&bar[XB_TOPGEN], 1u);
            else XB_SPIN(xb_ld(&bar[XB_TOPGEN]) == tg, bar);
            __builtin_amdgcn_fence(__ATOMIC_ACQUIRE, "agent");
            xb_add(&bar[XB_XGEN(b.x)], 1u);
            asm volatile("s_waitcnt vmcnt(0)" ::: "memory");
        } else {
            XB_SPIN(xb_ld(&bar[XB_XGEN(b.x)]) == gen, bar);
            __builtin_amdgcn_fence(__ATOMIC_ACQUIRE, "agent");
            asm volatile("s_waitcnt vmcnt(0)" ::: "memory");
        }
    }
    __syncthreads();
}

constexpr int BATCH = 2, SEQ = 4096, T = BATCH * SEQ, D = 2048;
constexpr int NPROJ = 7184, NPROJ_PAD = 7424, SEGW = 1024;
constexpr int NH = 8, CH = 64, NCH = SEQ / CH;
constexpr int NEXP = 32, FE = 512;
constexpr float EPS = 1e-6f, LOG2E = 1.4426950408889634f;
constexpr float QSCALE = 0.125f * LOG2E;
static_assert(T == pg8::kT, "token count");

constexpr size_t MiB = 1u << 20;
constexpr size_t WS_CTL = 0, CTL_ZERO_BYTES = 1 * MiB;
constexpr size_t WS_WIN = 1 * MiB, WS_WOUT = 30 * MiB, WS_WGU = 38 * MiB, WS_WD = 166 * MiB;
constexpr size_t WS_XN = 230 * MiB, WS_SEG = 262 * MiB, WS_GATES = 374 * MiB, WS_OA = 375 * MiB, WS_QC = 407 * MiB, WS_KC = 423 * MiB, WS_CLOC = 439 * MiB, WS_MISC = 503 * MiB, WS_END = 505 * MiB;
constexpr size_t SEG_BYTES = (size_t)T * SEGW * 2;
constexpr size_t WS_QD = WS_SEG, WS_KD = WS_SEG + SEG_BYTES, WS_VD = WS_SEG + 2 * SEG_BYTES, WS_QM = WS_SEG + 3 * SEG_BYTES, WS_KM = WS_SEG + 4 * SEG_BYTES, WS_VM = WS_SEG + 5 * SEG_BYTES, WS_OM = WS_SEG + 6 * SEG_BYTES;
constexpr size_t WS_BCUM = WS_MISC, WS_NLOC = WS_MISC + 256 * 1024, WS_G = WS_MISC + MiB, WS_MLOC = WS_G + 4096, WS_MPREV = WS_G + 8192;
constexpr size_t WS_A2 = WS_XN, WS_X1 = 262 * MiB, WS_H2 = 326 * MiB, WS_LIST = 358 * MiB, WS_LISTW = 359 * MiB, WS_ROWTOK = 360 * MiB, WS_ROWW = 360 * MiB + 512 * 1024, WS_TAB = 361 * MiB;
constexpr size_t WS_HS = 375 * MiB, WS_HID = 471 * MiB, WS_Y0 = 230 * MiB, WS_Y1 = 326 * MiB;
constexpr int MAXROWS = 24576;
constexpr int CW_CNT = 8192;

struct Params {
    const float *x, *rel_bias, *ln_mix_g, *w_in, *conv_w, *conv_b, *b_i, *b_f, *lam_q1, *lam_k1, *lam_q2, *lam_k2, *diff_norm_g, *mlstm_norm_g, *w_out, *ln_ffn_g,
                *w_group, *b_group, *w_router, *b_router, *w_gate, *w_up, *w_down, *ln_f_g;
    float* out; unsigned char* ws;
};

__device__ __forceinline__ float bf2f(unsigned short v) { return __uint_as_float((unsigned)v << 16); }
__device__ __forceinline__ float wave_sum(float v) {
#pragma unroll
    for (int o = 1; o < 64; o <<= 1) v += __shfl_xor(v, o);
    return v;
}
__device__ __forceinline__ float wave_max(float v) {
#pragma unroll
    for (int o = 1; o < 64; o <<= 1) v = fmaxf(v, __shfl_xor(v, o));
    return v;
}
__device__ __forceinline__ int t5_bucket(int rel) {
    const int n = rel < 0 ? -rel : rel;
    int b = n < 8 ? n : n < 12 ? 8 : n < 16 ? 9 : n < 23 ? 10 : n < 32 ? 11 : n < 46 ? 12 : n < 64 ? 13 : n < 91 ? 14 : 15;
    return b + (rel > 0 ? 16 : 0);
}

template <int NB> __device__ __forceinline__ void transpose_item(const float* src, size_t ld, bf16* dst, size_t kd, LAS float* scr, int lane) {
    constexpr int RPI = 64 / NB;
#pragma unroll 8
    for (int i = 0; i < 64 / RPI; ++i) { const int kk = RPI * i + lane / NB; scr[kk * 33 + (lane % NB)] = src[(size_t)kk * ld + (lane % NB)]; }
    LDS_WAIT(); asm volatile("" ::: "memory");
    const int c = lane & 7;
#pragma unroll
    for (int j = 0; j < NB / 8; ++j) { const int n = (lane >> 3) + 8 * j; const LAS float* s = scr + (8 * c) * 33 + n;
        v4u o; o.x = pk2(s[0 * 33], s[1 * 33]); o.y = pk2(s[2 * 33], s[3 * 33]); o.z = pk2(s[4 * 33], s[5 * 33]); o.w = pk2(s[6 * 33], s[7 * 33]);
        *(GAS v4u*)(dst + (size_t)n * kd + 8 * c) = o; }
    LDS_WAIT(); asm volatile("" ::: "memory");
}
__device__ __forceinline__ void rms_row_to_bf16(const float* xrow, const float* g, bf16* orow, int lane) {
    const GAS f32x4* xr = (const GAS f32x4*)xrow + lane; const GAS f32x4* gr = (const GAS f32x4*)g + lane;
    f32x4 v[8]; float s = 0.f;
#pragma unroll
    for (int j = 0; j < 8; ++j) { v[j] = xr[64 * j]; s += (v[j].x * v[j].x + v[j].y * v[j].y) + (v[j].z * v[j].z + v[j].w * v[j].w); }
    const float rstd = rsqrtf(wave_sum(s) * (1.f / D) + EPS);
    GAS unsigned long long* o8 = (GAS unsigned long long*)orow + lane;
#pragma unroll
    for (int j = 0; j < 8; ++j) { const f32x4 gv = gr[64 * j];
        o8[64 * j] = (unsigned long long)pk2(v[j].x * rstd * gv.x, v[j].y * rstd * gv.y) | ((unsigned long long)pk2(v[j].z * rstd * gv.z, v[j].w * rstd * gv.w) << 32); }
}
__device__ __forceinline__ void prologue_body(const Params& p, LAS unsigned char* lds, int gw, int NGW, int wave, int lane) {
    LAS float* scr = (LAS float*)lds + wave * 4096;
    bf16* Win = (bf16*)(p.ws + WS_WIN); bf16* Wout = (bf16*)(p.ws + WS_WOUT); bf16* Wgu = (bf16*)(p.ws + WS_WGU); bf16* Wd = (bf16*)(p.ws + WS_WD); bf16* XN = (bf16*)(p.ws + WS_XN);
    constexpr int I_IN = 32 * 224, I_ING = 32, I_OUT = 32 * 64, I_G = NEXP * 32 * 16, I_D = NEXP * 8 * 64;
    constexpr int NITEMS = I_IN + I_ING + I_OUT + 2 * I_G + I_D;
    for (int it = gw; it < NITEMS; it += NGW) {
        int r = it;
        if (r < I_IN) { const int kb = r / 224, nb = r % 224; transpose_item<32>(p.w_in + (size_t)(64 * kb) * NPROJ + 32 * nb, NPROJ, Win + (size_t)(32 * nb) * D + 64 * kb, D, scr, lane); continue; } r -= I_IN;
        if (r < I_ING) { const int kb = r; transpose_item<16>(p.w_in + (size_t)(64 * kb) * NPROJ + 7168, NPROJ, Win + (size_t)7168 * D + 64 * kb, D, scr, lane); continue; } r -= I_ING;
        if (r < I_OUT) { const int kb = r / 64, nb = r % 64; transpose_item<32>(p.w_out + (size_t)(64 * kb) * D + 32 * nb, D, Wout + (size_t)(32 * nb) * D + 64 * kb, D, scr, lane); continue; } r -= I_OUT;
        if (r < 2 * I_G) { const int up = (r >= I_G) ? 1 : 0; if (up) r -= I_G; const int e = r / 512, q = r % 512, kb = q / 16, nb = q % 16;
            const float* src = (up ? p.w_up : p.w_gate) + (size_t)e * D * FE + (size_t)(64 * kb) * FE + 32 * nb;
            const int f0 = 32 * nb, rowb = e * 1024 + (f0 >> 7) * 256 + up * 128 + (f0 & 127);
            transpose_item<32>(src, FE, Wgu + (size_t)rowb * D + 64 * kb, D, scr, lane); continue; } r -= 2 * I_G;
        { const int e = r / 512, q = r % 512, kb = q / 64, nb = q % 64;
          transpose_item<32>(p.w_down + (size_t)e * FE * D + (size_t)(64 * kb) * D + 32 * nb, D, Wd + ((size_t)e * 2048 + 32 * nb) * FE + 64 * kb, FE, scr, lane); }
    }
    for (int r = gw; r < NPROJ_PAD - NPROJ; r += NGW) { GAS v4u* o = (GAS v4u*)(Win + (size_t)(NPROJ + r) * D) + lane; const v4u z = {0u, 0u, 0u, 0u};
#pragma unroll
        for (int j = 0; j < 4; ++j) o[64 * j] = z; }
    for (int m = gw; m < T; m += NGW) rms_row_to_bf16(p.x + (size_t)m * D, p.ln_mix_g, XN + (size_t)m * D, lane);
}
__global__ void __launch_bounds__(512, 2) k_prologue(Params p) {
    extern __shared__ __attribute__((aligned(16))) unsigned char lds[];
    const int tid = threadIdx.x, lane = tid & 63, wave = __builtin_amdgcn_readfirstlane(tid >> 6);
    prologue_body(p, (LAS unsigned char*)lds, blockIdx.x * 8 + wave, gridDim.x * 8, wave, lane);
}

__global__ void __launch_bounds__(512, 2) k_gemm_inproj(Params p) {
    extern __shared__ __attribute__((aligned(16))) unsigned char lds[];
    pg8::Gemm g{(const pg8::bf16_t*)(p.ws + WS_XN), (const pg8::bf16_t*)(p.ws + WS_WIN), T, NPROJ_PAD, D};
    pg8::StaticOrder S; S.init(T, NPROJ_PAD, gridDim.x, blockIdx.x);
    pg8::EpiInProj E{(pg8::bf16_t*)(p.ws + WS_SEG), (float*)(p.ws + WS_GATES), p.b_i, p.b_f, QSCALE};
    pg8::gemm_phase<pg8::EpiInProj, pg8::StaticOrder, true, true>((LAS unsigned char*)lds, g, S, E);
}
__global__ void __launch_bounds__(512, 2) k_gemm_outproj(Params p) {
    extern __shared__ __attribute__((aligned(16))) unsigned char lds[];
    pg8::Gemm g{(const pg8::bf16_t*)(p.ws + WS_A2), (const pg8::bf16_t*)(p.ws + WS_WOUT), T, D, D};
    pg8::StaticOrder S; S.init(T, D, gridDim.x, blockIdx.x);
    pg8::EpiOutProj E{p.x, (float*)(p.ws + WS_X1)};
    pg8::gemm_phase<pg8::EpiOutProj, pg8::StaticOrder, true, true>((LAS unsigned char*)lds, g, S, E);
}
__global__ void __launch_bounds__(512, 2) k_gemm_gu(Params p) {
    extern __shared__ __attribute__((aligned(16))) unsigned char lds[];
    pg8::Gemm g{(const pg8::bf16_t*)(p.ws + WS_HS), (const pg8::bf16_t*)(p.ws + WS_WGU), MAXROWS, NEXP * 1024, D};
    pg8::MoeSched S{(const int*)(p.ws + WS_TAB), 4, (int)gridDim.x, (int)blockIdx.x};
    pg8::EpiGU E{(pg8::bf16_t*)(p.ws + WS_HID), (const float*)(p.ws + WS_ROWW)};
    pg8::gemm_phase<pg8::EpiGU, pg8::MoeSched, true, true>((LAS unsigned char*)lds, g, S, E);
}
__global__ void __launch_bounds__(512, 2) k_gemm_down(Params p) {
    extern __shared__ __attribute__((aligned(16))) unsigned char lds[];
    pg8::Gemm g{(const pg8::bf16_t*)(p.ws + WS_HID), (const pg8::bf16_t*)(p.ws + WS_WD), MAXROWS, NEXP * 2048, FE};
    pg8::MoeSched S{(const int*)(p.ws + WS_TAB), 8, (int)gridDim.x, (int)blockIdx.x};
    pg8::EpiDown E{(pg8::bf16_t*)(p.ws + WS_Y0), (const int*)(p.ws + WS_ROWTOK), (WS_Y1 - WS_Y0) / 2};
    pg8::gemm_phase<pg8::EpiDown, pg8::MoeSched, true, true>((LAS unsigned char*)lds, g, S, E);
}

__global__ void __launch_bounds__(64) k_attn_naive(Params p) {
    __shared__ __attribute__((aligned(16))) float Ks[64][68];
    __shared__ __attribute__((aligned(16))) float Vs[64][68];
    __shared__ float tab[192];
    const int lane = threadIdx.x, bx = blockIdx.x;
    const int qc = 63 - (bx & 63), rest = bx >> 6, vh = rest & 1, map = (rest >> 1) & 1, h = (rest >> 2) & 7, b = rest >> 5;
    const bf16* QD = (const bf16*)(p.ws + WS_QD); const bf16* KD = (const bf16*)(p.ws + WS_KD); const bf16* VD = (const bf16*)(p.ws + WS_VD); bf16* OA = (bf16*)(p.ws + WS_OA);
    for (int i = lane; i < 191; i += 64) tab[i] = p.rel_bias[t5_bucket(i - 127) * 8 + h] * LOG2E;
    const int t = qc * 64 + lane; const size_t row = (size_t)b * SEQ + t;
    float q[64];
    { const v4u* qp = (const v4u*)(QD + row * 1024 + h * 128 + map * 64);
#pragma unroll
      for (int i = 0; i < 8; ++i) { const v4u w = qp[i];
          q[8 * i + 0] = __uint_as_float(w.x << 16); q[8 * i + 1] = __uint_as_float(w.x & 0xffff0000u); q[8 * i + 2] = __uint_as_float(w.y << 16); q[8 * i + 3] = __uint_as_float(w.y & 0xffff0000u);
          q[8 * i + 4] = __uint_as_float(w.z << 16); q[8 * i + 5] = __uint_as_float(w.z & 0xffff0000u); q[8 * i + 6] = __uint_as_float(w.w << 16); q[8 * i + 7] = __uint_as_float(w.w & 0xffff0000u); } }
    float acc[64];
#pragma unroll
    for (int d = 0; d < 64; ++d) acc[d] = 0.f;
    float m = -INFINITY, l = 0.f;
    for (int kt = 0; kt <= qc; ++kt) {
        __syncthreads();
        { const size_t krow = (size_t)b * SEQ + kt * 64 + lane;
          const v4u* kp = (const v4u*)(KD + krow * 1024 + h * 128 + map * 64);
#pragma unroll
          for (int i = 0; i < 8; ++i) { const v4u w = kp[i];
              *(f32x4*)&Ks[lane][8 * i] = (f32x4){__uint_as_float(w.x << 16), __uint_as_float(w.x & 0xffff0000u), __uint_as_float(w.y << 16), __uint_as_float(w.y & 0xffff0000u)};
              *(f32x4*)&Ks[lane][8 * i + 4] = (f32x4){__uint_as_float(w.z << 16), __uint_as_float(w.z & 0xffff0000u), __uint_as_float(w.w << 16), __uint_as_float(w.w & 0xffff0000u)}; }
          const v4u* vp = (const v4u*)(VD + krow * 1024 + h * 128 + vh * 64);
#pragma unroll
          for (int i = 0; i < 8; ++i) { const v4u w = vp[i];
              *(f32x4*)&Vs[lane][8 * i] = (f32x4){__uint_as_float(w.x << 16), __uint_as_float(w.x & 0xffff0000u), __uint_as_float(w.y << 16), __uint_as_float(w.y & 0xffff0000u)};
              *(f32x4*)&Vs[lane][8 * i + 4] = (f32x4){__uint_as_float(w.z << 16), __uint_as_float(w.z & 0xffff0000u), __uint_as_float(w.w << 16), __uint_as_float(w.w & 0xffff0000u)}; } }
        __syncthreads();
#pragma unroll 1
        for (int j0 = 0; j0 < 64; j0 += 16) {
            float s[16]; float mx = -INFINITY;
#pragma unroll
            for (int jj = 0; jj < 16; ++jj) { float a = 0.f;
#pragma unroll
                for (int d = 0; d < 64; d += 4) { const f32x4 kv = *(const f32x4*)&Ks[j0 + jj][d]; a += q[d] * kv.x + q[d + 1] * kv.y + q[d + 2] * kv.z + q[d + 3] * kv.w; }
                int rel = kt * 64 + j0 + jj - t; rel = rel < -127 ? -127 : rel;
                s[jj] = a + tab[rel + 127]; mx = fmaxf(mx, s[jj]); }
            const float mn = fmaxf(m, mx), sc = __builtin_amdgcn_exp2f(m - mn); l *= sc;
#pragma unroll
            for (int d = 0; d < 64; ++d) acc[d] *= sc;
#pragma unroll
            for (int jj = 0; jj < 16; ++jj) { const float pj = __builtin_amdgcn_exp2f(s[jj] - mn); l += pj;
#pragma unroll
                for (int d = 0; d < 64; d += 4) { const f32x4 vv = *(const f32x4*)&Vs[j0 + jj][d]; acc[d] += pj * vv.x; acc[d + 1] += pj * vv.y; acc[d + 2] += pj * vv.z; acc[d + 3] += pj * vv.w; } }
            m = mn;
        }
    }
    const float inv = 1.f / l;
    v4u* op = (v4u*)(OA + row * 2048 + h * 256 + map * 128 + vh * 64);
#pragma unroll
    for (int i = 0; i < 8; ++i) { v4u w; w.x = pk2(acc[8 * i] * inv, acc[8 * i + 1] * inv); w.y = pk2(acc[8 * i + 2] * inv, acc[8 * i + 3] * inv); w.z = pk2(acc[8 * i + 4] * inv, acc[8 * i + 5] * inv); w.w = pk2(acc[8 * i + 6] * inv, acc[8 * i + 7] * inv); op[i] = w; }
}

__global__ void __launch_bounds__(256) k_conv(Params p) {
    const int idx = blockIdx.x * 256 + threadIdx.x; const int t = idx >> 8, c8 = (idx & 255) * 8, ts = t & (SEQ - 1), cc = c8 & 1023; const bool isk = c8 >= 1024;
    const bf16* src = (const bf16*)(p.ws + (isk ? WS_KM : WS_QM)); bf16* dst = (bf16*)(p.ws + (isk ? WS_KC : WS_QC));
    float a[8];
#pragma unroll
    for (int i = 0; i < 8; ++i) a[i] = p.conv_b[c8 + i];
#pragma unroll
    for (int j = 0; j < 4; ++j) { if (ts - 3 + j >= 0) { const v4u w = *(const v4u*)(src + (size_t)(t - 3 + j) * 1024 + cc); const float* cw = p.conv_w + j * 2048 + c8;
        a[0] += cw[0] * __uint_as_float(w.x << 16); a[1] += cw[1] * __uint_as_float(w.x & 0xffff0000u); a[2] += cw[2] * __uint_as_float(w.y << 16); a[3] += cw[3] * __uint_as_float(w.y & 0xffff0000u);
        a[4] += cw[4] * __uint_as_float(w.z << 16); a[5] += cw[5] * __uint_as_float(w.z & 0xffff0000u); a[6] += cw[6] * __uint_as_float(w.w << 16); a[7] += cw[7] * __uint_as_float(w.w & 0xffff0000u); } }
    const float sc = isk ? 0.08838834764831845f : 1.f;
#pragma unroll
    for (int i = 0; i < 8; ++i) a[i] = a[i] / (1.f + __expf(-a[i])) * sc;
    v4u o; o.x = pk2(a[0], a[1]); o.y = pk2(a[2], a[3]); o.z = pk2(a[4], a[5]); o.w = pk2(a[6], a[7]);
    *(v4u*)(dst + (size_t)t * 1024 + cc) = o;
}
__global__ void __launch_bounds__(256) k_mlstm_local(Params p) {
    __shared__ __attribute__((aligned(16))) float vs[64][128];
    __shared__ __attribute__((aligned(16))) float ks[64][128];
    __shared__ float wt[64], lf[64];
    const int tid = threadIdx.x, bx = blockIdx.x, bh = bx >> 6, c = bx & 63, b = bh >> 3, h = bh & 7; const size_t row0 = (size_t)b * SEQ + c * 64;
    const float* GATES = (const float*)(p.ws + WS_GATES); const bf16* VM = (const bf16*)(p.ws + WS_VM); const bf16* KC = (const bf16*)(p.ws + WS_KC);
    float* BCUM = (float*)(p.ws + WS_BCUM); float* Gc = (float*)(p.ws + WS_G); float* MLOC = (float*)(p.ws + WS_MLOC); float* CLOC = (float*)(p.ws + WS_CLOC); float* NLOC = (float*)(p.ws + WS_NLOC);
    if (tid < 64) { const float f = GATES[(row0 + tid) * 16 + 8 + h]; lf[tid] = fminf(f, 0.f) - log1pf(expf(-fabsf(f))); }
    __syncthreads();
    if (tid == 0) { float a = 0.f; for (int l = 0; l < 64; ++l) { a += lf[l]; lf[l] = a; } }
    __syncthreads();
    if (tid < 64) { const float g = lf[63], w = g - lf[tid] + GATES[(row0 + tid) * 16 + h]; const float mx = wave_max(w); wt[tid] = expf(w - mx);
        BCUM[(size_t)bx * 64 + tid] = lf[tid]; if (tid == 0) { Gc[bx] = g; MLOC[bx] = mx; } }
    __syncthreads();
    for (int idx = tid; idx < 8192; idx += 256) { const int l = idx >> 7, d = idx & 127; vs[l][d] = bf2f(VM[(row0 + l) * 1024 + h * 128 + d]) * wt[l]; ks[l][d] = bf2f(KC[(row0 + l) * 1024 + h * 128 + d]); }
    __syncthreads();
    const int d0 = (tid >> 4) * 8, e0 = (tid & 15) * 8;
    float acc[8][8];
#pragma unroll
    for (int i = 0; i < 8; ++i)
#pragma unroll
        for (int j = 0; j < 8; ++j) acc[i][j] = 0.f;
    for (int l = 0; l < 64; ++l) { float a[8], k[8];
#pragma unroll
        for (int i = 0; i < 8; ++i) { a[i] = vs[l][d0 + i]; k[i] = ks[l][e0 + i]; }
#pragma unroll
        for (int i = 0; i < 8; ++i)
#pragma unroll
            for (int j = 0; j < 8; ++j) acc[i][j] += a[i] * k[j]; }
    float* co = CLOC + (size_t)bx * 16384;
#pragma unroll
    for (int i = 0; i < 8; ++i) { *(f32x4*)(co + (d0 + i) * 128 + e0) = (f32x4){acc[i][0], acc[i][1], acc[i][2], acc[i][3]}; *(f32x4*)(co + (d0 + i) * 128 + e0 + 4) = (f32x4){acc[i][4], acc[i][5], acc[i][6], acc[i][7]}; }
    if (tid < 128) { float n = 0.f; for (int l = 0; l < 64; ++l) n += wt[l] * ks[l][tid]; NLOC[(size_t)bx * 128 + tid] = n; }
}
__global__ void __launch_bounds__(256) k_mlstm_scan(Params p) {
    const int bh = blockIdx.x / 65, idx = (blockIdx.x % 65) * 256 + threadIdx.x; if (idx >= 16384 + 128) return;
    const float* Gc = (const float*)(p.ws + WS_G); const float* MLOC = (const float*)(p.ws + WS_MLOC); float* MPREV = (float*)(p.ws + WS_MPREV);
    float* base = idx < 16384 ? (float*)(p.ws + WS_CLOC) + (size_t)bh * 64 * 16384 + idx : (float*)(p.ws + WS_NLOC) + (size_t)bh * 64 * 128 + (idx - 16384);
    const size_t stride = idx < 16384 ? 16384 : 128;
    float m = 0.f, val = 0.f;
    for (int c = 0; c < 64; ++c) { const float g = Gc[bh * 64 + c], ml = MLOC[bh * 64 + c]; float* ptr = base + (size_t)c * stride; const float loc = *ptr; *ptr = val;
        if (idx == 0) MPREV[bh * 64 + c] = m;
        const float mn = fmaxf(g + m, ml); val = expf(g + m - mn) * val + expf(ml - mn) * loc; m = mn; }
}
constexpr int MOUT_LDS = 64 * 129 * 4 * 2 + 64 * 65 * 4 + 5 * 256;
__global__ void __launch_bounds__(256) k_mlstm_out(Params p) {
    extern __shared__ __attribute__((aligned(16))) unsigned char ldsraw[];
    float (*qs)[129] = (float (*)[129])ldsraw; float (*kv)[129] = (float (*)[129])(ldsraw + 64 * 129 * 4); float (*Sm)[65] = (float (*)[65])(ldsraw + 2 * 64 * 129 * 4);
    float* bl = (float*)(ldsraw + 2 * 64 * 129 * 4 + 64 * 65 * 4); float* il = bl + 64; float* mt = il + 64; float* inter = mt + 64; float* dn = inter + 64;
    const int tid = threadIdx.x, bx = blockIdx.x, bh = bx >> 6, c = bx & 63, b = bh >> 3, h = bh & 7; const size_t row0 = (size_t)b * SEQ + c * 64;
    const float* GATES = (const float*)(p.ws + WS_GATES); const bf16* VM = (const bf16*)(p.ws + WS_VM); const bf16* KC = (const bf16*)(p.ws + WS_KC); const bf16* QC = (const bf16*)(p.ws + WS_QC); const bf16* OM = (const bf16*)(p.ws + WS_OM);
    const float* BCUM = (const float*)(p.ws + WS_BCUM); const float* MPREV = (const float*)(p.ws + WS_MPREV); const float* CPREV = (const float*)(p.ws + WS_CLOC) + (size_t)bx * 16384; const float* NPREV = (const float*)(p.ws + WS_NLOC) + (size_t)bx * 128;
    bf16* A2 = (bf16*)(p.ws + WS_A2);
    for (int idx = tid; idx < 8192; idx += 256) { const int l = idx >> 7, e = idx & 127; qs[l][e] = bf2f(QC[(row0 + l) * 1024 + h * 128 + e]); kv[l][e] = bf2f(KC[(row0 + l) * 1024 + h * 128 + e]); }
    if (tid < 64) { bl[tid] = BCUM[(size_t)bx * 64 + tid]; il[tid] = GATES[(row0 + tid) * 16 + h]; }
    const float mprev = MPREV[bx];
    __syncthreads();
    if (tid < 64) { float mx = -INFINITY; for (int s = 0; s <= tid; ++s) mx = fmaxf(mx, bl[tid] - bl[s] + il[s]); const float mi = bl[tid] + mprev, m = fmaxf(mx, mi); mt[tid] = m; inter[tid] = expf(mi - m); }
    __syncthreads();
    const int t = tid >> 2, sq = tid & 3;
    for (int jj = 0; jj < 16; ++jj) { const int s = sq * 16 + jj; float a = 0.f; for (int e = 0; e < 128; ++e) a += qs[t][e] * kv[s][e];
        const float w = (s <= t) ? expf(bl[t] - bl[s] + il[s] - mt[t]) : 0.f; Sm[t][s] = a * w; }
    __syncthreads();
    if (tid < 64) { float d1 = 0.f; for (int s = 0; s < 64; ++s) d1 += Sm[tid][s]; float nq = 0.f; for (int e = 0; e < 128; ++e) nq += NPREV[e] * qs[tid][e];
        dn[tid] = fmaxf(fabsf(d1 + inter[tid] * nq), expf(-mt[tid])); }
    for (int idx = tid; idx < 8192; idx += 256) { const int l = idx >> 7, d = idx & 127; kv[l][d] = bf2f(VM[(row0 + l) * 1024 + h * 128 + d]); }
    __syncthreads();
    float acc[32];
#pragma unroll
    for (int i = 0; i < 32; ++i) acc[i] = 0.f;
    for (int s = 0; s < 64; ++s) { const float w = Sm[t][s];
#pragma unroll
        for (int i = 0; i < 32; ++i) acc[i] += w * kv[s][sq * 32 + i]; }
    const float it = inter[t];
    { float acc2[32];
#pragma unroll
      for (int i = 0; i < 32; ++i) acc2[i] = 0.f;
      const float* cp = CPREV + (sq * 32) * 128;
#pragma unroll 1
      for (int e = 0; e < 128; ++e) { const float qe = qs[t][e];
#pragma unroll
          for (int i = 0; i < 32; ++i) acc2[i] += cp[i * 128 + e] * qe; }
#pragma unroll
      for (int i = 0; i < 32; ++i) acc[i] += it * acc2[i]; }
    const float rd = 1.f / dn[t]; float ss = 0.f;
#pragma unroll
    for (int i = 0; i < 32; ++i) { acc[i] *= rd; ss += acc[i] * acc[i]; }
    ss += __shfl_xor(ss, 1); ss += __shfl_xor(ss, 2);
    const float rstd = rsqrtf(ss * (1.f / 128.f) + EPS);
#pragma unroll
    for (int i = 0; i < 32; i += 2) { const int d = h * 128 + sq * 32 + i;
        const float o0 = bf2f(OM[(row0 + t) * 1024 + d]), o1 = bf2f(OM[(row0 + t) * 1024 + d + 1]);
        const float y0 = acc[i] * rstd * p.mlstm_norm_g[d] / (1.f + __expf(-o0)), y1 = acc[i + 1] * rstd * p.mlstm_norm_g[d + 1] / (1.f + __expf(-o1));
        *(unsigned*)(A2 + (row0 + t) * 2048 + 1024 + d) = pk2(y0, y1); }
}
__global__ void __launch_bounds__(256) k_diff_combine(Params p) {
    const int lane = threadIdx.x & 63, gw = blockIdx.x * 4 + (threadIdx.x >> 6), row = gw >> 3, h = gw & 7;
    const float lam = expf(wave_sum(p.lam_q1[lane] * p.lam_k1[lane])) - expf(wave_sum(p.lam_q2[lane] * p.lam_k2[lane])) + 0.2f;
    const bf16* OA = (const bf16*)(p.ws + WS_OA); bf16* A2 = (bf16*)(p.ws + WS_A2);
    const unsigned w1 = *(const unsigned*)(OA + (size_t)row * 2048 + h * 256 + 2 * lane), w2 = *(const unsigned*)(OA + (size_t)row * 2048 + h * 256 + 128 + 2 * lane);
    const float v0 = __uint_as_float(w1 << 16) - lam * __uint_as_float(w2 << 16), v1 = __uint_as_float(w1 & 0xffff0000u) - lam * __uint_as_float(w2 & 0xffff0000u);
    const float rstd = rsqrtf(wave_sum(v0 * v0 + v1 * v1) * (1.f / 128.f) + EPS);
    *(unsigned*)(A2 + (size_t)row * 2048 + h * 128 + 2 * lane) = pk2(v0 * rstd * p.diff_norm_g[h * 128 + 2 * lane] * 0.8f, v1 * rstd * p.diff_norm_g[h * 128 + 2 * lane + 1] * 0.8f);
}

__global__ void __launch_bounds__(512) k_router(Params p) {
    const int lane = threadIdx.x & 63, row = blockIdx.x * 8 + (threadIdx.x >> 6);
    const float* X1 = (const float*)(p.ws + WS_X1); bf16* H2 = (bf16*)(p.ws + WS_H2);
    const GAS f32x4* xr = (const GAS f32x4*)(X1 + (size_t)row * D) + lane; const GAS f32x4* gr = (const GAS f32x4*)p.ln_ffn_g + lane;
    f32x4 v[8]; float s = 0.f;
#pragma unroll
    for (int j = 0; j < 8; ++j) { v[j] = xr[64 * j]; s += (v[j].x * v[j].x + v[j].y * v[j].y) + (v[j].z * v[j].z + v[j].w * v[j].w); }
    const float rstd = rsqrtf(wave_sum(s) * (1.f / D) + EPS);
    GAS unsigned long long* o8 = (GAS unsigned long long*)(H2 + (size_t)row * D) + lane;
#pragma unroll
    for (int j = 0; j < 8; ++j) { const f32x4 gv = gr[64 * j]; v[j].x *= rstd * gv.x; v[j].y *= rstd * gv.y; v[j].z *= rstd * gv.z; v[j].w *= rstd * gv.w;
        o8[64 * j] = (unsigned long long)pk2(v[j].x, v[j].y) | ((unsigned long long)pk2(v[j].z, v[j].w) << 32); }
    float ag[4] = {0.f, 0.f, 0.f, 0.f}; float ar[4][8];
#pragma unroll
    for (int g = 0; g < 4; ++g)
#pragma unroll
        for (int e = 0; e < 8; ++e) ar[g][e] = 0.f;
#pragma unroll
    for (int j = 0; j < 8; ++j)
#pragma unroll
        for (int q = 0; q < 4; ++q) { const int k = 256 * j + 4 * lane + q; const float hv = v[j][q];
            const f32x4 wg = *(const f32x4*)(p.w_group + (size_t)k * 4); ag[0] += hv * wg.x; ag[1] += hv * wg.y; ag[2] += hv * wg.z; ag[3] += hv * wg.w;
#pragma unroll
            for (int g = 0; g < 4; ++g) { const f32x4 w0 = *(const f32x4*)(p.w_router + ((size_t)g * D + k) * 8), w1 = *(const f32x4*)(p.w_router + ((size_t)g * D + k) * 8 + 4);
                ar[g][0] += hv * w0.x; ar[g][1] += hv * w0.y; ar[g][2] += hv * w0.z; ar[g][3] += hv * w0.w; ar[g][4] += hv * w1.x; ar[g][5] += hv * w1.y; ar[g][6] += hv * w1.z; ar[g][7] += hv * w1.w; } }
#pragma unroll
    for (int g = 0; g < 4; ++g) { ag[g] = wave_sum(ag[g]) + p.b_group[g];
#pragma unroll
        for (int e = 0; e < 8; ++e) ar[g][e] = wave_sum(ar[g][e]) + p.b_router[g * 8 + e]; }
    int gs = 0; float gm = ag[0];
#pragma unroll
    for (int g = 1; g < 4; ++g) if (ag[g] > gm) { gm = ag[g]; gs = g; }
    float se = 0.f;
#pragma unroll
    for (int g = 0; g < 4; ++g) se += expf(ag[g] - gm);
    const float gw = 1.f / se;
    float el[8];
#pragma unroll
    for (int e = 0; e < 8; ++e) el[e] = gs == 0 ? ar[0][e] : gs == 1 ? ar[1][e] : gs == 2 ? ar[2][e] : ar[3][e];
    int i0 = 0; float v0 = el[0];
#pragma unroll
    for (int e = 1; e < 8; ++e) if (el[e] > v0) { v0 = el[e]; i0 = e; }
    int i1 = -1; float v1 = -INFINITY;
#pragma unroll
    for (int e = 0; e < 8; ++e) if (e != i0 && el[e] > v1) { v1 = el[e]; i1 = e; }
    const float w0 = 1.f / (1.f + expf(v1 - v0)), w1 = 1.f - w0;
    if (lane == 0) {
        unsigned* cnt = (unsigned*)(p.ws + WS_CTL) + CW_CNT; int* LIST = (int*)(p.ws + WS_LIST); float* LISTW = (float*)(p.ws + WS_LISTW);
        const int e0 = gs * 8 + i0, e1 = gs * 8 + i1;
        const unsigned p0 = atomicAdd(cnt + e0, 1u); LIST[e0 * 8192 + p0] = row * 2; LISTW[e0 * 8192 + p0] = gw * w0;
        const unsigned p1 = atomicAdd(cnt + e1, 1u); LIST[e1 * 8192 + p1] = row * 2 + 1; LISTW[e1 * 8192 + p1] = gw * w1;
    }
}
__global__ void __launch_bounds__(512) k_sortcopy(Params p) {
    __shared__ int s_cnt[32], s_rowbase[33], s_tilebase[33];
    const int tid = threadIdx.x, lane = tid & 63, wave = tid >> 6;
    const unsigned* cnt = (const unsigned*)(p.ws + WS_CTL) + CW_CNT;
    if (tid == 0) { int rb = 0, tb = 0; for (int e = 0; e < 32; ++e) { const int n = (int)cnt[e]; s_cnt[e] = n; s_rowbase[e] = rb; s_tilebase[e] = tb; const int nt = (n + 255) >> 8; rb += nt * 256; tb += nt; } s_rowbase[32] = rb; s_tilebase[32] = tb; }
    __syncthreads();
    const int MT = s_tilebase[32]; int* TAB = (int*)(p.ws + WS_TAB);
    if (blockIdx.x == 0) { if (tid == 0) TAB[0] = MT; if (tid < MT) { int e = 0; while (e < 31 && s_tilebase[e + 1] <= tid) ++e; TAB[1 + tid] = e; } }
    const int* LIST = (const int*)(p.ws + WS_LIST); const float* LISTW = (const float*)(p.ws + WS_LISTW); int* ROWTOK = (int*)(p.ws + WS_ROWTOK); float* ROWW = (float*)(p.ws + WS_ROWW);
    const bf16* H2 = (const bf16*)(p.ws + WS_H2); bf16* HS = (bf16*)(p.ws + WS_HS);
    for (int r = blockIdx.x * 8 + wave; r < MT * 256; r += gridDim.x * 8) {
        int e = 0; while (e < 31 && s_rowbase[e + 1] <= r) ++e;
        const int i = r - s_rowbase[e]; const bool valid = i < s_cnt[e];
        int ts = -1; float w = 0.f; if (valid) { ts = LIST[e * 8192 + i]; w = LISTW[e * 8192 + i]; }
        GAS v4u* dst = (GAS v4u*)(HS + (size_t)r * D) + lane;
        if (valid) { const GAS v4u* src = (const GAS v4u*)(H2 + (size_t)(ts >> 1) * D) + lane;
#pragma unroll
            for (int j = 0; j < 4; ++j) dst[64 * j] = src[64 * j]; }
        else { const v4u z = {0u, 0u, 0u, 0u};
#pragma unroll
            for (int j = 0; j < 4; ++j) dst[64 * j] = z; }
        if (lane == 0) { ROWTOK[r] = ts; ROWW[r] = w; }
    }
}
__global__ void __launch_bounds__(512) k_final(Params p) {
    const int lane = threadIdx.x & 63, row = blockIdx.x * 8 + (threadIdx.x >> 6);
    const GAS f32x4* xr = (const GAS f32x4*)((const float*)(p.ws + WS_X1) + (size_t)row * D) + lane; const GAS f32x4* gr = (const GAS f32x4*)p.ln_f_g + lane;
    const GAS unsigned long long* y0 = (const GAS unsigned long long*)((const bf16*)(p.ws + WS_Y0) + (size_t)row * D) + lane; const GAS unsigned long long* y1 = (const GAS unsigned long long*)((const bf16*)(p.ws + WS_Y1) + (size_t)row * D) + lane;
    f32x4 v[8]; float s = 0.f;
#pragma unroll
    for (int j = 0; j < 8; ++j) { v[j] = xr[64 * j]; const unsigned long long a = y0[64 * j], b = y1[64 * j];
        v[j].x += __uint_as_float((unsigned)a << 16) + __uint_as_float((unsigned)b << 16); v[j].y += __uint_as_float((unsigned)a & 0xffff0000u) + __uint_as_float((unsigned)b & 0xffff0000u);
        v[j].z += __uint_as_float((unsigned)(a >> 32) << 16) + __uint_as_float((unsigned)(b >> 32) << 16); v[j].w += __uint_as_float((unsigned)(a >> 32) & 0xffff0000u) + __uint_as_float((unsigned)(b >> 32) & 0xffff0000u);
        s += (v[j].x * v[j].x + v[j].y * v[j].y) + (v[j].z * v[j].z + v[j].w * v[j].w); }
    const float rstd = rsqrtf(wave_sum(s) * (1.f / D) + EPS);
    GAS f32x4* o = (GAS f32x4*)(p.out + (size_t)row * D) + lane;
#pragma unroll
    for (int j = 0; j < 8; ++j) { const f32x4 gv = gr[64 * j]; o[64 * j] = (f32x4){v[j].x * rstd * gv.x, v[j].y * rstd * gv.y, v[j].z * rstd * gv.z, v[j].w * rstd * gv.w}; }
}

constexpr int GEMM_LDS = 147456;
extern "C" void kernel_launch(void* const* d_in, const int* in_sizes, int n_in, void* d_out, int out_size, void* d_ws, size_t ws_size, hipStream_t stream) {
    static int ready = 0;
    if (ready == 0) {
        if (n_in != 24 || in_sizes[0] != T * D || out_size != T * D || ws_size < WS_END) { fprintf(stderr, "kernel_launch: unexpected shapes (n_in %d, in0 %d, out %d, ws %zu)\n", n_in, n_in > 0 ? in_sizes[0] : -1, out_size, ws_size); ready = -1; return; }
        hipFuncSetAttribute((const void*)k_prologue, hipFuncAttributeMaxDynamicSharedMemorySize, GEMM_LDS);
        hipFuncSetAttribute((const void*)k_gemm_inproj, hipFuncAttributeMaxDynamicSharedMemorySize, GEMM_LDS);
        hipFuncSetAttribute((const void*)k_gemm_outproj, hipFuncAttributeMaxDynamicSharedMemorySize, GEMM_LDS);
        hipFuncSetAttribute((const void*)k_gemm_gu, hipFuncAttributeMaxDynamicSharedMemorySize, GEMM_LDS);
        hipFuncSetAttribute((const void*)k_gemm_down, hipFuncAttributeMaxDynamicSharedMemorySize, GEMM_LDS);
        hipFuncSetAttribute((const void*)k_mlstm_out, hipFuncAttributeMaxDynamicSharedMemorySize, MOUT_LDS);
        (void)hipGetLastError();
        ready = 1;
    }
    if (ready < 0) return;
    hipMemsetAsync((char*)d_ws + WS_CTL, 0, CTL_ZERO_BYTES, stream);
    Params p{};
    const float** pf = (const float**)&p;
    for (int i = 0; i < 24; ++i) pf[i] = (const float*)d_in[i];
    p.out = (float*)d_out; p.ws = (unsigned char*)d_ws;
    hipLaunchKernelGGL(k_prologue, dim3(256), dim3(512), GEMM_LDS, stream, p);
    hipLaunchKernelGGL(k_gemm_inproj, dim3(256), dim3(512), GEMM_LDS, stream, p);
    hipLaunchKernelGGL(k_attn_naive, dim3(2 * 8 * 2 * 2 * 64), dim3(64), 0, stream, p);
    hipLaunchKernelGGL(k_conv, dim3(T), dim3(256), 0, stream, p);
    hipLaunchKernelGGL(k_mlstm_local, dim3(1024), dim3(256), 0, stream, p);
    hipLaunchKernelGGL(k_mlstm_scan, dim3(16 * 65), dim3(256), 0, stream, p);
    hipLaunchKernelGGL(k_mlstm_out, dim3(1024), dim3(256), MOUT_LDS, stream, p);
    hipLaunchKernelGGL(k_diff_combine, dim3(T * NH / 4), dim3(256), 0, stream, p);
    hipLaunchKernelGGL(k_gemm_outproj, dim3(256), dim3(512), GEMM_LDS, stream, p);
    hipLaunchKernelGGL(k_router, dim3(T / 8), dim3(512), 0, stream, p);
    hipLaunchKernelGGL(k_sortcopy, dim3(256), dim3(512), 0, stream, p);
    hipLaunchKernelGGL(k_gemm_gu, dim3(256), dim3(512), GEMM_LDS, stream, p);
    hipLaunchKernelGGL(k_gemm_down, dim3(256), dim3(512), GEMM_LDS, stream, p);
    hipLaunchKernelGGL(k_final, dim3(T / 8), dim3(512), 0, stream, p);
}
```

```cpp
#include <hip/hip_runtime.h>
#include <cstdio>
#include <cstdint>
#include <cmath>
namespace pg8 {
#define PG8_LAS __attribute__((address_space(3)))
typedef unsigned short bf16_t;
typedef short bf16x8 __attribute__((ext_vector_type(8)));
typedef float f32x4 __attribute__((ext_vector_type(4)));
typedef unsigned u32x4 __attribute__((ext_vector_type(4)));
constexpr int BM = 256, BK = 64, HALF = 128, HTB = HALF * BK * 2  , STAGE_BYTES = 8 * HTB, NXCD = 8, WGM = 8;

__host__ __device__ __forceinline__ int lds_byte(int r, int c) { const int st = (r >> 4) * 2 + (c >> 5), rr = r & 15, cc = c & 31, ob = rr * 64 + cc * 2; return st * 1024 + (ob ^ (((ob >> 9) & 1) << 5)); }
__host__ __device__ __forceinline__ void stage_rc(int b, int& R, int& C) { const int st = b / 1024, sb = b % 1024, swz = sb ^ (((sb >> 9) & 1) << 5); R = (st >> 1) * 16 + swz / 64; C = (st & 1) * 32 + (swz % 64) / 2; }
__host__ __device__ __forceinline__ int perm32(int rho) { const int n = rho >> 4, i = rho & 15; return 8 * (i >> 2) + 4 * n + (i & 3); }

struct Unit { int pm, pn; };
struct Gemm { const bf16_t* A; const bf16_t* Bt; int M, N, K; };

struct StaticOrder {
    int nM, nN, nwg, G, c;
    __host__ __device__ void init(int M, int N, int G_, int c_) { nM = M / BM; nN = N / BM; nwg = nM * nN; G = G_; c = c_; }
    __host__ __device__ bool next(int i, Unit& u) const {
        const long L = (long)i * G + c; if (L >= nwg) return false;
        int wgid = (int)L; { const int q = nwg / NXCD, r = nwg % NXCD, xcd = wgid % NXCD, off = wgid / NXCD; wgid = (xcd < r ? xcd * (q + 1) : r * (q + 1) + (xcd - r) * q) + off; }
        const int nig = WGM * nN, gid = wgid / nig, fm = gid * WGM, gsz = (nM - fm) < WGM ? (nM - fm) : WGM;
        u.pm = fm + ((wgid % nig) % gsz); u.pn = (wgid % nig) / gsz; return true;
    }
    __device__ __forceinline__ void a_ready(const Unit&) const {}
    __device__ __forceinline__ void done(const Unit&) const {}
};

__device__ __forceinline__ unsigned cvt_pk_bf16(float lo, float hi) { unsigned r; asm volatile("v_cvt_pk_bf16_f32 %0, %1, %2" : "=v"(r) : "v"(lo), "v"(hi)); return r; }
typedef float f32x2 __attribute__((ext_vector_type(2)));
constexpr int kT = 8192;
struct MoeSched {
    const int* tab; int nN, G, c;
    __device__ __forceinline__ bool next(int i, Unit& u) const {
        const int MT = tab[0]; const long L = (long)i * G + c; if (L >= (long)MT * nN) return false;
        const int mt = (int)(L / nN), pn = (int)(L % nN); u.pm = mt; u.pn = tab[1 + mt] * nN + pn; return true;
    }
    __device__ __forceinline__ void a_ready(const Unit&) const {}
    __device__ __forceinline__ void done(const Unit&) const {}
};
__device__ __forceinline__ u32x4 pack8(const f32x4 v0, const f32x4 v1) { u32x4 w; w.x = cvt_pk_bf16(v0[0], v0[1]); w.y = cvt_pk_bf16(v0[2], v0[3]); w.z = cvt_pk_bf16(v1[0], v1[1]); w.w = cvt_pk_bf16(v1[2], v1[3]); return w; }
struct EpiInProj {
    static constexpr bool PERM = true, AFTER_DRAIN = false;
    bf16_t* seg; float* gates;
    __device__ __forceinline__ void operator()(const f32x4 (&acc)[2][2][4][2], const Unit& u, int wr, int wc, int fr, int fq) const {
        const int row0 = u.pm * BM + wr * 64 + fr;
        if (u.pn < 28) {
            const int s = u.pn >> 2; bf16_t* base = seg + (size_t)s * ((size_t)kT * 1024);
            const int col0 = (u.pn & 3) * BM + wc * 32 + 8 * fq;
#pragma unroll
            for (int ai = 0; ai < 2; ++ai)
#pragma unroll
                for (int m = 0; m < 4; ++m) { bf16_t* rowp = base + (size_t)(row0 + ai * HALF + m * 16) * 1024 + col0;
#pragma unroll
                    for (int bj = 0; bj < 2; ++bj) *(u32x4*)(rowp + bj * HALF) = pack8(acc[ai][bj][m][0], acc[ai][bj][m][1]); }
        } else if (wc == 0 && fq < 2) {
            float* gp = gates + (size_t)row0 * 16 + 8 * fq;
#pragma unroll
            for (int ai = 0; ai < 2; ++ai)
#pragma unroll
                for (int m = 0; m < 4; ++m) { *(f32x4*)(gp + (size_t)(ai * HALF + m * 16) * 16) = acc[ai][0][m][0]; *(f32x4*)(gp + (size_t)(ai * HALF + m * 16) * 16 + 4) = acc[ai][0][m][1]; }
        }
    }
};
struct EpiOutProj {
    static constexpr bool PERM = false, AFTER_DRAIN = false;
    const float* x; float* x1;
    __device__ __forceinline__ void operator()(const f32x4 (&acc)[2][2][4][2], const Unit& u, int wr, int wc, int fr, int fq) const {
        const int col0 = u.pn * BM + wc * 32 + 4 * fq;
#pragma unroll
        for (int ai = 0; ai < 2; ++ai)
#pragma unroll
            for (int m = 0; m < 4; ++m) { const size_t off = (size_t)(u.pm * BM + ai * HALF + wr * 64 + m * 16 + fr) * 2048 + col0;
#pragma unroll
                for (int bj = 0; bj < 2; ++bj)
#pragma unroll
                    for (int n = 0; n < 2; ++n) { const f32x4 o = acc[ai][bj][m][n] + *(const f32x4*)(x + off + bj * HALF + n * 16); *(f32x4*)(x1 + off + bj * HALF + n * 16) = o; } }
    }
};
__device__ __forceinline__ float silu_f(float g) { return g / (1.f + __expf(-g)); }
struct EpiGU {
    static constexpr bool PERM = true, AFTER_DRAIN = false;
    bf16_t* hid; const float* roww;
    __device__ __forceinline__ void operator()(const f32x4 (&acc)[2][2][4][2], const Unit& u, int wr, int wc, int fr, int fq) const {
        const int pnl = u.pn & 3, row0 = u.pm * BM + wr * 64 + fr, col0 = pnl * 128 + wc * 32 + 8 * fq;
#pragma unroll
        for (int ai = 0; ai < 2; ++ai)
#pragma unroll
            for (int m = 0; m < 4; ++m) { const int r = row0 + ai * HALF + m * 16; const float w = roww[r]; f32x4 h0, h1;
#pragma unroll
                for (int i = 0; i < 4; ++i) { h0[i] = silu_f(acc[ai][0][m][0][i]) * acc[ai][1][m][0][i] * w; h1[i] = silu_f(acc[ai][0][m][1][i]) * acc[ai][1][m][1][i] * w; }
                *(u32x4*)(hid + (size_t)r * 512 + col0) = pack8(h0, h1); }
    }
};
struct EpiDown {
    static constexpr bool PERM = true, AFTER_DRAIN = false;
    bf16_t* y; const int* rowtok; size_t slot_stride;
    __device__ __forceinline__ void operator()(const f32x4 (&acc)[2][2][4][2], const Unit& u, int wr, int wc, int fr, int fq) const {
        const int pnl = u.pn & 7, row0 = u.pm * BM + wr * 64 + fr, col0 = pnl * BM + wc * 32 + 8 * fq;
#pragma unroll
        for (int ai = 0; ai < 2; ++ai)
#pragma unroll
            for (int m = 0; m < 4; ++m) { const int r = row0 + ai * HALF + m * 16; const int ts = rowtok[r];
                if (ts >= 0) { bf16_t* dst = y + (size_t)(ts & 1) * slot_stride + (size_t)(ts >> 1) * 2048 + col0;
#pragma unroll
                    for (int bj = 0; bj < 2; ++bj) *(u32x4*)(dst + bj * HALF) = pack8(acc[ai][bj][m][0], acc[ai][bj][m][1]); } }
    }
};
template <class Epi, class Sched, bool ALIGN_EPI = false, bool SP2 = false>
__device__ __forceinline__ void gemm_phase(PG8_LAS unsigned char* lds, const Gemm g, const Sched& S, const Epi& E) {
    const int tid = threadIdx.x, wid = __builtin_amdgcn_readfirstlane(tid >> 6), lane = tid & 63, wr = wid >> 2, wc = wid & 3, fr = lane & 15, fq = lane >> 4;
    const int K = g.K, nt = K / BK;
    unsigned voffA[2], voffB[2];
#pragma unroll
    for (int i = 0; i < 2; ++i) { int R, C; stage_rc(tid * 16 + i * 8192, R, C); const int Rb = Epi::PERM ? ((R & ~31) + perm32(R & 31)) : R;
        voffA[i] = (unsigned)(R * K + C) * 2u; voffB[i] = (unsigned)(Rb * K + C) * 2u; }
    const size_t kstep = (size_t)(BK * 2);
    const size_t hstep = (size_t)HALF * K * 2;
    const size_t tstep = 2 * hstep;
    const unsigned ldsw = (unsigned)wid * 1024u;
    const int aoff = lds_byte(wr * 64 + fr, fq * 8), boff = lds_byte(wc * 32 + fr, fq * 8);
#define PG8_SA(b, h) (((b) * 2 + (h)) * HTB)
#define PG8_SB(b, h) ((4 + (b) * 2 + (h)) * HTB)
#define PG8_STAGE(bufoff, gbase, voff) do { _Pragma("unroll") for (int _i = 0; _i < 2; ++_i) \
        __builtin_amdgcn_global_load_lds((const unsigned*)((const char*)(gbase) + (voff)[_i]), (PG8_LAS unsigned*)(lds + (bufoff) + ldsw + _i * 8192), 16, 0, 0); } while (0)
#define PG8_LDA(dst, b, h) do { _Pragma("unroll") for (int m = 0; m < 4; ++m) _Pragma("unroll") for (int k = 0; k < 2; ++k) dst[m][k] = *(const PG8_LAS bf16x8*)(lds + PG8_SA(b, h) + aoff + m * 2048 + k * 1024); } while (0)
#define PG8_LDB(dst, b, h) do { _Pragma("unroll") for (int n = 0; n < 2; ++n) _Pragma("unroll") for (int k = 0; k < 2; ++k) dst[n][k] = *(const PG8_LAS bf16x8*)(lds + PG8_SB(b, h) + boff + n * 2048 + k * 1024); } while (0)
#define PG8_MMA(ai, bj, At, Bt) do { __builtin_amdgcn_s_setprio(1); _Pragma("unroll") for (int m = 0; m < 4; ++m) _Pragma("unroll") for (int n = 0; n < 2; ++n) _Pragma("unroll") for (int k = 0; k < 2; ++k) \
        acc[ai][bj][m][n] = __builtin_amdgcn_mfma_f32_16x16x32_bf16(Bt[n][k], At[m][k], acc[ai][bj][m][n], 0, 0, 0); __builtin_amdgcn_s_setprio(0); } while (0)
#define PG8_WAIT_V(n) asm volatile("s_waitcnt vmcnt(" #n ")" ::: "memory")
#define PG8_WAIT_L(n) asm volatile("s_waitcnt lgkmcnt(" #n ")" ::: "memory")
#define PG8_BAR __builtin_amdgcn_s_barrier()
#define PG8_SCHED __builtin_amdgcn_sched_barrier(0)
    Unit cur, nxt; int ui = 0;
    if (!S.next(0, cur)) return;
    f32x4 acc[2][2][4][2];
#pragma unroll
    for (int a = 0; a < 2; ++a)
#pragma unroll
        for (int b = 0; b < 2; ++b)
#pragma unroll
            for (int m = 0; m < 4; ++m)
#pragma unroll
                for (int n = 0; n < 2; ++n) acc[a][b][m][n] = (f32x4){0.f, 0.f, 0.f, 0.f};
    bf16x8 At[4][2], B0[2][2], B1[2][2];
    const char* cA = (const char*)g.A + (size_t)cur.pm * tstep; const char* cB = (const char*)g.Bt + (size_t)cur.pn * tstep;
    S.a_ready(cur);
    if constexpr (SP2) {
        PG8_STAGE(PG8_SB(0, 0), cB, voffB); PG8_STAGE(PG8_SB(0, 1), cB + hstep, voffB); PG8_STAGE(PG8_SA(0, 0), cA, voffA); PG8_STAGE(PG8_SA(0, 1), cA + hstep, voffA);
        if (wr == 1) PG8_BAR;
        PG8_WAIT_V(2); PG8_BAR;
        PG8_STAGE(PG8_SB(1, 0), cB + kstep, voffB); PG8_STAGE(PG8_SA(1, 0), cA + kstep, voffA); PG8_STAGE(PG8_SB(1, 1), cB + hstep + kstep, voffB);
        PG8_WAIT_V(6); PG8_BAR;
    } else {
        PG8_STAGE(PG8_SB(0, 0), cB, voffB); PG8_STAGE(PG8_SA(0, 0), cA, voffA); PG8_STAGE(PG8_SB(0, 1), cB + hstep, voffB); PG8_STAGE(PG8_SA(0, 1), cA + hstep, voffA);
        if (wr == 1) PG8_BAR;
        PG8_WAIT_V(4); PG8_BAR;
        PG8_STAGE(PG8_SB(1, 0), cB + kstep, voffB); PG8_STAGE(PG8_SA(1, 0), cA + kstep, voffA); PG8_STAGE(PG8_SB(1, 1), cB + hstep + kstep, voffB);
        PG8_WAIT_V(6); PG8_BAR;
    }
    for (;;) {
        const bool has_next = S.next(ui + 1, nxt);
        const char* nA = has_next ? (const char*)g.A + (size_t)nxt.pm * tstep : cA; const char* nB = has_next ? (const char*)g.Bt + (size_t)nxt.pn * tstep : cB;
        for (int t = 0; t < nt; t += 2) {
            const bool last = (t == nt - 2);
            const char* a1 = cA + (size_t)(t + 1) * kstep;
            const char* a2 = last ? nA : cA + (size_t)(t + 2) * kstep; const char* b2 = last ? nB : cB + (size_t)(t + 2) * kstep;
            const char* a3 = a2 + kstep; const char* b3 = b2 + kstep;
            if (last && has_next) S.a_ready(nxt);
            if constexpr (SP2) {
            PG8_LDB(B0, 0, 0); PG8_LDB(B1, 0, 1); PG8_SCHED; PG8_LDA(At, 0, 0); PG8_STAGE(PG8_SA(1, 1), a1 + hstep, voffA);
            PG8_WAIT_V(8); PG8_WAIT_L(0); PG8_BAR; PG8_MMA(0, 0, At, B0); PG8_MMA(0, 1, At, B1); PG8_BAR; PG8_SCHED;
            PG8_LDA(At, 0, 1); PG8_STAGE(PG8_SB(0, 0), b2, voffB); PG8_STAGE(PG8_SB(0, 1), b2 + hstep, voffB); PG8_STAGE(PG8_SA(0, 0), a2, voffA);
            PG8_WAIT_V(8); PG8_WAIT_L(0); PG8_BAR; PG8_MMA(1, 0, At, B0); PG8_MMA(1, 1, At, B1); PG8_BAR; PG8_SCHED;
            PG8_LDB(B0, 1, 0); PG8_LDB(B1, 1, 1); PG8_SCHED; PG8_LDA(At, 1, 0); PG8_STAGE(PG8_SA(0, 1), a2 + hstep, voffA);
            PG8_WAIT_V(8); PG8_WAIT_L(0); PG8_BAR; PG8_MMA(0, 0, At, B0); PG8_MMA(0, 1, At, B1); PG8_BAR; PG8_SCHED;
            PG8_LDA(At, 1, 1); PG8_STAGE(PG8_SB(1, 0), b3, voffB); PG8_STAGE(PG8_SB(1, 1), b3 + hstep, voffB); PG8_STAGE(PG8_SA(1, 0), a3, voffA);
            PG8_WAIT_V(8); PG8_WAIT_L(0); PG8_BAR; PG8_MMA(1, 0, At, B0); PG8_MMA(1, 1, At, B1); PG8_BAR; PG8_SCHED;
            } else {
            PG8_LDB(B0, 0, 0); PG8_SCHED; PG8_LDA(At, 0, 0); PG8_STAGE(PG8_SA(1, 1), a1 + hstep, voffA);
            PG8_WAIT_L(8); PG8_BAR; PG8_WAIT_L(0); PG8_MMA(0, 0, At, B0); PG8_BAR; PG8_SCHED;
            PG8_LDB(B1, 0, 1); PG8_STAGE(PG8_SB(0, 0), b2, voffB);
            PG8_BAR; PG8_WAIT_L(0); PG8_MMA(0, 1, At, B1); PG8_BAR;
            PG8_LDA(At, 0, 1); PG8_STAGE(PG8_SA(0, 0), a2, voffA);
            PG8_BAR; PG8_WAIT_L(0); PG8_MMA(1, 0, At, B0); PG8_BAR; PG8_SCHED;
            PG8_STAGE(PG8_SB(0, 1), b2 + hstep, voffB);
            PG8_WAIT_V(6); PG8_BAR; PG8_MMA(1, 1, At, B1); PG8_BAR;
            PG8_LDB(B0, 1, 0); PG8_SCHED; PG8_LDA(At, 1, 0); PG8_STAGE(PG8_SA(0, 1), a2 + hstep, voffA);
            PG8_WAIT_L(8); PG8_BAR; PG8_WAIT_L(0); PG8_MMA(0, 0, At, B0); PG8_BAR; PG8_SCHED;
            PG8_LDB(B1, 1, 1); PG8_STAGE(PG8_SB(1, 0), b3, voffB);
            PG8_BAR; PG8_WAIT_L(0); PG8_MMA(0, 1, At, B1); PG8_BAR;
            PG8_LDA(At, 1, 1); PG8_STAGE(PG8_SA(1, 0), a3, voffA);
            PG8_BAR; PG8_WAIT_L(0); PG8_MMA(1, 0, At, B0); PG8_BAR; PG8_SCHED;
            PG8_STAGE(PG8_SB(1, 1), b3 + hstep, voffB);
            PG8_WAIT_V(6); PG8_BAR; PG8_MMA(1, 1, At, B1); PG8_BAR;
            }
        }
        if constexpr (ALIGN_EPI) { if (wr == 0) PG8_BAR; }
        if constexpr (!Epi::AFTER_DRAIN) { E(acc, cur, wr, wc, fr, fq); S.done(cur); }
        if (!has_next) break;
#pragma unroll
        for (int a = 0; a < 2; ++a)
#pragma unroll
            for (int b = 0; b < 2; ++b)
#pragma unroll
                for (int m = 0; m < 4; ++m)
#pragma unroll
                    for (int n = 0; n < 2; ++n) acc[a][b][m][n] = (f32x4){0.f, 0.f, 0.f, 0.f};
        cur = nxt; cA = nA; cB = nB; ++ui;
        if constexpr (ALIGN_EPI) { if (wr == 1) PG8_BAR; }
    }
    PG8_WAIT_V(0);
    if constexpr (!ALIGN_EPI) { if (wr == 0) PG8_BAR; }
    PG8_BAR;
    if constexpr (Epi::AFTER_DRAIN) { E.fused(acc, cur, wr, wc, fr, fq, lds, wid, lane); S.done(cur); }
#undef PG8_SA
#undef PG8_SB
#undef PG8_STAGE
#undef PG8_LDA
#undef PG8_LDB
#undef PG8_MMA
#undef PG8_WAIT_V
#undef PG8_WAIT_L
#undef PG8_BAR
#undef PG8_SCHED
}
}
#define GAS __attribute__((address_space(1)))
#define LAS __attribute__((address_space(3)))
typedef unsigned short bf16;
typedef unsigned v4u __attribute__((ext_vector_type(4)));
typedef float f32x4 __attribute__((ext_vector_type(4)));
typedef short bf16x8 __attribute__((ext_vector_type(8)));
typedef GAS unsigned gu32;
typedef GAS unsigned long long gu64;
#define RLX_AGENT __ATOMIC_RELAXED, __HIP_MEMORY_SCOPE_AGENT
#define LDS_WAIT() asm volatile("s_waitcnt lgkmcnt(0)" ::: "memory")
#define VM_WAIT() asm volatile("s_waitcnt vmcnt(0)" ::: "memory")
__device__ __forceinline__ unsigned long long rt() { return __builtin_amdgcn_s_memrealtime(); }
__device__ __forceinline__ unsigned f2bf(float f) { unsigned u = __builtin_bit_cast(unsigned, f); return (u + 0x7fffu + ((u >> 16) & 1u)) >> 16; }
__device__ __forceinline__ unsigned pk2(float lo, float hi) { return f2bf(lo) | (f2bf(hi) << 16); }

#define XB_TMO      128
#define XB_XCNT(j)  (256  + 64 * (j))
#define XB_XSUB(j)  (1280 + 64 * (j))
#define XB_XGEN(j)  (2304 + 64 * (j))
#define XB_TOP      3328
#define XB_TOPGEN   3392
#define XCD_BAR_WORDS 3456
#define XB_SPIN_CAP (1u << 18)

__device__ __forceinline__ unsigned xb_ld(unsigned* p)              { return __hip_atomic_load(p, __ATOMIC_RELAXED, __HIP_MEMORY_SCOPE_AGENT); }
__device__ __forceinline__ unsigned xb_add(unsigned* p, unsigned v) { return __hip_atomic_fetch_add(p, v, __ATOMIC_RELAXED, __HIP_MEMORY_SCOPE_AGENT); }
__device__ __forceinline__ unsigned xb_xcc_id() { return (unsigned)__builtin_amdgcn_s_getreg((3 << 11) | 20) & 0xFu; }
#define XB_SPIN(cond, bar) do { unsigned _sp = 0; while (cond) { __builtin_amdgcn_s_sleep(1); \
    if ((++_sp & 255u) == 0u) { if (xb_ld(&(bar)[XB_TMO])) break; if (_sp > XB_SPIN_CAP) { atomicAdd(&(bar)[XB_TMO], 1u); break; } } } } while (0)

struct XcdBarrier {
    unsigned* bar; unsigned x;
    volatile LAS unsigned* st;
};

__device__ __forceinline__ XcdBarrier xcd_barrier_post(unsigned* bar, volatile LAS unsigned* st) {
    XcdBarrier b; b.bar = bar; b.x = xb_xcc_id(); b.st = st;
    if (threadIdx.x == 0) (void)xb_add(&bar[XB_XCNT(b.x)], 1u);
    return b;
}
__device__ __forceinline__ void xcd_barrier_complete(unsigned* bar, unsigned x, unsigned& nloc, unsigned& nx) {
    const unsigned G = gridDim.x * gridDim.y * gridDim.z;
    unsigned sum, cnt, mine, sp = 0u;
    for (;;) {
        sum = 0u; cnt = 0u; mine = 0u;
#pragma unroll
        for (unsigned j = 0; j < 16; ++j) { const unsigned c = xb_ld(&bar[XB_XCNT(j)]); sum += c; cnt += (c > 0u) ? 1u : 0u; mine = (j == x) ? c : mine; }
        if (sum == G) break;
        __builtin_amdgcn_s_sleep(1);
        if ((++sp & 255u) == 0u) { if (xb_ld(&bar[XB_TMO])) break; if (sp > XB_SPIN_CAP) { atomicAdd(&bar[XB_TMO], 1u); break; } }
    }
    nloc = mine > 0u ? mine : 1u; nx = cnt > 0u ? cnt : 1u;
}

__device__ __forceinline__ void xcd_barrier(const XcdBarrier& b) {
    asm volatile("s_waitcnt vmcnt(0)" ::: "memory");
    __syncthreads();
    if (threadIdx.x == 0) {
        unsigned* bar = b.bar;
        __builtin_amdgcn_s_waitcnt(0);
        unsigned nloc = b.st[0], nx = b.st[1];
        if (nloc == 0u) { xcd_barrier_complete(bar, b.x, nloc, nx); b.st[0] = nloc; b.st[1] = nx; }
        const unsigned old = xb_add(&bar[XB_XSUB(b.x)], 1u);
        const unsigned gen = old / nloc;
        if (old + 1u == (gen + 1u) * nloc) {
            __builtin_amdgcn_fence(__ATOMIC_RELEASE, "agent");
            asm volatile("s_waitcnt vmcnt(0)" ::: "memory");
            const unsigned og = xb_add(&bar[XB_TOP], 1u);
            const unsigned tg = og / nx;
            if (og + 1u == (tg + 1u) * nx) xb_add(&bar[XB_TOPGEN], 1u);
            else XB_SPIN(xb_ld(&bar[XB_TOPGEN]) == tg, bar);
            __builtin_amdgcn_fence(__ATOMIC_ACQUIRE, "agent");
            xb_add(&bar[XB_XGEN(b.x)], 1u);
            asm volatile("s_waitcnt vmcnt(0)" ::: "memory");
        } else {
            XB_SPIN(xb_ld(&bar[XB_XGEN(b.x)]) == gen, bar);
            __builtin_amdgcn_fence(__ATOMIC_ACQUIRE, "agent");
            asm volatile("s_waitcnt vmcnt(0)" ::: "memory");
        }
    }
    __syncthreads();
}
#include <hip/hip_bf16.h>
#include <cmath>
namespace attn_body {
using bf16=__hip_bfloat16;
using bf16x8=__attribute__((ext_vector_type(8)))short;
using s16x4=__attribute__((ext_vector_type(4)))short;
using f32x16=__attribute__((ext_vector_type(16)))float;
using u32x4=__attribute__((ext_vector_type(4)))unsigned;
constexpr int BATCH=2,SEQ=4096,D=64,DM=1024,OP=2048;
constexpr int NW=8,QBLK=32,QB=QBLK*NW,KVBLK=64,NQB=SEQ/QB;
constexpr int ATTN_PITCH=DM, ATTN_UNIT_ROWS=QB;
__device__ __forceinline__ int crow(int r,int hi){return (r&3)+8*(r>>2)+4*hi;}
#define SBAR() __builtin_amdgcn_sched_barrier(0)
__device__ __forceinline__ void cmask(f32x16&p0,f32x16&p1,int t,int NT,int wid,int qw,int r32,int hi,const __attribute__((address_space(3))) float*tab){
  const float NEG=-INFINITY; const int jb=t-(NT-4);
  if(jb>(wid>>1)){
    #pragma unroll
    for(int r=0;r<16;++r){p0[r]=NEG;p1[r]=NEG;}
  } else if(64*t>qw-154){
    const __attribute__((address_space(3))) float*tb=tab+(64*t+4*hi-(qw+r32)+191);
    #pragma unroll
    for(int r=0;r<16;++r){p0[r]+=tb[(r&3)+8*(r>>2)];p1[r]+=tb[(r&3)+8*(r>>2)+32];}
  }
}

constexpr int NSLOT=3, SLOTB=8192;
constexpr int LDS_K=0, LDS_V=NSLOT*SLOTB, LDS_WS=2*NSLOT*SLOTB, LDS_OST=LDS_WS+NW*64*4, LDS_BYTES=LDS_OST+NW*4096;
constexpr float C2=0.125f*1.4426950408889634f;
__device__ __forceinline__ void glds16(const void*gsrc,unsigned lds_dst){unsigned keep;
  asm volatile("s_mov_b32 %0, m0\n\ts_mov_b32 m0, %2\n\ts_nop 0\n\tglobal_load_lds_dwordx4 %1, off\n\ts_mov_b32 m0, %0":"=&s"(keep):"v"(gsrc),"s"(lds_dst):"memory");}
__device__ __forceinline__ float max3f(float a,float b,float c){float r;asm("v_max3_f32 %0, %1, %2, %3":"=v"(r):"v"(a),"v"(b),"v"(c));return r;}
__device__ __forceinline__ float max2f(float a,float b){float r;asm("v_max_f32_e32 %0, %1, %2":"=v"(r):"v"(a),"v"(b));return r;}
__device__ __forceinline__ float fadd_s(float a,float b){float r;asm("v_add_f32_e32 %0, %1, %2":"=v"(r):"v"(a),"v"(b));return r;}
__device__ __forceinline__ float fsub_s(float a,float b){float r;asm("v_sub_f32_e32 %0, %1, %2":"=v"(r):"v"(a),"v"(b));return r;}
typedef float f32x2_t __attribute__((ext_vector_type(2))); typedef __bf16 bf16x2_t __attribute__((ext_vector_type(2)));
__device__ __forceinline__ unsigned cvtpk_s(float lo,float hi){f32x2_t v={lo,hi};bf16x2_t b=__builtin_convertvector(v,bf16x2_t);return __builtin_bit_cast(unsigned,b);}
#define WAIT_BAR(N) asm volatile("s_waitcnt vmcnt(" #N ") lgkmcnt(0)\n\ts_barrier":::"memory")

__device__ __forceinline__ void qkt(f32x16&p0,f32x16&p1,const char*Kslot,const bf16x8*qr,const f32x16&negm,int r32,int hi){
  const char*kb=Kslot+hi*1024+r32*16;
  #pragma unroll
  for(int d0=0;d0<4;++d0){
    const bf16x8 b0=*reinterpret_cast<const bf16x8*>(kb+d0*2048);
    const bf16x8 b1=*reinterpret_cast<const bf16x8*>(kb+d0*2048+512);
    if(d0==0){p0=__builtin_amdgcn_mfma_f32_32x32x16_bf16(b0,qr[0],negm,0,0,0);p1=__builtin_amdgcn_mfma_f32_32x32x16_bf16(b1,qr[0],negm,0,0,0);}
    else{p0=__builtin_amdgcn_mfma_f32_32x32x16_bf16(b0,qr[d0],p0,0,0,0);p1=__builtin_amdgcn_mfma_f32_32x32x16_bf16(b1,qr[d0],p1,0,0,0);}}
}
typedef __attribute__((address_space(3))) const char* lds_cptr;
typedef short v4i16_t __attribute__((ext_vector_type(4)));
__device__ __forceinline__ void kload8(bf16x8*kf,lds_cptr kp){
  kf[0]=*(const __attribute__((address_space(3))) bf16x8*)(kp);      kf[1]=*(const __attribute__((address_space(3))) bf16x8*)(kp+512);
  kf[2]=*(const __attribute__((address_space(3))) bf16x8*)(kp+2048); kf[3]=*(const __attribute__((address_space(3))) bf16x8*)(kp+2560);
  kf[4]=*(const __attribute__((address_space(3))) bf16x8*)(kp+4096); kf[5]=*(const __attribute__((address_space(3))) bf16x8*)(kp+4608);
  kf[6]=*(const __attribute__((address_space(3))) bf16x8*)(kp+6144); kf[7]=*(const __attribute__((address_space(3))) bf16x8*)(kp+6656);
}
__device__ __forceinline__ void kload2(bf16x8*kf,lds_cptr kp,int j){ kf[2*j]=*(const __attribute__((address_space(3))) bf16x8*)(kp+j*2048); kf[2*j+1]=*(const __attribute__((address_space(3))) bf16x8*)(kp+j*2048+512); }
__device__ __forceinline__ s16x4 vtr(lds_cptr p){ return __builtin_bit_cast(s16x4,__builtin_amdgcn_ds_read_tr16_b64_v4i16((__attribute__((address_space(3))) v4i16_t*)p)); }
__device__ __forceinline__ float rowmax(const f32x16&p0,const f32x16&p1){
  float a=max3f(p0[0],p0[1],p1[0]),b=max3f(p0[2],p0[3],p1[1]);a=max3f(a,p1[2],p1[3]);
  #pragma unroll
  for(int r=4;r<16;r+=4){a=max3f(a,p0[r],p0[r+1]);b=max3f(b,p0[r+2],p0[r+3]);a=max3f(a,p1[r],p1[r+1]);b=max3f(b,p1[r+2],p1[r+3]);}
  const float m=max2f(a,b);
  auto rr=__builtin_amdgcn_permlane32_swap(__float_as_uint(m),__float_as_uint(m),false,false);
  return max2f(__uint_as_float(rr[0]),__uint_as_float(rr[1]));
}
__device__ __forceinline__ void pv(f32x16*o,int vb,bf16x8 pa0,bf16x8 pa1,bf16x8 pa2,bf16x8 pa3){
  #pragma unroll
  for(int d0=0;d0<2;++d0){s16x4 lo[4],hi[4];
    #pragma unroll
    for(int ks=0;ks<4;++ks){
      asm volatile("ds_read_b64_tr_b16 %0,%1 offset:%c2":"=&v"(lo[ks]):"v"(vb),"i"(d0*4096+ks*1024):"memory");
      asm volatile("ds_read_b64_tr_b16 %0,%1 offset:%c2":"=&v"(hi[ks]):"v"(vb),"i"(d0*4096+ks*1024+512):"memory");}
    asm volatile("s_waitcnt lgkmcnt(0)":::"memory");SBAR();
    #define PK(k) (bf16x8){lo[k][0],lo[k][1],lo[k][2],lo[k][3],hi[k][0],hi[k][1],hi[k][2],hi[k][3]}
    o[d0]=__builtin_amdgcn_mfma_f32_32x32x16_bf16(pa0,PK(0),o[d0],0,0,0);
    o[d0]=__builtin_amdgcn_mfma_f32_32x32x16_bf16(pa1,PK(1),o[d0],0,0,0);
    o[d0]=__builtin_amdgcn_mfma_f32_32x32x16_bf16(pa2,PK(2),o[d0],0,0,0);
    o[d0]=__builtin_amdgcn_mfma_f32_32x32x16_bf16(pa3,PK(3),o[d0],0,0,0);
    #undef PK
  }
}

#ifndef ATTN_STORE16
#define ATTN_STORE16(p,v) (*(u32x4*)(p)=(v))
#endif
template<int THRL> __device__ __forceinline__ void attn_unit(int b,int qcol,int vcol,int ocol,int qb,const bf16*Q,const bf16*__restrict__ K,const bf16*__restrict__ V,bf16*O,char*shm,const __attribute__((address_space(3))) float*tab){
  const int tid=threadIdx.x,lane=tid&63,r32=lane&31,hi=lane>>5; const int wid=__builtin_amdgcn_readfirstlane(tid>>6);
  const long rowbase=(long)b*SEQ; const int q0=qb*QB;
  const bf16*Qw=Q+(rowbase+q0+wid*QBLK)*DM+qcol;
  const bf16*Kh=K+rowbase*DM+qcol,*Vh=V+rowbase*DM+vcol;
  const unsigned lds0=(unsigned)(uintptr_t)shm;
  float*wsf=(float*)(shm+LDS_WS)+wid*64;
  const bf16*ksrc=Kh+(long)lane*DM+wid*8;
  const bf16*vsrc=Vh+(long)(16*(wid&3)+(lane>>2))*DM+(wid>>2)*32+(lane&3)*8;
  const unsigned kdst=lds0+LDS_K+wid*1024, vdst=lds0+LDS_V+wid*1024;
  #define DMA_K(t,slot) glds16(ksrc+(long)(t)*KVBLK*DM,(unsigned)__builtin_amdgcn_readfirstlane(kdst+(slot)))
  #define DMA_V(t,slot) glds16(vsrc+(long)(t)*KVBLK*DM,(unsigned)__builtin_amdgcn_readfirstlane(vdst+(slot)))
  const int vb0=(int)(lds0+LDS_V)+((lane>>4)&1)*32+(lane&3)*8+(4*hi+((lane&15)>>2))*64;
  const char*Kbase=shm+LDS_K; bf16x8 kf[8];
  const lds_cptr shm3=(lds_cptr)shm; const lds_cptr kp0=shm3+LDS_K+hi*1024+r32*16; const lds_cptr vp0=shm3+LDS_V+((lane>>4)&1)*32+(lane&3)*8+(4*hi+((lane&15)>>2))*64;
  const int NT=(q0+QB)/KVBLK;
  DMA_K(0,0);DMA_V(0,0);DMA_K(1,SLOTB);
  bf16x8 qr[4];
  #pragma unroll
  for(int d0=0;d0<4;++d0)qr[d0]=*reinterpret_cast<const bf16x8*>(&Qw[(long)r32*DM+d0*16+hi*8]);
  float mhat=0.f,l_reg=0.f;f32x16 o[2];f32x16 negm; { float z_; asm volatile("v_mov_b32 %0, 0":"=v"(z_)); _Pragma("unroll") for(int r=0;r<16;++r){o[0][r]=z_;o[1][r]=z_;negm[r]=z_;} } asm volatile("":"+v"(negm));
  const int qw=q0+wid*QBLK;
  #define CMASK(P0,P1,t) cmask(P0,P1,(t),NT,wid,qw,r32,hi,tab)
  bool resc=false;
  #define START(P0,P1) do{ const float rm=rowmax(P0,P1); resc=false; \
    { const float dl=rm; mhat=fadd_s(mhat,dl); \
      _Pragma("unroll") for(int r=0;r<16;++r){P0[r]=fsub_s(P0[r],dl);P1[r]=fsub_s(P1[r],dl);} \
      _Pragma("unroll") for(int r=0;r<16;++r)negm[r]=-mhat; asm volatile("":"+v"(negm)); } \
    _Pragma("unroll") for(int r=0;r<16;++r)P0[r]=__builtin_amdgcn_exp2f(P0[r]); }while(0)
  #define RESC() do{ if(resc){ asm volatile("s_waitcnt lgkmcnt(0)":::"memory"); \
      _Pragma("unroll") for(int d_=0;d_<2;++d_) _Pragma("unroll") for(int r=0;r<16;++r)o[d_][r]*=wsf[crow(r,hi)]; } }while(0)
  f32x16 pA0,pA1,pB0,pB1;
  int sl_prev=0,sl_cur=0,sl_next=SLOTB;
  #define ROT() do{sl_prev=sl_cur;sl_cur=sl_next;sl_next=(sl_next==(NSLOT-1)*SLOTB)?0:sl_next+SLOTB;}while(0)
  DMA_K(2,2*SLOTB);
  WAIT_BAR(3);
  qkt(pA0,pA1,Kbase,qr,negm,r32,hi);asm volatile("s_nop 15\n\ts_nop 7":"+v"(pA0),"+v"(pA1));CMASK(pA0,pA1,0);
  START(pA0,pA1);
  _Pragma("unroll") for(int r=0;r<16;++r)pA1[r]=__builtin_amdgcn_exp2f(pA1[r]);
  WAIT_BAR(0);
  DMA_K(3,0);DMA_V(1,SLOTB);
  ROT();
  kload8(kf,kp0+sl_cur);
  WAIT_BAR(2);
  s16x4 vlo[8],vhi[8]; u32x4 pw0,pw1,pw2,pw3;
  #define PKW(P,B) cvtpk_s(P[B],P[B+1])
  #define PAF(k) __builtin_bit_cast(bf16x8,pw##k)
  #define VFR(i) (bf16x8){vlo[i][0],vlo[i][1],vlo[i][2],vlo[i][3],vhi[i][0],vhi[i][1],vhi[i][2],vhi[i][3]}
  #define PIN(x) asm volatile("":"+v"(x))
  #define MX3(a,b,c) __builtin_fmaxf(__builtin_fmaxf((a),(b)),(c))
  #define GAPA(MF,A0,A1,A2,A3,W0,W1,PW) do{ MF; sacc+=A0; sacc+=A1; sacc+=A2; sacc+=A3; PIN(sacc); W0; W1; PIN(PW); SBAR(); }while(0)
  #define EX(v) __builtin_amdgcn_exp2f(v)
  #define GAPB(MF,X,B) do{ MF; X[B]=EX(X[B]); X[B+1]=EX(X[B+1]); X[B+2]=EX(X[B+2]); X[B+3]=EX(X[B+3]); PIN(X); SBAR(); }while(0)
  #define VRD(i) do{ vlo[i]=vtr(vp_+(((i)>>2)*4096+((i)&3)*1024)); vhi[i]=vtr(vp_+(((i)>>2)*4096+((i)&3)*1024+512)); }while(0)
  #define KRD(G,j) do{ if(G){ kload2(kf,kp0+sl_next,j); SBAR(); } }while(0)
  #define STEP(C0,C1,P0,P1,t,GK,GV,GL) do{ SBAR(); \
    const lds_cptr vp_=vp0+sl_prev; \
    VRD(0); SBAR(); float sacc=(P0[0]+P0[1]); \
    GAPA(C0=__builtin_amdgcn_mfma_f32_32x32x16_bf16(kf[0],qr[0],negm,0,0,0), P0[2],P0[3],P0[4],P0[5],     pw0[0]=PKW(P0,0), pw0[1]=PKW(P0,2), pw0); \
    VRD(4); SBAR(); GAPA(C1=__builtin_amdgcn_mfma_f32_32x32x16_bf16(kf[1],qr[0],negm,0,0,0), P0[6],P0[7],P0[8],P0[9],     pw0[2]=PKW(P0,4), pw0[3]=PKW(P0,6), pw0); \
    VRD(1); SBAR(); GAPA(C0=__builtin_amdgcn_mfma_f32_32x32x16_bf16(kf[2],qr[1],C0,0,0,0),   P0[10],P0[11],P0[12],P0[13], pw1[0]=PKW(P0,8), pw1[1]=PKW(P0,10), pw1); \
    VRD(5); SBAR(); GAPA(C1=__builtin_amdgcn_mfma_f32_32x32x16_bf16(kf[3],qr[1],C1,0,0,0),   P0[14],P0[15],P1[0],P1[1],   pw1[2]=PKW(P0,12),pw1[3]=PKW(P0,14), pw1); \
    VRD(2); SBAR(); GAPA(C0=__builtin_amdgcn_mfma_f32_32x32x16_bf16(kf[4],qr[2],C0,0,0,0),   P1[2],P1[3],P1[4],P1[5],     pw2[0]=PKW(P1,0), pw2[1]=PKW(P1,2), pw2); \
    VRD(6); SBAR(); GAPA(C1=__builtin_amdgcn_mfma_f32_32x32x16_bf16(kf[5],qr[2],C1,0,0,0),   P1[6],P1[7],P1[8],P1[9],     pw2[2]=PKW(P1,4), pw2[3]=PKW(P1,6), pw2); \
    VRD(3); SBAR(); GAPA(C0=__builtin_amdgcn_mfma_f32_32x32x16_bf16(kf[6],qr[3],C0,0,0,0),   P1[10],P1[11],P1[12],P1[13], pw3[0]=PKW(P1,8), pw3[1]=PKW(P1,10), pw3); \
    VRD(7); SBAR(); GAPA(C1=__builtin_amdgcn_mfma_f32_32x32x16_bf16(kf[7],qr[3],C1,0,0,0),   P1[14],P1[15],0.f,0.f,       pw3[2]=PKW(P1,12),pw3[3]=PKW(P1,14), pw3); \
    l_reg+=sacc; \
    if(GK){DMA_K((t)+3,sl_cur);} if(GV){DMA_V((t)+1,sl_next);} \
    CMASK(C0,C1,t); \
    { float a=MX3(C0[0],C0[1],C1[0]),b=MX3(C0[2],C0[3],C1[1]); a=MX3(a,C1[2],C1[3]); \
      _Pragma("unroll") for(int r=4;r<16;r+=4){a=MX3(a,C0[r],C0[r+1]);b=MX3(b,C0[r+2],C0[r+3]);a=MX3(a,C1[r],C1[r+1]);b=MX3(b,C1[r+2],C1[r+3]);} \
      float rm=__builtin_fmaxf(a,b); { auto rr=__builtin_amdgcn_permlane32_swap(__float_as_uint(rm),__float_as_uint(rm),false,false); rm=__builtin_fmaxf(__uint_as_float(rr[0]),__uint_as_float(rr[1])); } \
      resc=false; \
      if(__builtin_expect(__any(rm>(float)THRL),0)){ const float dl=__builtin_fmaxf(rm,0.f); mhat+=dl; \
        _Pragma("unroll") for(int r=0;r<16;++r){C0[r]-=dl;C1[r]-=dl;} \
        _Pragma("unroll") for(int r=0;r<16;++r)negm[r]=-mhat; asm volatile("":"+v"(negm)); \
        const float f=__builtin_amdgcn_exp2f(-dl); l_reg*=f; if(hi==0)wsf[r32]=f; resc=true; } } \
    SBAR(); \
    GAPB(o[0]=__builtin_amdgcn_mfma_f32_32x32x16_bf16(PAF(0),VFR(0),o[0],0,0,0), C0,0); \
    GAPB(o[1]=__builtin_amdgcn_mfma_f32_32x32x16_bf16(PAF(0),VFR(4),o[1],0,0,0), C0,4); \
    KRD(GL,0); GAPB(o[0]=__builtin_amdgcn_mfma_f32_32x32x16_bf16(PAF(1),VFR(1),o[0],0,0,0), C0,8); \
    KRD(GL,1); GAPB(o[1]=__builtin_amdgcn_mfma_f32_32x32x16_bf16(PAF(1),VFR(5),o[1],0,0,0), C0,12); \
    KRD(GL,2); GAPB(o[0]=__builtin_amdgcn_mfma_f32_32x32x16_bf16(PAF(2),VFR(2),o[0],0,0,0), C1,0); \
    KRD(GL,3); GAPB(o[1]=__builtin_amdgcn_mfma_f32_32x32x16_bf16(PAF(2),VFR(6),o[1],0,0,0), C1,4); \
    GAPB(o[0]=__builtin_amdgcn_mfma_f32_32x32x16_bf16(PAF(3),VFR(3),o[0],0,0,0), C1,8); \
    GAPB(o[1]=__builtin_amdgcn_mfma_f32_32x32x16_bf16(PAF(3),VFR(7),o[1],0,0,0), C1,12); \
    }while(0)
  int t=1;
  #undef CMASK
  #define CMASK(P0,P1,t) do{}while(0)
  for(;t+7<NT;t+=2){
    STEP(pB0,pB1,pA0,pA1,t,true,true,true);     WAIT_BAR(2); RESC(); ROT();
    STEP(pA0,pA1,pB0,pB1,t+1,true,true,true);   WAIT_BAR(2); RESC(); ROT();
  }
  #undef CMASK
  #define CMASK(P0,P1,t) cmask(P0,P1,(t),NT,wid,qw,r32,hi,tab)
  #define ENDW(tt) do{ if((tt)+3<NT){WAIT_BAR(2);} else if((tt)+2<NT){WAIT_BAR(1);} else {WAIT_BAR(0);} }while(0)
  for(;t+1<NT;t+=2){
    STEP(pB0,pB1,pA0,pA1,t,(t+3<NT),(t+1<NT),(t+1<NT));       ENDW(t);   RESC(); ROT();
    STEP(pA0,pA1,pB0,pB1,t+1,(t+4<NT),(t+2<NT),(t+2<NT));     ENDW(t+1); RESC(); ROT();
  }
  STEP(pB0,pB1,pA0,pA1,NT-1,false,false,false); RESC();
  { float sacc=pB0[0]+pB0[1]; _Pragma("unroll") for(int r=2;r<16;++r)sacc+=pB0[r]; _Pragma("unroll") for(int r=0;r<16;++r)sacc+=pB1[r]; l_reg+=sacc;
    pw0=(u32x4){PKW(pB0,0),PKW(pB0,2),PKW(pB0,4),PKW(pB0,6)};pw1=(u32x4){PKW(pB0,8),PKW(pB0,10),PKW(pB0,12),PKW(pB0,14)};pw2=(u32x4){PKW(pB1,0),PKW(pB1,2),PKW(pB1,4),PKW(pB1,6)};pw3=(u32x4){PKW(pB1,8),PKW(pB1,10),PKW(pB1,12),PKW(pB1,14)};
    SBAR(); pv(o,vb0+sl_cur,PAF(0),PAF(1),PAF(2),PAF(3)); }
  #undef PKW
  #undef PAF
  #undef VFR
  #undef PIN
  #undef MX3
  #undef GAPA
  #undef GAPB
  #undef EX
  #undef VRD
  #undef KRD
  #undef STEP
  #undef ENDW
  {auto rr=__builtin_amdgcn_permlane32_swap(__float_as_uint(l_reg),__float_as_uint(l_reg),false,false);l_reg=__uint_as_float(rr[0])+__uint_as_float(rr[1]);}
  if(hi==0)wsf[32+r32]=l_reg;asm volatile("s_waitcnt lgkmcnt(0)":::"memory");
  float rli[16];
  #pragma unroll
  for(int r=0;r<16;++r)rli[r]=__builtin_amdgcn_rcpf(wsf[32+crow(r,hi)]);
  bf16*Ow=O+(rowbase+q0+wid*QBLK)*OP+ocol;
  { bf16*stg=(bf16*)(shm+LDS_OST)+wid*2048;
    #pragma unroll
    for(int r=0;r<16;++r){const int orow=crow(r,hi);
      #pragma unroll
      for(int d0=0;d0<2;++d0)stg[orow*64+d0*32+r32]=__float2bfloat16(o[d0][r]*rli[r]);}
    asm volatile("s_waitcnt lgkmcnt(0)":::"memory");
    #pragma unroll
    for(int i=0;i<4;++i){const int row=i*8+(lane>>3),ch=lane&7; const u32x4 v=*(const u32x4*)(stg+row*64+ch*8); ATTN_STORE16(Ow+(long)row*OP+ch*8,v);} }
  asm volatile("s_waitcnt lgkmcnt(0)\n\ts_barrier":::"memory");
  #undef DMA_K
  #undef DMA_V
  #undef CMASK
  #undef START
  #undef RESC
  #undef ROT
}
constexpr int ATTN_LDS_BYTES=LDS_BYTES;
struct AttnTensors { const bf16* Q; const bf16* K; const bf16* V; bf16* O; };
template<int THRL=8> __device__ __forceinline__ void attn_phase(char*lds,const AttnTensors&T,int vcu,const float*rel_bias){
  const int hc=vcu>>2,s=vcu&3,vh=hc&1,map=(hc>>1)&1,h=(hc>>2)&7,b=hc>>5;
  __attribute__((address_space(3))) float*tab=(__attribute__((address_space(3))) float*)(lds+LDS_BYTES);
  { const float c15=rel_bias[15*8+h];
    for(int i=threadIdx.x;i<256;i+=512){ const int rel=i-191; const int n=rel<0?-rel:rel;
      int bk=n<8?n:n<12?8:n<16?9:n<23?10:n<32?11:n<46?12:n<64?13:n<91?14:15; if(rel>0)bk+=16;
      tab[i]=(rel_bias[bk*8+h]-c15)*1.4426950408889634f; } }
  asm volatile("s_waitcnt lgkmcnt(0)\n\ts_barrier":::"memory");
  #pragma unroll 1
  for(int i=0;i<4;++i){ const int qb=(i==0)?s:(i==1)?7-s:(i==2)?8+s:15-s;
    attn_unit<THRL>(b,h*128+map*64,h*128+vh*64,h*256+map*128+vh*64,qb,T.Q,T.K,T.V,T.O,lds,tab); }
}
#undef SBAR
#undef WAIT_BAR
}

constexpr int BATCH = 2, SEQ = 4096, T = BATCH * SEQ, D = 2048;
constexpr int NPROJ = 7184, NPROJ_PAD = 7424, SEGW = 1024;
constexpr int NH = 8, CH = 64, NCH = SEQ / CH;
constexpr int NEXP = 32, FE = 512;
constexpr float EPS = 1e-6f, LOG2E = 1.4426950408889634f;
constexpr float QSCALE = 0.125f * LOG2E;
static_assert(T == pg8::kT, "token count");

constexpr size_t MiB = 1u << 20;
constexpr size_t WS_CTL = 0, CTL_ZERO_BYTES = 1 * MiB;
constexpr size_t WS_WIN = 1 * MiB, WS_WOUT = 30 * MiB, WS_WGU = 38 * MiB, WS_WD = 166 * MiB;
constexpr size_t WS_XN = 230 * MiB, WS_SEG = 262 * MiB, WS_GATES = 374 * MiB, WS_OA = 375 * MiB, WS_QC = 407 * MiB, WS_KC = 423 * MiB, WS_CLOC = 439 * MiB, WS_MISC = 503 * MiB, WS_END = 505 * MiB;
constexpr size_t SEG_BYTES = (size_t)T * SEGW * 2;
constexpr size_t WS_QD = WS_SEG, WS_KD = WS_SEG + SEG_BYTES, WS_VD = WS_SEG + 2 * SEG_BYTES, WS_QM = WS_SEG + 3 * SEG_BYTES, WS_KM = WS_SEG + 4 * SEG_BYTES, WS_VM = WS_SEG + 5 * SEG_BYTES, WS_OM = WS_SEG + 6 * SEG_BYTES;
constexpr size_t WS_BCUM = WS_MISC, WS_NLOC = WS_MISC + 256 * 1024, WS_G = WS_MISC + MiB, WS_MLOC = WS_G + 4096, WS_MPREV = WS_G + 8192;
constexpr size_t WS_A2 = WS_XN, WS_X1 = 262 * MiB, WS_H2 = 326 * MiB, WS_LIST = 358 * MiB, WS_LISTW = 359 * MiB, WS_ROWTOK = 360 * MiB, WS_ROWW = 360 * MiB + 512 * 1024, WS_TAB = 361 * MiB;
constexpr size_t WS_HS = 375 * MiB, WS_HID = 471 * MiB, WS_Y0 = 230 * MiB, WS_Y1 = 326 * MiB;
constexpr int MAXROWS = 24576;
constexpr int CW_CNT = 32768;

struct Params {
    const float *x, *rel_bias, *ln_mix_g, *w_in, *conv_w, *conv_b, *b_i, *b_f, *lam_q1, *lam_k1, *lam_q2, *lam_k2, *diff_norm_g, *mlstm_norm_g, *w_out, *ln_ffn_g,
                *w_group, *b_group, *w_router, *b_router, *w_gate, *w_up, *w_down, *ln_f_g;
    float* out; unsigned char* ws;
    int ph_lo, ph_hi, li, pad;
};

__device__ __forceinline__ float bf2f(unsigned short v) { return __uint_as_float((unsigned)v << 16); }
__device__ __forceinline__ float wave_sum(float v) {
#pragma unroll
    for (int o = 1; o < 64; o <<= 1) v += __shfl_xor(v, o);
    return v;
}
__device__ __forceinline__ float wave_max(float v) {
#pragma unroll
    for (int o = 1; o < 64; o <<= 1) v = fmaxf(v, __shfl_xor(v, o));
    return v;
}
__device__ __forceinline__ int t5_bucket(int rel) {
    const int n = rel < 0 ? -rel : rel;
    int b = n < 8 ? n : n < 12 ? 8 : n < 16 ? 9 : n < 23 ? 10 : n < 32 ? 11 : n < 46 ? 12 : n < 64 ? 13 : n < 91 ? 14 : 15;
    return b + (rel > 0 ? 16 : 0);
}

template <int NB> __device__ __forceinline__ void transpose_item(const float* src, size_t ld, bf16* dst, size_t kd, LAS float* scr, int lane, float sc = 1.f) {
    constexpr int RPI = 64 / NB;
#pragma unroll 8
    for (int i = 0; i < 64 / RPI; ++i) { const int kk = RPI * i + lane / NB; scr[kk * 33 + (lane % NB)] = src[(size_t)kk * ld + (lane % NB)] * sc; }
    LDS_WAIT(); asm volatile("" ::: "memory");
    const int c = lane & 7;
#pragma unroll
    for (int j = 0; j < NB / 8; ++j) { const int n = (lane >> 3) + 8 * j; const LAS float* s = scr + (8 * c) * 33 + n;
        v4u o; o.x = pk2(s[0 * 33], s[1 * 33]); o.y = pk2(s[2 * 33], s[3 * 33]); o.z = pk2(s[4 * 33], s[5 * 33]); o.w = pk2(s[6 * 33], s[7 * 33]);
        *(GAS v4u*)(dst + (size_t)n * kd + 8 * c) = o; }
    LDS_WAIT(); asm volatile("" ::: "memory");
}
__device__ __forceinline__ void rms_row_to_bf16(const float* xrow, const float* g, bf16* orow, int lane) {
    const GAS f32x4* xr = (const GAS f32x4*)xrow + lane; const GAS f32x4* gr = (const GAS f32x4*)g + lane;
    f32x4 v[8]; float s = 0.f;
#pragma unroll
    for (int j = 0; j < 8; ++j) { v[j] = xr[64 * j]; s += (v[j].x * v[j].x + v[j].y * v[j].y) + (v[j].z * v[j].z + v[j].w * v[j].w); }
    const float rstd = rsqrtf(wave_sum(s) * (1.f / D) + EPS);
    GAS unsigned long long* o8 = (GAS unsigned long long*)orow + lane;
#pragma unroll
    for (int j = 0; j < 8; ++j) { const f32x4 gv = gr[64 * j];
        o8[64 * j] = (unsigned long long)pk2(v[j].x * rstd * gv.x, v[j].y * rstd * gv.y) | ((unsigned long long)pk2(v[j].z * rstd * gv.z, v[j].w * rstd * gv.w) << 32); }
}
__device__ __forceinline__ void prologue_body(const Params& p, LAS unsigned char* lds, int gw, int NGW, int wave, int lane) {
    LAS float* scr = (LAS float*)lds + wave * 4096;
    bf16* Win = (bf16*)(p.ws + WS_WIN); bf16* Wout = (bf16*)(p.ws + WS_WOUT); bf16* Wgu = (bf16*)(p.ws + WS_WGU); bf16* Wd = (bf16*)(p.ws + WS_WD); bf16* XN = (bf16*)(p.ws + WS_XN);
    constexpr int I_IN = 32 * 224, I_ING = 32, I_OUT = 32 * 64, I_G = NEXP * 32 * 16, I_D = NEXP * 8 * 64;
    constexpr int NITEMS = I_IN + I_ING + I_OUT + 2 * I_G + I_D;
    for (int it = gw; it < NITEMS; it += NGW) {
        int r = it;
        if (r < I_IN) { const int kb = r / 224, nb = r % 224; transpose_item<32>(p.w_in + (size_t)(64 * kb) * NPROJ + 32 * nb, NPROJ, Win + (size_t)(32 * nb) * D + 64 * kb, D, scr, lane, nb < 32 ? QSCALE : 1.f); continue; } r -= I_IN;
        if (r < I_ING) { const int kb = r; transpose_item<16>(p.w_in + (size_t)(64 * kb) * NPROJ + 7168, NPROJ, Win + (size_t)7168 * D + 64 * kb, D, scr, lane); continue; } r -= I_ING;
        if (r < I_OUT) { const int kb = r / 64, nb = r % 64; transpose_item<32>(p.w_out + (size_t)(64 * kb) * D + 32 * nb, D, Wout + (size_t)(32 * nb) * D + 64 * kb, D, scr, lane); continue; } r -= I_OUT;
        if (r < 2 * I_G) { const int up = (r >= I_G) ? 1 : 0; if (up) r -= I_G; const int e = r / 512, q = r % 512, kb = q / 16, nb = q % 16;
            const float* src = (up ? p.w_up : p.w_gate) + (size_t)e * D * FE + (size_t)(64 * kb) * FE + 32 * nb;
            const int f0 = 32 * nb, rowb = e * 1024 + (f0 >> 7) * 256 + up * 128 + (f0 & 127);
            transpose_item<32>(src, FE, Wgu + (size_t)rowb * D + 64 * kb, D, scr, lane); continue; } r -= 2 * I_G;
        { const int e = r / 512, q = r % 512, kb = q / 64, nb = q % 64;
          transpose_item<32>(p.w_down + (size_t)e * FE * D + (size_t)(64 * kb) * D + 32 * nb, D, Wd + ((size_t)e * 2048 + 32 * nb) * FE + 64 * kb, FE, scr, lane); }
    }
    for (int r = gw; r < NPROJ_PAD - NPROJ; r += NGW) { GAS v4u* o = (GAS v4u*)(Win + (size_t)(NPROJ + r) * D) + lane; const v4u z = {0u, 0u, 0u, 0u};
#pragma unroll
        for (int j = 0; j < 4; ++j) o[64 * j] = z; }
    for (int m = gw; m < T; m += NGW) rms_row_to_bf16(p.x + (size_t)m * D, p.ln_mix_g, XN + (size_t)m * D, lane);
}
#define ATTN_IN_MEGA 1

constexpr int LDS_BYTES = 147456;
constexpr int LDSCTL_OFF = 146432;
constexpr int CW_BAR = 4096;

__device__ __forceinline__ void ph_conv(const Params& p, int tid) {
    for (int idx = blockIdx.x * 512 + tid; idx < T * 256; idx += gridDim.x * 512) {
        const int t = idx >> 8, c8 = (idx & 255) * 8, ts = t & (SEQ - 1), cc = c8 & 1023; const bool isk = c8 >= 1024;
        const bf16* src = (const bf16*)(p.ws + (isk ? WS_KM : WS_QM)); bf16* dst = (bf16*)(p.ws + (isk ? WS_KC : WS_QC));
        float a[8];
#pragma unroll
        for (int i = 0; i < 8; ++i) a[i] = p.conv_b[c8 + i];
#pragma unroll
        for (int j = 0; j < 4; ++j) { if (ts - 3 + j >= 0) { const v4u w = *(const v4u*)(src + (size_t)(t - 3 + j) * 1024 + cc); const float* cw = p.conv_w + j * 2048 + c8;
            a[0] += cw[0] * __uint_as_float(w.x << 16); a[1] += cw[1] * __uint_as_float(w.x & 0xffff0000u); a[2] += cw[2] * __uint_as_float(w.y << 16); a[3] += cw[3] * __uint_as_float(w.y & 0xffff0000u);
            a[4] += cw[4] * __uint_as_float(w.z << 16); a[5] += cw[5] * __uint_as_float(w.z & 0xffff0000u); a[6] += cw[6] * __uint_as_float(w.w << 16); a[7] += cw[7] * __uint_as_float(w.w & 0xffff0000u); } }
        const float sc = isk ? 0.08838834764831845f : 1.f;
#pragma unroll
        for (int i = 0; i < 8; ++i) a[i] = a[i] / (1.f + __expf(-a[i])) * sc;
        v4u o; o.x = pk2(a[0], a[1]); o.y = pk2(a[2], a[3]); o.z = pk2(a[4], a[5]); o.w = pk2(a[6], a[7]);
        *(v4u*)(dst + (size_t)t * 1024 + cc) = o;
    }
}
__device__ __forceinline__ void ph_mlstm_local(const Params& p, unsigned char* lds, int tid) {
    float (*vs)[128] = (float (*)[128])lds; float (*ks)[128] = (float (*)[128])(lds + 32768); float* wt = (float*)(lds + 65536); float* lf = wt + 64;
    const float* GATES = (const float*)(p.ws + WS_GATES); const bf16* VM = (const bf16*)(p.ws + WS_VM); const bf16* KC = (const bf16*)(p.ws + WS_KC);
    float* BCUM = (float*)(p.ws + WS_BCUM); float* Gc = (float*)(p.ws + WS_G); float* MLOC = (float*)(p.ws + WS_MLOC); float* CLOC = (float*)(p.ws + WS_CLOC); float* NLOC = (float*)(p.ws + WS_NLOC);
    for (int bx = blockIdx.x; bx < 1024; bx += gridDim.x) {
        const int bh = bx >> 6, c = bx & 63, b = bh >> 3, h = bh & 7; const size_t row0 = (size_t)b * SEQ + c * 64;
        __syncthreads();
        if (tid < 64) { const float f = GATES[(row0 + tid) * 16 + 8 + h] + p.b_f[h]; lf[tid] = fminf(f, 0.f) - log1pf(expf(-fabsf(f))); }
        __syncthreads();
        if (tid == 0) { float a = 0.f; for (int l = 0; l < 64; ++l) { a += lf[l]; lf[l] = a; } }
        __syncthreads();
        if (tid < 64) { const float g = lf[63], w = g - lf[tid] + GATES[(row0 + tid) * 16 + h] + p.b_i[h]; const float mx = wave_max(w); wt[tid] = expf(w - mx);
            BCUM[(size_t)bx * 64 + tid] = lf[tid]; if (tid == 0) { Gc[bx] = g; MLOC[bx] = mx; } }
        __syncthreads();
        for (int idx = tid; idx < 8192; idx += 512) { const int l = idx >> 7, d = idx & 127; vs[l][d] = bf2f(VM[(row0 + l) * 1024 + h * 128 + d]) * wt[l]; ks[l][d] = bf2f(KC[(row0 + l) * 1024 + h * 128 + d]); }
        __syncthreads();
        const int d0 = (tid >> 5) * 8, e0 = (tid & 31) * 4;
        float acc[8][4];
#pragma unroll
        for (int i = 0; i < 8; ++i)
#pragma unroll
            for (int j = 0; j < 4; ++j) acc[i][j] = 0.f;
        for (int l = 0; l < 64; ++l) { float a[8]; const f32x4 k4 = *(const f32x4*)&ks[l][e0];
#pragma unroll
            for (int i = 0; i < 8; ++i) a[i] = vs[l][d0 + i];
#pragma unroll
            for (int i = 0; i < 8; ++i) { acc[i][0] += a[i] * k4.x; acc[i][1] += a[i] * k4.y; acc[i][2] += a[i] * k4.z; acc[i][3] += a[i] * k4.w; } }
        float* co = CLOC + (size_t)bx * 16384;
#pragma unroll
        for (int i = 0; i < 8; ++i) *(f32x4*)(co + (d0 + i) * 128 + e0) = (f32x4){acc[i][0], acc[i][1], acc[i][2], acc[i][3]};
        if (tid < 128) { float n = 0.f; for (int l = 0; l < 64; ++l) n += wt[l] * ks[l][tid]; NLOC[(size_t)bx * 128 + tid] = n; }
    }
}
__device__ __forceinline__ void ph_mlstm_scan(const Params& p, int tid) {
    const float* Gc = (const float*)(p.ws + WS_G); const float* MLOC = (const float*)(p.ws + WS_MLOC); float* MPREV = (float*)(p.ws + WS_MPREV);
    for (int el = blockIdx.x * 512 + tid; el < 16 * 16512; el += gridDim.x * 512) {
        const int bh = el / 16512, idx = el % 16512;
        float* base = idx < 16384 ? (float*)(p.ws + WS_CLOC) + (size_t)bh * 64 * 16384 + idx : (float*)(p.ws + WS_NLOC) + (size_t)bh * 64 * 128 + (idx - 16384);
        const size_t stride = idx < 16384 ? 16384 : 128;
        float m = 0.f, val = 0.f;
#pragma unroll 8
        for (int c = 0; c < 64; ++c) { const float g = Gc[bh * 64 + c], ml = MLOC[bh * 64 + c]; float* ptr = base + (size_t)c * stride; const float loc = *ptr; *ptr = val;
            if (idx == 0) MPREV[bh * 64 + c] = m;
            const float mn = fmaxf(g + m, ml); val = expf(g + m - mn) * val + expf(ml - mn) * loc; m = mn; }
    }
}
__device__ __forceinline__ void ph_mlstm_out(const Params& p, unsigned char* ldsraw, int tid) {
    float (*qs)[129] = (float (*)[129])ldsraw; float (*kv)[129] = (float (*)[129])(ldsraw + 64 * 129 * 4); float (*Sm)[65] = (float (*)[65])(ldsraw + 2 * 64 * 129 * 4);
    float* bl = (float*)(ldsraw + 2 * 64 * 129 * 4 + 64 * 65 * 4); float* il = bl + 64; float* mt = il + 64; float* inter = mt + 64; float* dn = inter + 64;
    const float* GATES = (const float*)(p.ws + WS_GATES); const bf16* VM = (const bf16*)(p.ws + WS_VM); const bf16* KC = (const bf16*)(p.ws + WS_KC); const bf16* QC = (const bf16*)(p.ws + WS_QC); const bf16* OM = (const bf16*)(p.ws + WS_OM);
    const float* BCUM = (const float*)(p.ws + WS_BCUM); const float* MPREV = (const float*)(p.ws + WS_MPREV);
    bf16* A2 = (bf16*)(p.ws + WS_A2);
    for (int bx = blockIdx.x; bx < 1024; bx += gridDim.x) {
        const int bh = bx >> 6, c = bx & 63, b = bh >> 3, h = bh & 7; const size_t row0 = (size_t)b * SEQ + c * 64;
        const float* CPREV = (const float*)(p.ws + WS_CLOC) + (size_t)bx * 16384; const float* NPREV = (const float*)(p.ws + WS_NLOC) + (size_t)bx * 128;
        __syncthreads();
        for (int idx = tid; idx < 8192; idx += 512) { const int l = idx >> 7, e = idx & 127; qs[l][e] = bf2f(QC[(row0 + l) * 1024 + h * 128 + e]); kv[l][e] = bf2f(KC[(row0 + l) * 1024 + h * 128 + e]); }
        if (tid < 64) { bl[tid] = BCUM[(size_t)bx * 64 + tid]; il[tid] = GATES[(row0 + tid) * 16 + h] + p.b_i[h]; }
        const float mprev = MPREV[bx];
        __syncthreads();
        if (tid < 64) { float mx = -INFINITY; for (int s = 0; s <= tid; ++s) mx = fmaxf(mx, bl[tid] - bl[s] + il[s]); const float mi = bl[tid] + mprev, m = fmaxf(mx, mi); mt[tid] = m; inter[tid] = expf(mi - m); }
        __syncthreads();
        const int t = tid >> 3, sq = tid & 7;
        for (int jj = 0; jj < 8; ++jj) { const int s = sq * 8 + jj; float a = 0.f;
#pragma unroll 4
            for (int e = 0; e < 128; ++e) a += qs[t][e] * kv[s][e];
            const float w = (s <= t) ? expf(bl[t] - bl[s] + il[s] - mt[t]) : 0.f; Sm[t][s] = a * w; }
        __syncthreads();
        if (tid < 64) { float d1 = 0.f;
#pragma unroll 4
            for (int s = 0; s < 64; ++s) d1 += Sm[tid][s];
            float nq = 0.f;
#pragma unroll 4
            for (int e = 0; e < 128; ++e) nq += NPREV[e] * qs[tid][e];
            dn[tid] = fmaxf(fabsf(d1 + inter[tid] * nq), expf(-mt[tid])); }
        for (int idx = tid; idx < 8192; idx += 512) { const int l = idx >> 7, d = idx & 127; kv[l][d] = bf2f(VM[(row0 + l) * 1024 + h * 128 + d]); }
        __syncthreads();
        float acc[16];
#pragma unroll
        for (int i = 0; i < 16; ++i) acc[i] = 0.f;
#pragma unroll 2
        for (int s = 0; s < 64; ++s) { const float w = Sm[t][s];
#pragma unroll
            for (int i = 0; i < 16; ++i) acc[i] += w * kv[s][sq * 16 + i]; }
        const float it = inter[t];
        { float acc2[16];
#pragma unroll
          for (int i = 0; i < 16; ++i) acc2[i] = 0.f;
          const float* cp = CPREV + (sq * 16) * 128;
#pragma unroll 1
          for (int e = 0; e < 128; ++e) { const float qe = qs[t][e];
#pragma unroll
              for (int i = 0; i < 16; ++i) acc2[i] += cp[i * 128 + e] * qe; }
#pragma unroll
          for (int i = 0; i < 16; ++i) acc[i] += it * acc2[i]; }
        const float rd = 1.f / dn[t]; float ss = 0.f;
#pragma unroll
        for (int i = 0; i < 16; ++i) { acc[i] *= rd; ss += acc[i] * acc[i]; }
        ss += __shfl_xor(ss, 1); ss += __shfl_xor(ss, 2); ss += __shfl_xor(ss, 4);
        const float rstd = rsqrtf(ss * (1.f / 128.f) + EPS);
#pragma unroll
        for (int i = 0; i < 16; i += 2) { const int d = h * 128 + sq * 16 + i;
            const float o0 = bf2f(OM[(row0 + t) * 1024 + d]), o1 = bf2f(OM[(row0 + t) * 1024 + d + 1]);
            const float y0 = acc[i] * rstd * p.mlstm_norm_g[d] / (1.f + __expf(-o0)), y1 = acc[i + 1] * rstd * p.mlstm_norm_g[d + 1] / (1.f + __expf(-o1));
            *(unsigned*)(A2 + (row0 + t) * 2048 + 1024 + d) = pk2(y0, y1); }
    }
}
__device__ __forceinline__ void ph_diff_combine(const Params& p, int tid) {
    const int lane = tid & 63;
    const float lam = expf(wave_sum(p.lam_q1[lane] * p.lam_k1[lane])) - expf(wave_sum(p.lam_q2[lane] * p.lam_k2[lane])) + 0.2f;
    const bf16* OA = (const bf16*)(p.ws + WS_OA); bf16* A2 = (bf16*)(p.ws + WS_A2);
    for (int gw = blockIdx.x * 8 + (tid >> 6); gw < T * NH; gw += gridDim.x * 8) { const int row = gw >> 3, h = gw & 7;
        const unsigned w1 = *(const unsigned*)(OA + (size_t)row * 2048 + h * 256 + 2 * lane), w2 = *(const unsigned*)(OA + (size_t)row * 2048 + h * 256 + 128 + 2 * lane);
        const float v0 = __uint_as_float(w1 << 16) - lam * __uint_as_float(w2 << 16), v1 = __uint_as_float(w1 & 0xffff0000u) - lam * __uint_as_float(w2 & 0xffff0000u);
        const float rstd = rsqrtf(wave_sum(v0 * v0 + v1 * v1) * (1.f / 128.f) + EPS);
        *(unsigned*)(A2 + (size_t)row * 2048 + h * 128 + 2 * lane) = pk2(v0 * rstd * p.diff_norm_g[h * 128 + 2 * lane] * 0.8f, v1 * rstd * p.diff_norm_g[h * 128 + 2 * lane + 1] * 0.8f); }
}
__device__ __forceinline__ void ph_router(const Params& p, LAS unsigned char* lds, int tid) {
    const int lane = tid & 63;
    const float* X1 = (const float*)(p.ws + WS_X1); bf16* H2 = (bf16*)(p.ws + WS_H2);
    for (int row = blockIdx.x * 8 + (tid >> 6); row < T; row += gridDim.x * 8) {
        const GAS f32x4* xr = (const GAS f32x4*)(X1 + (size_t)row * D) + lane; const GAS f32x4* gr = (const GAS f32x4*)p.ln_ffn_g + lane;
        f32x4 v[8]; float s = 0.f;
#pragma unroll
        for (int j = 0; j < 8; ++j) { v[j] = xr[64 * j]; s += (v[j].x * v[j].x + v[j].y * v[j].y) + (v[j].z * v[j].z + v[j].w * v[j].w); }
        const float rstd = rsqrtf(wave_sum(s) * (1.f / D) + EPS);
        GAS unsigned long long* o8 = (GAS unsigned long long*)(H2 + (size_t)row * D) + lane;
#pragma unroll
        for (int j = 0; j < 8; ++j) { const f32x4 gv = gr[64 * j]; v[j].x *= rstd * gv.x; v[j].y *= rstd * gv.y; v[j].z *= rstd * gv.z; v[j].w *= rstd * gv.w;
            o8[64 * j] = (unsigned long long)pk2(v[j].x, v[j].y) | ((unsigned long long)pk2(v[j].z, v[j].w) << 32); }
        LAS float* hl = (LAS float*)lds + (tid >> 6) * 2048;
#pragma unroll
        for (int j = 0; j < 8; ++j) *(LAS f32x4*)(hl + 256 * j + 4 * lane) = v[j];
        LDS_WAIT(); asm volatile("" ::: "memory");
        float ag[4] = {0.f, 0.f, 0.f, 0.f}; float ar[4][8];
#pragma unroll
        for (int g = 0; g < 4; ++g)
#pragma unroll
            for (int e = 0; e < 8; ++e) ar[g][e] = 0.f;
        const float* wgp = p.w_group + (size_t)lane * 4; const float* wrp = p.w_router + (size_t)lane * 8;
#pragma unroll 2
        for (int kk = 0; kk < 32; ++kk) { const float hv = hl[kk * 64 + lane];
            const f32x4 wg = *(const f32x4*)(wgp + (size_t)kk * 256); ag[0] += hv * wg.x; ag[1] += hv * wg.y; ag[2] += hv * wg.z; ag[3] += hv * wg.w;
#pragma unroll
            for (int g = 0; g < 4; ++g) { const f32x4 w0 = *(const f32x4*)(wrp + (size_t)g * (D * 8) + (size_t)kk * 512), w1 = *(const f32x4*)(wrp + (size_t)g * (D * 8) + (size_t)kk * 512 + 4);
                ar[g][0] += hv * w0.x; ar[g][1] += hv * w0.y; ar[g][2] += hv * w0.z; ar[g][3] += hv * w0.w; ar[g][4] += hv * w1.x; ar[g][5] += hv * w1.y; ar[g][6] += hv * w1.z; ar[g][7] += hv * w1.w; } }
        LDS_WAIT(); asm volatile("" ::: "memory");
#pragma unroll
        for (int g = 0; g < 4; ++g) { ag[g] = wave_sum(ag[g]) + p.b_group[g];
#pragma unroll
            for (int e = 0; e < 8; ++e) ar[g][e] = wave_sum(ar[g][e]) + p.b_router[g * 8 + e]; }
        int gs = 0; float gm = ag[0];
#pragma unroll
        for (int g = 1; g < 4; ++g) if (ag[g] > gm) { gm = ag[g]; gs = g; }
        float se = 0.f;
#pragma unroll
        for (int g = 0; g < 4; ++g) se += expf(ag[g] - gm);
        const float gw = 1.f / se;
        float el[8];
#pragma unroll
        for (int e = 0; e < 8; ++e) el[e] = gs == 0 ? ar[0][e] : gs == 1 ? ar[1][e] : gs == 2 ? ar[2][e] : ar[3][e];
        int i0 = 0; float v0 = el[0];
#pragma unroll
        for (int e = 1; e < 8; ++e) if (el[e] > v0) { v0 = el[e]; i0 = e; }
        int i1 = -1; float v1 = -INFINITY;
#pragma unroll
        for (int e = 0; e < 8; ++e) if (e != i0 && el[e] > v1) { v1 = el[e]; i1 = e; }
        const float w0 = 1.f / (1.f + expf(v1 - v0)), w1 = 1.f - w0;
        if (lane == 0) {
            unsigned* cnt = (unsigned*)(p.ws + WS_CTL) + CW_CNT; int* LIST = (int*)(p.ws + WS_LIST); float* LISTW = (float*)(p.ws + WS_LISTW);
            const int e0 = gs * 8 + i0, e1 = gs * 8 + i1;
            const unsigned p0 = atomicAdd(cnt + e0, 1u); LIST[e0 * 8192 + p0] = row * 2; LISTW[e0 * 8192 + p0] = gw * w0;
            const unsigned p1 = atomicAdd(cnt + e1, 1u); LIST[e1 * 8192 + p1] = row * 2 + 1; LISTW[e1 * 8192 + p1] = gw * w1;
        }
    }
}
__device__ __forceinline__ void ph_sortcopy(const Params& p, unsigned char* lds, int tid) {
    int* s_cnt = (int*)lds; int* s_rowbase = s_cnt + 32; int* s_tilebase = s_rowbase + 33;
    const int lane = tid & 63, wave = tid >> 6;
    const unsigned* cnt = (const unsigned*)(p.ws + WS_CTL) + CW_CNT;
    __syncthreads();
    if (tid == 0) { int rb = 0, tb = 0; for (int e = 0; e < 32; ++e) { const int n = (int)__hip_atomic_load(cnt + e, RLX_AGENT); s_cnt[e] = n; s_rowbase[e] = rb; s_tilebase[e] = tb; const int nt = (n + 255) >> 8; rb += nt * 256; tb += nt; } s_rowbase[32] = rb; s_tilebase[32] = tb; }
    __syncthreads();
    const int MT = s_tilebase[32]; int* TAB = (int*)(p.ws + WS_TAB);
    if (blockIdx.x == 0) { if (tid == 0) TAB[0] = MT; if (tid < MT) { int e = 0; while (e < 31 && s_tilebase[e + 1] <= tid) ++e; TAB[1 + tid] = e; } }
    const int* LIST = (const int*)(p.ws + WS_LIST); const float* LISTW = (const float*)(p.ws + WS_LISTW); int* ROWTOK = (int*)(p.ws + WS_ROWTOK); float* ROWW = (float*)(p.ws + WS_ROWW);
    const bf16* H2 = (const bf16*)(p.ws + WS_H2); bf16* HS = (bf16*)(p.ws + WS_HS);
    for (int r = blockIdx.x * 8 + wave; r < MT * 256; r += gridDim.x * 8) {
        int e = 0; while (e < 31 && s_rowbase[e + 1] <= r) ++e;
        const int i = r - s_rowbase[e]; const bool valid = i < s_cnt[e];
        int ts = -1; float w = 0.f; if (valid) { ts = LIST[e * 8192 + i]; w = LISTW[e * 8192 + i]; }
        GAS v4u* dst = (GAS v4u*)(HS + (size_t)r * D) + lane;
        if (valid) { const GAS v4u* src = (const GAS v4u*)(H2 + (size_t)(ts >> 1) * D) + lane;
#pragma unroll
            for (int j = 0; j < 4; ++j) dst[64 * j] = src[64 * j]; }
        else { const v4u z = {0u, 0u, 0u, 0u};
#pragma unroll
            for (int j = 0; j < 4; ++j) dst[64 * j] = z; }
        if (lane == 0) { ROWTOK[r] = ts; ROWW[r] = w; }
    }
}
__device__ __forceinline__ void ph_final(const Params& p, int tid) {
    const int lane = tid & 63;
    for (int row = blockIdx.x * 8 + (tid >> 6); row < T; row += gridDim.x * 8) {
        const GAS f32x4* xr = (const GAS f32x4*)((const float*)(p.ws + WS_X1) + (size_t)row * D) + lane; const GAS f32x4* gr = (const GAS f32x4*)p.ln_f_g + lane;
        const GAS unsigned long long* y0 = (const GAS unsigned long long*)((const bf16*)(p.ws + WS_Y0) + (size_t)row * D) + lane; const GAS unsigned long long* y1 = (const GAS unsigned long long*)((const bf16*)(p.ws + WS_Y1) + (size_t)row * D) + lane;
        f32x4 v[8]; float s = 0.f;
#pragma unroll
        for (int j = 0; j < 8; ++j) { v[j] = xr[64 * j]; const unsigned long long a = y0[64 * j], b = y1[64 * j];
            v[j].x += __uint_as_float((unsigned)a << 16) + __uint_as_float((unsigned)b << 16); v[j].y += __uint_as_float((unsigned)a & 0xffff0000u) + __uint_as_float((unsigned)b & 0xffff0000u);
            v[j].z += __uint_as_float((unsigned)(a >> 32) << 16) + __uint_as_float((unsigned)(b >> 32) << 16); v[j].w += __uint_as_float((unsigned)(a >> 32) & 0xffff0000u) + __uint_as_float((unsigned)(b >> 32) & 0xffff0000u);
            s += (v[j].x * v[j].x + v[j].y * v[j].y) + (v[j].z * v[j].z + v[j].w * v[j].w); }
        const float rstd = rsqrtf(wave_sum(s) * (1.f / D) + EPS);
        GAS f32x4* o = (GAS f32x4*)(p.out + (size_t)row * D) + lane;
#pragma unroll
        for (int j = 0; j < 8; ++j) { const f32x4 gv = gr[64 * j]; o[64 * j] = (f32x4){v[j].x * rstd * gv.x, v[j].y * rstd * gv.y, v[j].z * rstd * gv.z, v[j].w * rstd * gv.w}; }
    }
}

__global__ void __launch_bounds__(64) k_attn_naive(Params p) {
    __shared__ __attribute__((aligned(16))) float Ks[64][68];
    __shared__ __attribute__((aligned(16))) float Vs[64][68];
    __shared__ float tab[192];
    const int lane = threadIdx.x, bx = blockIdx.x;
    const int qc = 63 - (bx & 63), rest = bx >> 6, vh = rest & 1, map = (rest >> 1) & 1, h = (rest >> 2) & 7, b = rest >> 5;
    const bf16* QD = (const bf16*)(p.ws + WS_QD); const bf16* KD = (const bf16*)(p.ws + WS_KD); const bf16* VD = (const bf16*)(p.ws + WS_VD); bf16* OA = (bf16*)(p.ws + WS_OA);
    for (int i = lane; i < 191; i += 64) tab[i] = p.rel_bias[t5_bucket(i - 127) * 8 + h] * LOG2E;
    const int t = qc * 64 + lane; const size_t row = (size_t)b * SEQ + t;
    float q[64];
    { const v4u* qp = (const v4u*)(QD + row * 1024 + h * 128 + map * 64);
#pragma unroll
      for (int i = 0; i < 8; ++i) { const v4u w = qp[i];
          q[8 * i + 0] = __uint_as_float(w.x << 16); q[8 * i + 1] = __uint_as_float(w.x & 0xffff0000u); q[8 * i + 2] = __uint_as_float(w.y << 16); q[8 * i + 3] = __uint_as_float(w.y & 0xffff0000u);
          q[8 * i + 4] = __uint_as_float(w.z << 16); q[8 * i + 5] = __uint_as_float(w.z & 0xffff0000u); q[8 * i + 6] = __uint_as_float(w.w << 16); q[8 * i + 7] = __uint_as_float(w.w & 0xffff0000u); } }
    float acc[64];
#pragma unroll
    for (int d = 0; d < 64; ++d) acc[d] = 0.f;
    float m = -INFINITY, l = 0.f;
    for (int kt = 0; kt <= qc; ++kt) {
        __syncthreads();
        { const size_t krow = (size_t)b * SEQ + kt * 64 + lane;
          const v4u* kp = (const v4u*)(KD + krow * 1024 + h * 128 + map * 64);
#pragma unroll
          for (int i = 0; i < 8; ++i) { const v4u w = kp[i];
              *(f32x4*)&Ks[lane][8 * i] = (f32x4){__uint_as_float(w.x << 16), __uint_as_float(w.x & 0xffff0000u), __uint_as_float(w.y << 16), __uint_as_float(w.y & 0xffff0000u)};
              *(f32x4*)&Ks[lane][8 * i + 4] = (f32x4){__uint_as_float(w.z << 16), __uint_as_float(w.z & 0xffff0000u), __uint_as_float(w.w << 16), __uint_as_float(w.w & 0xffff0000u)}; }
          const v4u* vp = (const v4u*)(VD + krow * 1024 + h * 128 + vh * 64);
#pragma unroll
          for (int i = 0; i < 8; ++i) { const v4u w = vp[i];
              *(f32x4*)&Vs[lane][8 * i] = (f32x4){__uint_as_float(w.x << 16), __uint_as_float(w.x & 0xffff0000u), __uint_as_float(w.y << 16), __uint_as_float(w.y & 0xffff0000u)};
              *(f32x4*)&Vs[lane][8 * i + 4] = (f32x4){__uint_as_float(w.z << 16), __uint_as_float(w.z & 0xffff0000u), __uint_as_float(w.w << 16), __uint_as_float(w.w & 0xffff0000u)}; } }
        __syncthreads();
#pragma unroll 1
        for (int j0 = 0; j0 < 64; j0 += 16) {
            float s[16]; float mx = -INFINITY;
#pragma unroll
            for (int jj = 0; jj < 16; ++jj) { float a = 0.f;
#pragma unroll
                for (int d = 0; d < 64; d += 4) { const f32x4 kv = *(const f32x4*)&Ks[j0 + jj][d]; a += q[d] * kv.x + q[d + 1] * kv.y + q[d + 2] * kv.z + q[d + 3] * kv.w; }
                int rel = kt * 64 + j0 + jj - t; rel = rel < -127 ? -127 : rel;
                s[jj] = a + tab[rel + 127]; mx = fmaxf(mx, s[jj]); }
            const float mn = fmaxf(m, mx), sc = __builtin_amdgcn_exp2f(m - mn); l *= sc;
#pragma unroll
            for (int d = 0; d < 64; ++d) acc[d] *= sc;
#pragma unroll
            for (int jj = 0; jj < 16; ++jj) { const float pj = __builtin_amdgcn_exp2f(s[jj] - mn); l += pj;
#pragma unroll
                for (int d = 0; d < 64; d += 4) { const f32x4 vv = *(const f32x4*)&Vs[j0 + jj][d]; acc[d] += pj * vv.x; acc[d + 1] += pj * vv.y; acc[d + 2] += pj * vv.z; acc[d + 3] += pj * vv.w; } }
            m = mn;
        }
    }
    const float inv = 1.f / l;
    v4u* op = (v4u*)(OA + row * 2048 + h * 256 + map * 128 + vh * 64);
#pragma unroll
    for (int i = 0; i < 8; ++i) { v4u w; w.x = pk2(acc[8 * i] * inv, acc[8 * i + 1] * inv); w.y = pk2(acc[8 * i + 2] * inv, acc[8 * i + 3] * inv); w.z = pk2(acc[8 * i + 4] * inv, acc[8 * i + 5] * inv); w.w = pk2(acc[8 * i + 6] * inv, acc[8 * i + 7] * inv); op[i] = w; }
}

__global__ void __launch_bounds__(512, 2) mega_fwd(Params p) {
    extern __shared__ __attribute__((aligned(16))) unsigned char lds[];
    const int tid = threadIdx.x, lane = tid & 63, wave = __builtin_amdgcn_readfirstlane(tid >> 6);
    LAS unsigned char* l3 = (LAS unsigned char*)lds;
    for (int u = tid; u < (LDS_BYTES - LDSCTL_OFF) / 4; u += 512) ((LAS unsigned*)(l3 + LDSCTL_OFF))[u] = 0u;
    __syncthreads();
    XcdBarrier bar = xcd_barrier_post((unsigned*)(p.ws + WS_CTL) + CW_BAR + p.li * XCD_BAR_WORDS, (volatile LAS unsigned*)(l3 + LDSCTL_OFF + 64));
    const int lo = p.ph_lo, hi = p.ph_hi;
#define IN(k) (lo <= (k) && (k) < hi)
#define SEAM(k) do { if (IN(k) && IN((k) + 1)) xcd_barrier(bar); } while (0)
    if (IN(0)) prologue_body(p, l3, blockIdx.x * 8 + wave, gridDim.x * 8, wave, lane);
    SEAM(0);
    if (IN(1)) { pg8::Gemm g{(const pg8::bf16_t*)(p.ws + WS_XN), (const pg8::bf16_t*)(p.ws + WS_WIN), T, NPROJ_PAD, D};
      pg8::StaticOrder S; S.init(T, NPROJ_PAD, gridDim.x, blockIdx.x);
      pg8::EpiInProj E{(pg8::bf16_t*)(p.ws + WS_SEG), (float*)(p.ws + WS_GATES)};
      pg8::gemm_phase<pg8::EpiInProj, pg8::StaticOrder, true, true>(l3, g, S, E); }
    SEAM(1);
    if (IN(2)) ph_conv(p, tid);
    SEAM(2);
    if (IN(3)) {
#ifdef ATTN_IN_MEGA
        { const attn_body::AttnTensors AT{(const attn_body::bf16*)(p.ws + WS_QD), (const attn_body::bf16*)(p.ws + WS_KD), (const attn_body::bf16*)(p.ws + WS_VD), (attn_body::bf16*)(p.ws + WS_OA)};
          const int G = gridDim.x, bx = blockIdx.x; attn_body::attn_phase<8>((char*)lds, AT, (bx % 8) * (G / 8) + bx / 8, p.rel_bias); }
#endif
        ph_mlstm_local(p, lds, tid); }
    SEAM(3);
    if (IN(4)) ph_mlstm_scan(p, tid);
    SEAM(4);
    if (IN(5)) { ph_mlstm_out(p, lds, tid); ph_diff_combine(p, tid); }
    SEAM(5);
    if (IN(6)) { pg8::Gemm g{(const pg8::bf16_t*)(p.ws + WS_A2), (const pg8::bf16_t*)(p.ws + WS_WOUT), T, D, D};
      pg8::StaticOrder S; S.init(T, D, gridDim.x, blockIdx.x);
      pg8::EpiOutProj E{p.x, (float*)(p.ws + WS_X1)};
      pg8::gemm_phase<pg8::EpiOutProj, pg8::StaticOrder, true, true>(l3, g, S, E); }
    SEAM(6);
    if (IN(7)) ph_router(p, l3, tid);
    SEAM(7);
    if (IN(8)) ph_sortcopy(p, lds, tid);
    SEAM(8);
    if (IN(9)) { pg8::Gemm g{(const pg8::bf16_t*)(p.ws + WS_HS), (const pg8::bf16_t*)(p.ws + WS_WGU), MAXROWS, NEXP * 1024, D};
      pg8::MoeSched S{(const int*)(p.ws + WS_TAB), 4, (int)gridDim.x, (int)blockIdx.x};
      pg8::EpiGU E{(pg8::bf16_t*)(p.ws + WS_HID), (const float*)(p.ws + WS_ROWW)};
      pg8::gemm_phase<pg8::EpiGU, pg8::MoeSched, true, true>(l3, g, S, E); }
    SEAM(9);
    if (IN(10)) { pg8::Gemm g{(const pg8::bf16_t*)(p.ws + WS_HID), (const pg8::bf16_t*)(p.ws + WS_WD), MAXROWS, NEXP * 2048, FE};
      pg8::MoeSched S{(const int*)(p.ws + WS_TAB), 8, (int)gridDim.x, (int)blockIdx.x};
      pg8::EpiDown E{(pg8::bf16_t*)(p.ws + WS_Y0), (const int*)(p.ws + WS_ROWTOK), (WS_Y1 - WS_Y0) / 2};
      pg8::gemm_phase<pg8::EpiDown, pg8::MoeSched, true, true>(l3, g, S, E); }
    SEAM(10);
    if (IN(11)) ph_final(p, tid);
#undef IN
#undef SEAM
}

extern "C" void kernel_launch(void* const* d_in, const int* in_sizes, int n_in, void* d_out, int out_size, void* d_ws, size_t ws_size, hipStream_t stream) {
    static int grid = 0;
    if (grid == 0) {
        if (n_in != 24 || in_sizes[0] != T * D || out_size != T * D || ws_size < WS_END) { fprintf(stderr, "kernel_launch: unexpected shapes (n_in %d, in0 %d, out %d, ws %zu)\n", n_in, n_in > 0 ? in_sizes[0] : -1, out_size, ws_size); grid = -1; return; }
        int dev = 0, cus = 0, per_cu = 0;
        if (hipGetDevice(&dev) != hipSuccess || hipDeviceGetAttribute(&cus, hipDeviceAttributeMultiprocessorCount, dev) != hipSuccess) { grid = -1; return; }
        if (hipFuncSetAttribute((const void*)mega_fwd, hipFuncAttributeMaxDynamicSharedMemorySize, LDS_BYTES) != hipSuccess) { fprintf(stderr, "kernel_launch: hipFuncSetAttribute failed\n"); grid = -1; return; }
        if (hipOccupancyMaxActiveBlocksPerMultiprocessor(&per_cu, (const void*)mega_fwd, 512, LDS_BYTES) != hipSuccess || per_cu < 1) { fprintf(stderr, "kernel_launch: occupancy query reports %d workgroups per CU\n", per_cu); }
        (void)hipGetLastError();
        grid = 256;
        if (cus < 256) { fprintf(stderr, "kernel_launch: %d CUs < 256: the persistent grid would not be resident\n", cus); grid = -1; return; }
    }
    if (grid < 0) return;
    if (hipMemsetAsync((char*)d_ws + WS_CTL, 0, CTL_ZERO_BYTES, stream) != hipSuccess) return;
    Params p{};
    const float** pf = (const float**)&p;
    for (int i = 0; i < 24; ++i) pf[i] = (const float*)d_in[i];
    p.out = (float*)d_out; p.ws = (unsigned char*)d_ws;
#ifdef ATTN_IN_MEGA
    p.ph_lo = 0; p.ph_hi = 12; p.li = 0;
    hipLaunchKernelGGL(mega_fwd, dim3(grid), dim3(512), LDS_BYTES, stream, p);
#else
    p.ph_lo = 0; p.ph_hi = 3; p.li = 0;
    hipLaunchKernelGGL(mega_fwd, dim3(grid), dim3(512), LDS_BYTES, stream, p);
    hipLaunchKernelGGL(k_attn_naive, dim3(2 * 8 * 2 * 2 * 64), dim3(64), 0, stream, p);
    p.ph_lo = 3; p.ph_hi = 12; p.li = 1;
    hipLaunchKernelGGL(mega_fwd, dim3(grid), dim3(512), LDS_BYTES, stream, p);
#endif
}
```

```cpp
#include <hip/hip_runtime.h>
#include <cstdio>
#include <cstdint>
#include <cmath>
namespace pg8 {
#define PG8_LAS __attribute__((address_space(3)))
typedef unsigned short bf16_t;
typedef short bf16x8 __attribute__((ext_vector_type(8)));
typedef float f32x4 __attribute__((ext_vector_type(4)));
typedef unsigned u32x4 __attribute__((ext_vector_type(4)));
constexpr int BM = 256, BK = 64, HALF = 128, HTB = HALF * BK * 2  , STAGE_BYTES = 8 * HTB, NXCD = 8, WGM = 8;

__host__ __device__ __forceinline__ int lds_byte(int r, int c) { const int st = (r >> 4) * 2 + (c >> 5), rr = r & 15, cc = c & 31, ob = rr * 64 + cc * 2; return st * 1024 + (ob ^ (((ob >> 9) & 1) << 5)); }
__host__ __device__ __forceinline__ void stage_rc(int b, int& R, int& C) { const int st = b / 1024, sb = b % 1024, swz = sb ^ (((sb >> 9) & 1) << 5); R = (st >> 1) * 16 + swz / 64; C = (st & 1) * 32 + (swz % 64) / 2; }
__host__ __device__ __forceinline__ int perm32(int rho) { const int n = rho >> 4, i = rho & 15; return 8 * (i >> 2) + 4 * n + (i & 3); }

struct Unit { int pm, pn; };
struct Gemm { const bf16_t* A; const bf16_t* Bt; int M, N, K; };

struct StaticOrder {
    int nM, nN, nwg, G, c;
    __host__ __device__ void init(int M, int N, int G_, int c_) { nM = M / BM; nN = N / BM; nwg = nM * nN; G = G_; c = c_; }
    __host__ __device__ bool next(int i, Unit& u) const {
        const long L = (long)i * G + c; if (L >= nwg) return false;
        int wgid = (int)L; { const int q = nwg / NXCD, r = nwg % NXCD, xcd = wgid % NXCD, off = wgid / NXCD; wgid = (xcd < r ? xcd * (q + 1) : r * (q + 1) + (xcd - r) * q) + off; }
        const int nig = WGM * nN, gid = wgid / nig, fm = gid * WGM, gsz = (nM - fm) < WGM ? (nM - fm) : WGM;
        u.pm = fm + ((wgid % nig) % gsz); u.pn = (wgid % nig) / gsz; return true;
    }
    __device__ __forceinline__ void a_ready(const Unit&) const {}
    __device__ __forceinline__ void done(const Unit&) const {}
};

__device__ __forceinline__ unsigned cvt_pk_bf16(float lo, float hi) { unsigned r; asm volatile("v_cvt_pk_bf16_f32 %0, %1, %2" : "=v"(r) : "v"(lo), "v"(hi)); return r; }
typedef float f32x2 __attribute__((ext_vector_type(2)));
constexpr int kT = 8192;
struct MoeSched {
    const int* tab; int nN, G, c;
    __device__ __forceinline__ bool next(int i, Unit& u) const {
        const int MT = tab[0]; const long L = (long)i * G + c; if (L >= (long)MT * nN) return false;
        const int mt = (int)(L / nN), pn = (int)(L % nN); u.pm = mt; u.pn = tab[1 + mt] * nN + pn; return true;
    }
    __device__ __forceinline__ void a_ready(const Unit&) const {}
    __device__ __forceinline__ void done(const Unit&) const {}
};
__device__ __forceinline__ u32x4 pack8(const f32x4 v0, const f32x4 v1) { u32x4 w; w.x = cvt_pk_bf16(v0[0], v0[1]); w.y = cvt_pk_bf16(v0[2], v0[3]); w.z = cvt_pk_bf16(v1[0], v1[1]); w.w = cvt_pk_bf16(v1[2], v1[3]); return w; }
struct EpiInProj {
    static constexpr bool PERM = true, AFTER_DRAIN = false;
    bf16_t* seg; float* gates;
    __device__ __forceinline__ void operator()(const f32x4 (&acc)[2][2][4][2], const Unit& u, int wr, int wc, int fr, int fq) const {
        const int row0 = u.pm * BM + wr * 64 + fr;
        if (u.pn < 28) {
            const int s = u.pn >> 2; bf16_t* base = seg + (size_t)s * ((size_t)kT * 1024);
            const int col0 = (u.pn & 3) * BM + wc * 32 + 8 * fq;
#pragma unroll
            for (int ai = 0; ai < 2; ++ai)
#pragma unroll
                for (int m = 0; m < 4; ++m) { bf16_t* rowp = base + (size_t)(row0 + ai * HALF + m * 16) * 1024 + col0;
#pragma unroll
                    for (int bj = 0; bj < 2; ++bj) *(u32x4*)(rowp + bj * HALF) = pack8(acc[ai][bj][m][0], acc[ai][bj][m][1]); }
        } else if (wc == 0 && fq < 2) {
            float* gp = gates + (size_t)row0 * 16 + 8 * fq;
#pragma unroll
            for (int ai = 0; ai < 2; ++ai)
#pragma unroll
                for (int m = 0; m < 4; ++m) { *(f32x4*)(gp + (size_t)(ai * HALF + m * 16) * 16) = acc[ai][0][m][0]; *(f32x4*)(gp + (size_t)(ai * HALF + m * 16) * 16 + 4) = acc[ai][0][m][1]; }
        }
    }
};
struct EpiOutProj {
    static constexpr bool PERM = false, AFTER_DRAIN = false;
    const float* x; float* x1;
    __device__ __forceinline__ void operator()(const f32x4 (&acc)[2][2][4][2], const Unit& u, int wr, int wc, int fr, int fq) const {
        const int col0 = u.pn * BM + wc * 32 + 4 * fq;
#pragma unroll
        for (int ai = 0; ai < 2; ++ai)
#pragma unroll
            for (int m = 0; m < 4; ++m) { const size_t off = (size_t)(u.pm * BM + ai * HALF + wr * 64 + m * 16 + fr) * 2048 + col0;
#pragma unroll
                for (int bj = 0; bj < 2; ++bj)
#pragma unroll
                    for (int n = 0; n < 2; ++n) { const f32x4 o = acc[ai][bj][m][n] + *(const f32x4*)(x + off + bj * HALF + n * 16); *(f32x4*)(x1 + off + bj * HALF + n * 16) = o; } }
    }
};
__device__ __forceinline__ float silu_f(float g) { return g / (1.f + __expf(-g)); }
struct EpiGU {
    static constexpr bool PERM = true, AFTER_DRAIN = false;
    bf16_t* hid; const float* roww;
    __device__ __forceinline__ void operator()(const f32x4 (&acc)[2][2][4][2], const Unit& u, int wr, int wc, int fr, int fq) const {
        const int pnl = u.pn & 3, row0 = u.pm * BM + wr * 64 + fr, col0 = pnl * 128 + wc * 32 + 8 * fq;
#pragma unroll
        for (int ai = 0; ai < 2; ++ai)
#pragma unroll
            for (int m = 0; m < 4; ++m) { const int r = row0 + ai * HALF + m * 16; const float w = roww[r]; f32x4 h0, h1;
#pragma unroll
                for (int i = 0; i < 4; ++i) { h0[i] = silu_f(acc[ai][0][m][0][i]) * acc[ai][1][m][0][i] * w; h1[i] = silu_f(acc[ai][0][m][1][i]) * acc[ai][1][m][1][i] * w; }
                *(u32x4*)(hid + (size_t)r * 512 + col0) = pack8(h0, h1); }
    }
};
struct EpiDown {
    static constexpr bool PERM = true, AFTER_DRAIN = false;
    bf16_t* y; const int* rowtok; size_t slot_stride;
    __device__ __forceinline__ void operator()(const f32x4 (&acc)[2][2][4][2], const Unit& u, int wr, int wc, int fr, int fq) const {
        const int pnl = u.pn & 7, row0 = u.pm * BM + wr * 64 + fr, col0 = pnl * BM + wc * 32 + 8 * fq;
#pragma unroll
        for (int ai = 0; ai < 2; ++ai)
#pragma unroll
            for (int m = 0; m < 4; ++m) { const int r = row0 + ai * HALF + m * 16; const int ts = rowtok[r];
                if (ts >= 0) { bf16_t* dst = y + (size_t)(ts & 1) * slot_stride + (size_t)(ts >> 1) * 2048 + col0;
#pragma unroll
                    for (int bj = 0; bj < 2; ++bj) *(u32x4*)(dst + bj * HALF) = pack8(acc[ai][bj][m][0], acc[ai][bj][m][1]); } }
    }
};
template <class Epi, class Sched, bool ALIGN_EPI = false, bool SP2 = false>
__device__ __forceinline__ void gemm_phase(PG8_LAS unsigned char* lds, const Gemm g, const Sched& S, const Epi& E) {
    const int tid = threadIdx.x, wid = __builtin_amdgcn_readfirstlane(tid >> 6), lane = tid & 63, wr = wid >> 2, wc = wid & 3, fr = lane & 15, fq = lane >> 4;
    const int K = g.K, nt = K / BK;
    unsigned voffA[2], voffB[2];
#pragma unroll
    for (int i = 0; i < 2; ++i) { int R, C; stage_rc(tid * 16 + i * 8192, R, C); const int Rb = Epi::PERM ? ((R & ~31) + perm32(R & 31)) : R;
        voffA[i] = (unsigned)(R * K + C) * 2u; voffB[i] = (unsigned)(Rb * K + C) * 2u; }
    const size_t kstep = (size_t)(BK * 2);
    const size_t hstep = (size_t)HALF * K * 2;
    const size_t tstep = 2 * hstep;
    const unsigned ldsw = (unsigned)wid * 1024u;
    const int aoff = lds_byte(wr * 64 + fr, fq * 8), boff = lds_byte(wc * 32 + fr, fq * 8);
#define PG8_SA(b, h) (((b) * 2 + (h)) * HTB)
#define PG8_SB(b, h) ((4 + (b) * 2 + (h)) * HTB)
#define PG8_STAGE(bufoff, gbase, voff) do { _Pragma("unroll") for (int _i = 0; _i < 2; ++_i) \
        __builtin_amdgcn_global_load_lds((const unsigned*)((const char*)(gbase) + (voff)[_i]), (PG8_LAS unsigned*)(lds + (bufoff) + ldsw + _i * 8192), 16, 0, 0); } while (0)
#define PG8_LDA(dst, b, h) do { _Pragma("unroll") for (int m = 0; m < 4; ++m) _Pragma("unroll") for (int k = 0; k < 2; ++k) dst[m][k] = *(const PG8_LAS bf16x8*)(lds + PG8_SA(b, h) + aoff + m * 2048 + k * 1024); } while (0)
#define PG8_LDB(dst, b, h) do { _Pragma("unroll") for (int n = 0; n < 2; ++n) _Pragma("unroll") for (int k = 0; k < 2; ++k) dst[n][k] = *(const PG8_LAS bf16x8*)(lds + PG8_SB(b, h) + boff + n * 2048 + k * 1024); } while (0)
#define PG8_MMA(ai, bj, At, Bt) do { __builtin_amdgcn_s_setprio(1); _Pragma("unroll") for (int m = 0; m < 4; ++m) _Pragma("unroll") for (int n = 0; n < 2; ++n) _Pragma("unroll") for (int k = 0; k < 2; ++k) \
        acc[ai][bj][m][n] = __builtin_amdgcn_mfma_f32_16x16x32_bf16(Bt[n][k], At[m][k], acc[ai][bj][m][n], 0, 0, 0); __builtin_amdgcn_s_setprio(0); } while (0)
#define PG8_WAIT_V(n) asm volatile("s_waitcnt vmcnt(" #n ")" ::: "memory")
#define PG8_WAIT_L(n) asm volatile("s_waitcnt lgkmcnt(" #n ")" ::: "memory")
#define PG8_BAR __builtin_amdgcn_s_barrier()
#define PG8_SCHED __builtin_amdgcn_sched_barrier(0)
    Unit cur, nxt; int ui = 0;
    if (!S.next(0, cur)) return;
    f32x4 acc[2][2][4][2];
#pragma unroll
    for (int a = 0; a < 2; ++a)
#pragma unroll
        for (int b = 0; b < 2; ++b)
#pragma unroll
            for (int m = 0; m < 4; ++m)
#pragma unroll
                for (int n = 0; n < 2; ++n) acc[a][b][m][n] = (f32x4){0.f, 0.f, 0.f, 0.f};
    bf16x8 At[4][2], B0[2][2], B1[2][2];
    const char* cA = (const char*)g.A + (size_t)cur.pm * tstep; const char* cB = (const char*)g.Bt + (size_t)cur.pn * tstep;
    S.a_ready(cur);
    if constexpr (SP2) {
        PG8_STAGE(PG8_SB(0, 0), cB, voffB); PG8_STAGE(PG8_SB(0, 1), cB + hstep, voffB); PG8_STAGE(PG8_SA(0, 0), cA, voffA); PG8_STAGE(PG8_SA(0, 1), cA + hstep, voffA);
        if (wr == 1) PG8_BAR;
        PG8_WAIT_V(2); PG8_BAR;
        PG8_STAGE(PG8_SB(1, 0), cB + kstep, voffB); PG8_STAGE(PG8_SA(1, 0), cA + kstep, voffA); PG8_STAGE(PG8_SB(1, 1), cB + hstep + kstep, voffB);
        PG8_WAIT_V(6); PG8_BAR;
    } else {
        PG8_STAGE(PG8_SB(0, 0), cB, voffB); PG8_STAGE(PG8_SA(0, 0), cA, voffA); PG8_STAGE(PG8_SB(0, 1), cB + hstep, voffB); PG8_STAGE(PG8_SA(0, 1), cA + hstep, voffA);
        if (wr == 1) PG8_BAR;
        PG8_WAIT_V(4); PG8_BAR;
        PG8_STAGE(PG8_SB(1, 0), cB + kstep, voffB); PG8_STAGE(PG8_SA(1, 0), cA + kstep, voffA); PG8_STAGE(PG8_SB(1, 1), cB + hstep + kstep, voffB);
        PG8_WAIT_V(6); PG8_BAR;
    }
    for (;;) {
        const bool has_next = S.next(ui + 1, nxt);
        const char* nA = has_next ? (const char*)g.A + (size_t)nxt.pm * tstep : cA; const char* nB = has_next ? (const char*)g.Bt + (size_t)nxt.pn * tstep : cB;
        for (int t = 0; t < nt; t += 2) {
            const bool last = (t == nt - 2);
            const char* a1 = cA + (size_t)(t + 1) * kstep;
            const char* a2 = last ? nA : cA + (size_t)(t + 2) * kstep; const char* b2 = last ? nB : cB + (size_t)(t + 2) * kstep;
            const char* a3 = a2 + kstep; const char* b3 = b2 + kstep;
            if (last && has_next) S.a_ready(nxt);
            if constexpr (SP2) {
            PG8_LDB(B0, 0, 0); PG8_LDB(B1, 0, 1); PG8_SCHED; PG8_LDA(At, 0, 0); PG8_STAGE(PG8_SA(1, 1), a1 + hstep, voffA);
            PG8_WAIT_V(8); PG8_WAIT_L(0); PG8_BAR; PG8_MMA(0, 0, At, B0); PG8_MMA(0, 1, At, B1); PG8_BAR; PG8_SCHED;
            PG8_LDA(At, 0, 1); PG8_STAGE(PG8_SB(0, 0), b2, voffB); PG8_STAGE(PG8_SB(0, 1), b2 + hstep, voffB); PG8_STAGE(PG8_SA(0, 0), a2, voffA);
            PG8_WAIT_V(8); PG8_WAIT_L(0); PG8_BAR; PG8_MMA(1, 0, At, B0); PG8_MMA(1, 1, At, B1); PG8_BAR; PG8_SCHED;
            PG8_LDB(B0, 1, 0); PG8_LDB(B1, 1, 1); PG8_SCHED; PG8_LDA(At, 1, 0); PG8_STAGE(PG8_SA(0, 1), a2 + hstep, voffA);
            PG8_WAIT_V(8); PG8_WAIT_L(0); PG8_BAR; PG8_MMA(0, 0, At, B0); PG8_MMA(0, 1, At, B1); PG8_BAR; PG8_SCHED;
            PG8_LDA(At, 1, 1); PG8_STAGE(PG8_SB(1, 0), b3, voffB); PG8_STAGE(PG8_SB(1, 1), b3 + hstep, voffB); PG8_STAGE(PG8_SA(1, 0), a3, voffA);
            PG8_WAIT_V(8); PG8_WAIT_L(0); PG8_BAR; PG8_MMA(1, 0, At, B0); PG8_MMA(1, 1, At, B1); PG8_BAR; PG8_SCHED;
            } else {
            PG8_LDB(B0, 0, 0); PG8_SCHED; PG8_LDA(At, 0, 0); PG8_STAGE(PG8_SA(1, 1), a1 + hstep, voffA);
            PG8_WAIT_L(8); PG8_BAR; PG8_WAIT_L(0); PG8_MMA(0, 0, At, B0); PG8_BAR; PG8_SCHED;
            PG8_LDB(B1, 0, 1); PG8_STAGE(PG8_SB(0, 0), b2, voffB);
            PG8_BAR; PG8_WAIT_L(0); PG8_MMA(0, 1, At, B1); PG8_BAR;
            PG8_LDA(At, 0, 1); PG8_STAGE(PG8_SA(0, 0), a2, voffA);
            PG8_BAR; PG8_WAIT_L(0); PG8_MMA(1, 0, At, B0); PG8_BAR; PG8_SCHED;
            PG8_STAGE(PG8_SB(0, 1), b2 + hstep, voffB);
            PG8_WAIT_V(6); PG8_BAR; PG8_MMA(1, 1, At, B1); PG8_BAR;
            PG8_LDB(B0, 1, 0); PG8_SCHED; PG8_LDA(At, 1, 0); PG8_STAGE(PG8_SA(0, 1), a2 + hstep, voffA);
            PG8_WAIT_L(8); PG8_BAR; PG8_WAIT_L(0); PG8_MMA(0, 0, At, B0); PG8_BAR; PG8_SCHED;
            PG8_LDB(B1, 1, 1); PG8_STAGE(PG8_SB(1, 0), b3, voffB);
            PG8_BAR; PG8_WAIT_L(0); PG8_MMA(0, 1, At, B1); PG8_BAR;
            PG8_LDA(At, 1, 1); PG8_STAGE(PG8_SA(1, 0), a3, voffA);
            PG8_BAR; PG8_WAIT_L(0); PG8_MMA(1, 0, At, B0); PG8_BAR; PG8_SCHED;
            PG8_STAGE(PG8_SB(1, 1), b3 + hstep, voffB);
            PG8_WAIT_V(6); PG8_BAR; PG8_MMA(1, 1, At, B1); PG8_BAR;
            }
        }
        if constexpr (ALIGN_EPI) { if (wr == 0) PG8_BAR; }
        if constexpr (!Epi::AFTER_DRAIN) { E(acc, cur, wr, wc, fr, fq); S.done(cur); }
        if (!has_next) break;
#pragma unroll
        for (int a = 0; a < 2; ++a)
#pragma unroll
            for (int b = 0; b < 2; ++b)
#pragma unroll
                for (int m = 0; m < 4; ++m)
#pragma unroll
                    for (int n = 0; n < 2; ++n) acc[a][b][m][n] = (f32x4){0.f, 0.f, 0.f, 0.f};
        cur = nxt; cA = nA; cB = nB; ++ui;
        if constexpr (ALIGN_EPI) { if (wr == 1) PG8_BAR; }
    }
    PG8_WAIT_V(0);
    if constexpr (!ALIGN_EPI) { if (wr == 0) PG8_BAR; }
    PG8_BAR;
    if constexpr (Epi::AFTER_DRAIN) { E.fused(acc, cur, wr, wc, fr, fq, lds, wid, lane); S.done(cur); }
#undef PG8_SA
#undef PG8_SB
#undef PG8_STAGE
#undef PG8_LDA
#undef PG8_LDB
#undef PG8_MMA
#undef PG8_WAIT_V
#undef PG8_WAIT_L
#undef PG8_BAR
#undef PG8_SCHED
}
}
#define GAS __attribute__((address_space(1)))
#define LAS __attribute__((address_space(3)))
typedef unsigned short bf16;
typedef unsigned v4u __attribute__((ext_vector_type(4)));
typedef float f32x4 __attribute__((ext_vector_type(4)));
typedef short bf16x8 __attribute__((ext_vector_type(8)));
typedef GAS unsigned gu32;
typedef GAS unsigned long long gu64;
#define RLX_AGENT __ATOMIC_RELAXED, __HIP_MEMORY_SCOPE_AGENT
#define LDS_WAIT() asm volatile("s_waitcnt lgkmcnt(0)" ::: "memory")
#define VM_WAIT() asm volatile("s_waitcnt vmcnt(0)" ::: "memory")
__device__ __forceinline__ unsigned long long rt() { return __builtin_amdgcn_s_memrealtime(); }
__device__ __forceinline__ unsigned f2bf(float f) { unsigned u = __builtin_bit_cast(unsigned, f); return (u + 0x7fffu + ((u >> 16) & 1u)) >> 16; }
__device__ __forceinline__ unsigned pk2(float lo, float hi) { return f2bf(lo) | (f2bf(hi) << 16); }

#define XB_TMO      128
#define XB_XCNT(j)  (256  + 64 * (j))
#define XB_XSUB(j)  (1280 + 64 * (j))
#define XB_XGEN(j)  (2304 + 64 * (j))
#define XB_TOP      3328
#define XB_TOPGEN   3392
#define XCD_BAR_WORDS 3456
#define XB_SPIN_CAP (1u << 18)

__device__ __forceinline__ unsigned xb_ld(unsigned* p)              { return __hip_atomic_load(p, __ATOMIC_RELAXED, __HIP_MEMORY_SCOPE_AGENT); }
__device__ __forceinline__ unsigned xb_add(unsigned* p, unsigned v) { return __hip_atomic_fetch_add(p, v, __ATOMIC_RELAXED, __HIP_MEMORY_SCOPE_AGENT); }
__device__ __forceinline__ unsigned xb_xcc_id() { return (unsigned)__builtin_amdgcn_s_getreg((3 << 11) | 20) & 0xFu; }
#define XB_SPIN(cond, bar) do { unsigned _sp = 0; while (cond) { __builtin_amdgcn_s_sleep(1); \
    if ((++_sp & 255u) == 0u) { if (xb_ld(&(bar)[XB_TMO])) break; if (_sp > XB_SPIN_CAP) { atomicAdd(&(bar)[XB_TMO], 1u); break; } } } } while (0)

struct XcdBarrier {
    unsigned* bar; unsigned x;
    volatile LAS unsigned* st;
};

__device__ __forceinline__ XcdBarrier xcd_barrier_post(unsigned* bar, volatile LAS unsigned* st) {
    XcdBarrier b; b.bar = bar; b.x = xb_xcc_id(); b.st = st;
    if (threadIdx.x == 0) (void)xb_add(&bar[XB_XCNT(b.x)], 1u);
    return b;
}
__device__ __forceinline__ void xcd_barrier_complete(unsigned* bar, unsigned x, unsigned& nloc, unsigned& nx) {
    const unsigned G = gridDim.x * gridDim.y * gridDim.z;
    unsigned sum, cnt, mine, sp = 0u;
    for (;;) {
        sum = 0u; cnt = 0u; mine = 0u;
#pragma unroll
        for (unsigned j = 0; j < 16; ++j) { const unsigned c = xb_ld(&bar[XB_XCNT(j)]); sum += c; cnt += (c > 0u) ? 1u : 0u; mine = (j == x) ? c : mine; }
        if (sum == G) break;
        __builtin_amdgcn_s_sleep(1);
        if ((++sp & 255u) == 0u) { if (xb_ld(&bar[XB_TMO])) break; if (sp > XB_SPIN_CAP) { atomicAdd(&bar[XB_TMO], 1u); break; } }
    }
    nloc = mine > 0u ? mine : 1u; nx = cnt > 0u ? cnt : 1u;
}

__device__ __forceinline__ void xcd_barrier(const XcdBarrier& b) {
    asm volatile("s_waitcnt vmcnt(0)" ::: "memory");
    __syncthreads();
    if (threadIdx.x == 0) {
        unsigned* bar = b.bar;
        __builtin_amdgcn_s_waitcnt(0);
        unsigned nloc = b.st[0], nx = b.st[1];
        if (nloc == 0u) { xcd_barrier_complete(bar, b.x, nloc, nx); b.st[0] = nloc; b.st[1] = nx; }
        const unsigned old = xb_add(&bar[XB_XSUB(b.x)], 1u);
        const unsigned gen = old / nloc;
        if (old + 1u == (gen + 1u) * nloc) {
            __builtin_amdgcn_fence(__ATOMIC_RELEASE, "agent");
            asm volatile("s_waitcnt vmcnt(0)" ::: "memory");
            const unsigned og = xb_add(&bar[XB_TOP], 1u);
            const unsigned tg = og / nx;
            if (og + 1u == (tg + 1u) * nx) xb_add(&bar[XB_TOPGEN], 1u);
            else XB_SPIN(xb_ld(&bar[XB_TOPGEN]) == tg, bar);
            __builtin_amdgcn_fence(__ATOMIC_ACQUIRE, "agent");
            xb_add(&bar[XB_XGEN(b.x)], 1u);
            asm volatile("s_waitcnt vmcnt(0)" ::: "memory");
        } else {
            XB_SPIN(xb_ld(&bar[XB_XGEN(b.x)]) == gen, bar);
            __builtin_amdgcn_fence(__ATOMIC_ACQUIRE, "agent");
            asm volatile("s_waitcnt vmcnt(0)" ::: "memory");
        }
    }
    __syncthreads();
}
#include <hip/hip_bf16.h>
#include <cmath>
namespace attn_body {
using bf16=__hip_bfloat16;
using bf16x8=__attribute__((ext_vector_type(8)))short;
using s16x4=__attribute__((ext_vector_type(4)))short;
using f32x16=__attribute__((ext_vector_type(16)))float;
using u32x4=__attribute__((ext_vector_type(4)))unsigned;
constexpr int BATCH=2,SEQ=4096,D=64,DM=1024,OP=2048;
constexpr int NW=8,QBLK=32,QB=QBLK*NW,KVBLK=64,NQB=SEQ/QB;
constexpr int ATTN_PITCH=DM, ATTN_UNIT_ROWS=QB;
__device__ __forceinline__ int crow(int r,int hi){return (r&3)+8*(r>>2)+4*hi;}
#define SBAR() __builtin_amdgcn_sched_barrier(0)
__device__ __forceinline__ void cmask(f32x16&p0,f32x16&p1,int t,int NT,int wid,int qw,int r32,int hi,const __attribute__((address_space(3))) float*tab){
  const float NEG=-INFINITY; const int jb=t-(NT-4);
  if(jb>(wid>>1)){
    #pragma unroll
    for(int r=0;r<16;++r){p0[r]=NEG;p1[r]=NEG;}
  } else if(64*t>qw-154){
    const __attribute__((address_space(3))) float*tb=tab+(64*t+4*hi-(qw+r32)+191);
    #pragma unroll
    for(int r=0;r<16;++r){p0[r]+=tb[(r&3)+8*(r>>2)];p1[r]+=tb[(r&3)+8*(r>>2)+32];}
  }
}

constexpr int NSLOT=3, SLOTB=8192;
constexpr int LDS_K=0, LDS_V=NSLOT*SLOTB, LDS_WS=2*NSLOT*SLOTB, LDS_OST=LDS_WS+NW*64*4, LDS_BYTES=LDS_OST+NW*4096;
constexpr float C2=0.125f*1.4426950408889634f;
__device__ __forceinline__ void glds16(const void*gsrc,unsigned lds_dst){unsigned keep;
  asm volatile("s_mov_b32 %0, m0\n\ts_mov_b32 m0, %2\n\ts_nop 0\n\tglobal_load_lds_dwordx4 %1, off\n\ts_mov_b32 m0, %0":"=&s"(keep):"v"(gsrc),"s"(lds_dst):"memory");}
__device__ __forceinline__ float max3f(float a,float b,float c){float r;asm("v_max3_f32 %0, %1, %2, %3":"=v"(r):"v"(a),"v"(b),"v"(c));return r;}
__device__ __forceinline__ float max2f(float a,float b){float r;asm("v_max_f32_e32 %0, %1, %2":"=v"(r):"v"(a),"v"(b));return r;}
__device__ __forceinline__ float fadd_s(float a,float b){float r;asm("v_add_f32_e32 %0, %1, %2":"=v"(r):"v"(a),"v"(b));return r;}
__device__ __forceinline__ float fsub_s(float a,float b){float r;asm("v_sub_f32_e32 %0, %1, %2":"=v"(r):"v"(a),"v"(b));return r;}
typedef float f32x2_t __attribute__((ext_vector_type(2))); typedef __bf16 bf16x2_t __attribute__((ext_vector_type(2)));
__device__ __forceinline__ unsigned cvtpk_s(float lo,float hi){f32x2_t v={lo,hi};bf16x2_t b=__builtin_convertvector(v,bf16x2_t);return __builtin_bit_cast(unsigned,b);}
#define WAIT_BAR(N) asm volatile("s_waitcnt vmcnt(" #N ") lgkmcnt(0)\n\ts_barrier":::"memory")

__device__ __forceinline__ void qkt(f32x16&p0,f32x16&p1,const char*Kslot,const bf16x8*qr,const f32x16&negm,int r32,int hi){
  const char*kb=Kslot+hi*1024+r32*16;
  #pragma unroll
  for(int d0=0;d0<4;++d0){
    const bf16x8 b0=*reinterpret_cast<const bf16x8*>(kb+d0*2048);
    const bf16x8 b1=*reinterpret_cast<const bf16x8*>(kb+d0*2048+512);
    if(d0==0){p0=__builtin_amdgcn_mfma_f32_32x32x16_bf16(b0,qr[0],negm,0,0,0);p1=__builtin_amdgcn_mfma_f32_32x32x16_bf16(b1,qr[0],negm,0,0,0);}
    else{p0=__builtin_amdgcn_mfma_f32_32x32x16_bf16(b0,qr[d0],p0,0,0,0);p1=__builtin_amdgcn_mfma_f32_32x32x16_bf16(b1,qr[d0],p1,0,0,0);}}
}
typedef __attribute__((address_space(3))) const char* lds_cptr;
typedef short v4i16_t __attribute__((ext_vector_type(4)));
__device__ __forceinline__ void kload8(bf16x8*kf,lds_cptr kp){
  kf[0]=*(const __attribute__((address_space(3))) bf16x8*)(kp);      kf[1]=*(const __attribute__((address_space(3))) bf16x8*)(kp+512);
  kf[2]=*(const __attribute__((address_space(3))) bf16x8*)(kp+2048); kf[3]=*(const __attribute__((address_space(3))) bf16x8*)(kp+2560);
  kf[4]=*(const __attribute__((address_space(3))) bf16x8*)(kp+4096); kf[5]=*(const __attribute__((address_space(3))) bf16x8*)(kp+4608);
  kf[6]=*(const __attribute__((address_space(3))) bf16x8*)(kp+6144); kf[7]=*(const __attribute__((address_space(3))) bf16x8*)(kp+6656);
}
__device__ __forceinline__ void kload2(bf16x8*kf,lds_cptr kp,int j){ kf[2*j]=*(const __attribute__((address_space(3))) bf16x8*)(kp+j*2048); kf[2*j+1]=*(const __attribute__((address_space(3))) bf16x8*)(kp+j*2048+512); }
__device__ __forceinline__ s16x4 vtr(lds_cptr p){ return __builtin_bit_cast(s16x4,__builtin_amdgcn_ds_read_tr16_b64_v4i16((__attribute__((address_space(3))) v4i16_t*)p)); }
__device__ __forceinline__ float rowmax(const f32x16&p0,const f32x16&p1){
  float a=max3f(p0[0],p0[1],p1[0]),b=max3f(p0[2],p0[3],p1[1]);a=max3f(a,p1[2],p1[3]);
  #pragma unroll
  for(int r=4;r<16;r+=4){a=max3f(a,p0[r],p0[r+1]);b=max3f(b,p0[r+2],p0[r+3]);a=max3f(a,p1[r],p1[r+1]);b=max3f(b,p1[r+2],p1[r+3]);}
  const float m=max2f(a,b);
  auto rr=__builtin_amdgcn_permlane32_swap(__float_as_uint(m),__float_as_uint(m),false,false);
  return max2f(__uint_as_float(rr[0]),__uint_as_float(rr[1]));
}
__device__ __forceinline__ void pv(f32x16*o,int vb,bf16x8 pa0,bf16x8 pa1,bf16x8 pa2,bf16x8 pa3){
  #pragma unroll
  for(int d0=0;d0<2;++d0){s16x4 lo[4],hi[4];
    #pragma unroll
    for(int ks=0;ks<4;++ks){
      asm volatile("ds_read_b64_tr_b16 %0,%1 offset:%c2":"=&v"(lo[ks]):"v"(vb),"i"(d0*4096+ks*1024):"memory");
      asm volatile("ds_read_b64_tr_b16 %0,%1 offset:%c2":"=&v"(hi[ks]):"v"(vb),"i"(d0*4096+ks*1024+512):"memory");}
    asm volatile("s_waitcnt lgkmcnt(0)":::"memory");SBAR();
    #define PK(k) (bf16x8){lo[k][0],lo[k][1],lo[k][2],lo[k][3],hi[k][0],hi[k][1],hi[k][2],hi[k][3]}
    o[d0]=__builtin_amdgcn_mfma_f32_32x32x16_bf16(pa0,PK(0),o[d0],0,0,0);
    o[d0]=__builtin_amdgcn_mfma_f32_32x32x16_bf16(pa1,PK(1),o[d0],0,0,0);
    o[d0]=__builtin_amdgcn_mfma_f32_32x32x16_bf16(pa2,PK(2),o[d0],0,0,0);
    o[d0]=__builtin_amdgcn_mfma_f32_32x32x16_bf16(pa3,PK(3),o[d0],0,0,0);
    #undef PK
  }
}

#ifndef ATTN_STORE16
#define ATTN_STORE16(p,v) (*(u32x4*)(p)=(v))
#endif
template<int THRL> __device__ __forceinline__ void attn_unit(int b,int qcol,int vcol,int ocol,int qb,const bf16*Q,const bf16*__restrict__ K,const bf16*__restrict__ V,bf16*O,char*shm,const __attribute__((address_space(3))) float*tab){
  const int tid=threadIdx.x,lane=tid&63,r32=lane&31,hi=lane>>5; const int wid=__builtin_amdgcn_readfirstlane(tid>>6);
  const long rowbase=(long)b*SEQ; const int q0=qb*QB;
  const bf16*Qw=Q+(rowbase+q0+wid*QBLK)*DM+qcol;
  const bf16*Kh=K+rowbase*DM+qcol,*Vh=V+rowbase*DM+vcol;
  const unsigned lds0=(unsigned)(uintptr_t)shm;
  float*wsf=(float*)(shm+LDS_WS)+wid*64;
  const bf16*ksrc=Kh+(long)lane*DM+wid*8;
  const bf16*vsrc=Vh+(long)(16*(wid&3)+(lane>>2))*DM+(wid>>2)*32+(lane&3)*8;
  const unsigned kdst=lds0+LDS_K+wid*1024, vdst=lds0+LDS_V+wid*1024;
  #define DMA_K(t,slot) glds16(ksrc+(long)(t)*KVBLK*DM,(unsigned)__builtin_amdgcn_readfirstlane(kdst+(slot)))
  #define DMA_V(t,slot) glds16(vsrc+(long)(t)*KVBLK*DM,(unsigned)__builtin_amdgcn_readfirstlane(vdst+(slot)))
  const int vb0=(int)(lds0+LDS_V)+((lane>>4)&1)*32+(lane&3)*8+(4*hi+((lane&15)>>2))*64;
  const char*Kbase=shm+LDS_K; bf16x8 kf[8];
  const lds_cptr shm3=(lds_cptr)shm; const lds_cptr kp0=shm3+LDS_K+hi*1024+r32*16; const lds_cptr vp0=shm3+LDS_V+((lane>>4)&1)*32+(lane&3)*8+(4*hi+((lane&15)>>2))*64;
  const int NT=(q0+QB)/KVBLK;
  DMA_K(0,0);DMA_V(0,0);DMA_K(1,SLOTB);
  bf16x8 qr[4];
  #pragma unroll
  for(int d0=0;d0<4;++d0)qr[d0]=*reinterpret_cast<const bf16x8*>(&Qw[(long)r32*DM+d0*16+hi*8]);
  float mhat=0.f,l_reg=0.f;f32x16 o[2];f32x16 negm; { float z_; asm volatile("v_mov_b32 %0, 0":"=v"(z_)); _Pragma("unroll") for(int r=0;r<16;++r){o[0][r]=z_;o[1][r]=z_;negm[r]=z_;} } asm volatile("":"+v"(negm));
  const int qw=q0+wid*QBLK;
  #define CMASK(P0,P1,t) cmask(P0,P1,(t),NT,wid,qw,r32,hi,tab)
  bool resc=false;
  #define START(P0,P1) do{ const float rm=rowmax(P0,P1); resc=false; \
    { const float dl=rm; mhat=fadd_s(mhat,dl); \
      _Pragma("unroll") for(int r=0;r<16;++r){P0[r]=fsub_s(P0[r],dl);P1[r]=fsub_s(P1[r],dl);} \
      _Pragma("unroll") for(int r=0;r<16;++r)negm[r]=-mhat; asm volatile("":"+v"(negm)); } \
    _Pragma("unroll") for(int r=0;r<16;++r)P0[r]=__builtin_amdgcn_exp2f(P0[r]); }while(0)
  #define RESC() do{ if(resc){ asm volatile("s_waitcnt lgkmcnt(0)":::"memory"); \
      _Pragma("unroll") for(int d_=0;d_<2;++d_) _Pragma("unroll") for(int r=0;r<16;++r)o[d_][r]*=wsf[crow(r,hi)]; } }while(0)
  f32x16 pA0,pA1,pB0,pB1;
  int sl_prev=0,sl_cur=0,sl_next=SLOTB;
  #define ROT() do{sl_prev=sl_cur;sl_cur=sl_next;sl_next=(sl_next==(NSLOT-1)*SLOTB)?0:sl_next+SLOTB;}while(0)
  DMA_K(2,2*SLOTB);
  WAIT_BAR(3);
  qkt(pA0,pA1,Kbase,qr,negm,r32,hi);asm volatile("s_nop 15\n\ts_nop 7":"+v"(pA0),"+v"(pA1));CMASK(pA0,pA1,0);
  START(pA0,pA1);
  _Pragma("unroll") for(int r=0;r<16;++r)pA1[r]=__builtin_amdgcn_exp2f(pA1[r]);
  WAIT_BAR(0);
  DMA_K(3,0);DMA_V(1,SLOTB);
  ROT();
  kload8(kf,kp0+sl_cur);
  WAIT_BAR(2);
  s16x4 vlo[8],vhi[8]; u32x4 pw0,pw1,pw2,pw3;
  #define PKW(P,B) cvtpk_s(P[B],P[B+1])
  #define PAF(k) __builtin_bit_cast(bf16x8,pw##k)
  #define VFR(i) (bf16x8){vlo[i][0],vlo[i][1],vlo[i][2],vlo[i][3],vhi[i][0],vhi[i][1],vhi[i][2],vhi[i][3]}
  #define PIN(x) asm volatile("":"+v"(x))
  #define MX3(a,b,c) __builtin_fmaxf(__builtin_fmaxf((a),(b)),(c))
  #define GAPA(MF,A0,A1,A2,A3,W0,W1,PW) do{ MF; sacc+=A0; sacc+=A1; sacc+=A2; sacc+=A3; PIN(sacc); W0; W1; PIN(PW); SBAR(); }while(0)
  #define EX(v) __builtin_amdgcn_exp2f(v)
  #define GAPB(MF,X,B) do{ MF; X[B]=EX(X[B]); X[B+1]=EX(X[B+1]); X[B+2]=EX(X[B+2]); X[B+3]=EX(X[B+3]); PIN(X); SBAR(); }while(0)
  #define VRD(i) do{ vlo[i]=vtr(vp_+(((i)>>2)*4096+((i)&3)*1024)); vhi[i]=vtr(vp_+(((i)>>2)*4096+((i)&3)*1024+512)); }while(0)
  #define KRD(G,j) do{ if(G){ kload2(kf,kp0+sl_next,j); SBAR(); } }while(0)
  #define STEP(C0,C1,P0,P1,t,GK,GV,GL) do{ SBAR(); \
    const lds_cptr vp_=vp0+sl_prev; \
    VRD(0); SBAR(); float sacc=(P0[0]+P0[1]); \
    GAPA(C0=__builtin_amdgcn_mfma_f32_32x32x16_bf16(kf[0],qr[0],negm,0,0,0), P0[2],P0[3],P0[4],P0[5],     pw0[0]=PKW(P0,0), pw0[1]=PKW(P0,2), pw0); \
    VRD(4); SBAR(); GAPA(C1=__builtin_amdgcn_mfma_f32_32x32x16_bf16(kf[1],qr[0],negm,0,0,0), P0[6],P0[7],P0[8],P0[9],     pw0[2]=PKW(P0,4), pw0[3]=PKW(P0,6), pw0); \
    VRD(1); SBAR(); GAPA(C0=__builtin_amdgcn_mfma_f32_32x32x16_bf16(kf[2],qr[1],C0,0,0,0),   P0[10],P0[11],P0[12],P0[13], pw1[0]=PKW(P0,8), pw1[1]=PKW(P0,10), pw1); \
    VRD(5); SBAR(); GAPA(C1=__builtin_amdgcn_mfma_f32_32x32x16_bf16(kf[3],qr[1],C1,0,0,0),   P0[14],P0[15],P1[0],P1[1],   pw1[2]=PKW(P0,12),pw1[3]=PKW(P0,14), pw1); \
    VRD(2); SBAR(); GAPA(C0=__builtin_amdgcn_mfma_f32_32x32x16_bf16(kf[4],qr[2],C0,0,0,0),   P1[2],P1[3],P1[4],P1[5],     pw2[0]=PKW(P1,0), pw2[1]=PKW(P1,2), pw2); \
    VRD(6); SBAR(); GAPA(C1=__builtin_amdgcn_mfma_f32_32x32x16_bf16(kf[5],qr[2],C1,0,0,0),   P1[6],P1[7],P1[8],P1[9],     pw2[2]=PKW(P1,4), pw2[3]=PKW(P1,6), pw2); \
    VRD(3); SBAR(); GAPA(C0=__builtin_amdgcn_mfma_f32_32x32x16_bf16(kf[6],qr[3],C0,0,0,0),   P1[10],P1[11],P1[12],P1[13], pw3[0]=PKW(P1,8), pw3[1]=PKW(P1,10), pw3); \
    VRD(7); SBAR(); GAPA(C1=__builtin_amdgcn_mfma_f32_32x32x16_bf16(kf[7],qr[3],C1,0,0,0),   P1[14],P1[15],0.f,0.f,       pw3[2]=PKW(P1,12),pw3[3]=PKW(P1,14), pw3); \
    l_reg+=sacc; \
    if(GK){DMA_K((t)+3,sl_cur);} if(GV){DMA_V((t)+1,sl_next);} \
    CMASK(C0,C1,t); \
    { float a=MX3(C0[0],C0[1],C1[0]),b=MX3(C0[2],C0[3],C1[1]); a=MX3(a,C1[2],C1[3]); \
      _Pragma("unroll") for(int r=4;r<16;r+=4){a=MX3(a,C0[r],C0[r+1]);b=MX3(b,C0[r+2],C0[r+3]);a=MX3(a,C1[r],C1[r+1]);b=MX3(b,C1[r+2],C1[r+3]);} \
      float rm=__builtin_fmaxf(a,b); { auto rr=__builtin_amdgcn_permlane32_swap(__float_as_uint(rm),__float_as_uint(rm),false,false); rm=__builtin_fmaxf(__uint_as_float(rr[0]),__uint_as_float(rr[1])); } \
      resc=false; \
      if(__builtin_expect(__any(rm>(float)THRL),0)){ const float dl=__builtin_fmaxf(rm,0.f); mhat+=dl; \
        _Pragma("unroll") for(int r=0;r<16;++r){C0[r]-=dl;C1[r]-=dl;} \
        _Pragma("unroll") for(int r=0;r<16;++r)negm[r]=-mhat; asm volatile("":"+v"(negm)); \
        const float f=__builtin_amdgcn_exp2f(-dl); l_reg*=f; if(hi==0)wsf[r32]=f; resc=true; } } \
    SBAR(); \
    GAPB(o[0]=__builtin_amdgcn_mfma_f32_32x32x16_bf16(PAF(0),VFR(0),o[0],0,0,0), C0,0); \
    GAPB(o[1]=__builtin_amdgcn_mfma_f32_32x32x16_bf16(PAF(0),VFR(4),o[1],0,0,0), C0,4); \
    KRD(GL,0); GAPB(o[0]=__builtin_amdgcn_mfma_f32_32x32x16_bf16(PAF(1),VFR(1),o[0],0,0,0), C0,8); \
    KRD(GL,1); GAPB(o[1]=__builtin_amdgcn_mfma_f32_32x32x16_bf16(PAF(1),VFR(5),o[1],0,0,0), C0,12); \
    KRD(GL,2); GAPB(o[0]=__builtin_amdgcn_mfma_f32_32x32x16_bf16(PAF(2),VFR(2),o[0],0,0,0), C1,0); \
    KRD(GL,3); GAPB(o[1]=__builtin_amdgcn_mfma_f32_32x32x16_bf16(PAF(2),VFR(6),o[1],0,0,0), C1,4); \
    GAPB(o[0]=__builtin_amdgcn_mfma_f32_32x32x16_bf16(PAF(3),VFR(3),o[0],0,0,0), C1,8); \
    GAPB(o[1]=__builtin_amdgcn_mfma_f32_32x32x16_bf16(PAF(3),VFR(7),o[1],0,0,0), C1,12); \
    }while(0)
  int t=1;
  #undef CMASK
  #define CMASK(P0,P1,t) do{}while(0)
  for(;t+7<NT;t+=2){
    STEP(pB0,pB1,pA0,pA1,t,true,true,true);     WAIT_BAR(2); RESC(); ROT();
    STEP(pA0,pA1,pB0,pB1,t+1,true,true,true);   WAIT_BAR(2); RESC(); ROT();
  }
  #undef CMASK
  #define CMASK(P0,P1,t) cmask(P0,P1,(t),NT,wid,qw,r32,hi,tab)
  #define ENDW(tt) do{ if((tt)+3<NT){WAIT_BAR(2);} else if((tt)+2<NT){WAIT_BAR(1);} else {WAIT_BAR(0);} }while(0)
  for(;t+1<NT;t+=2){
    STEP(pB0,pB1,pA0,pA1,t,(t+3<NT),(t+1<NT),(t+1<NT));       ENDW(t);   RESC(); ROT();
    STEP(pA0,pA1,pB0,pB1,t+1,(t+4<NT),(t+2<NT),(t+2<NT));     ENDW(t+1); RESC(); ROT();
  }
  STEP(pB0,pB1,pA0,pA1,NT-1,false,false,false); RESC();
  { float sacc=pB0[0]+pB0[1]; _Pragma("unroll") for(int r=2;r<16;++r)sacc+=pB0[r]; _Pragma("unroll") for(int r=0;r<16;++r)sacc+=pB1[r]; l_reg+=sacc;
    pw0=(u32x4){PKW(pB0,0),PKW(pB0,2),PKW(pB0,4),PKW(pB0,6)};pw1=(u32x4){PKW(pB0,8),PKW(pB0,10),PKW(pB0,12),PKW(pB0,14)};pw2=(u32x4){PKW(pB1,0),PKW(pB1,2),PKW(pB1,4),PKW(pB1,6)};pw3=(u32x4){PKW(pB1,8),PKW(pB1,10),PKW(pB1,12),PKW(pB1,14)};
    SBAR(); pv(o,vb0+sl_cur,PAF(0),PAF(1),PAF(2),PAF(3)); }
  #undef PKW
  #undef PAF
  #undef VFR
  #undef PIN
  #undef MX3
  #undef GAPA
  #undef GAPB
  #undef EX
  #undef VRD
  #undef KRD
  #undef STEP
  #undef ENDW
  {auto rr=__builtin_amdgcn_permlane32_swap(__float_as_uint(l_reg),__float_as_uint(l_reg),false,false);l_reg=__uint_as_float(rr[0])+__uint_as_float(rr[1]);}
  if(hi==0)wsf[32+r32]=l_reg;asm volatile("s_waitcnt lgkmcnt(0)":::"memory");
  float rli[16];
  #pragma unroll
  for(int r=0;r<16;++r)rli[r]=__builtin_amdgcn_rcpf(wsf[32+crow(r,hi)]);
  bf16*Ow=O+(rowbase+q0+wid*QBLK)*OP+ocol;
  { bf16*stg=(bf16*)(shm+LDS_OST)+wid*2048;
    #pragma unroll
    for(int r=0;r<16;++r){const int orow=crow(r,hi);
      #pragma unroll
      for(int d0=0;d0<2;++d0)stg[orow*64+d0*32+r32]=__float2bfloat16(o[d0][r]*rli[r]);}
    asm volatile("s_waitcnt lgkmcnt(0)":::"memory");
    #pragma unroll
    for(int i=0;i<4;++i){const int row=i*8+(lane>>3),ch=lane&7; const u32x4 v=*(const u32x4*)(stg+row*64+ch*8); ATTN_STORE16(Ow+(long)row*OP+ch*8,v);} }
  asm volatile("s_waitcnt lgkmcnt(0)\n\ts_barrier":::"memory");
  #undef DMA_K
  #undef DMA_V
  #undef CMASK
  #undef START
  #undef RESC
  #undef ROT
}
constexpr int ATTN_LDS_BYTES=LDS_BYTES;
struct AttnTensors { const bf16* Q; const bf16* K; const bf16* V; bf16* O; };
template<int THRL=8> __device__ __forceinline__ void attn_phase(char*lds,const AttnTensors&T,int vcu,const float*rel_bias){
  const int hc=vcu>>2,s=vcu&3,vh=hc&1,map=(hc>>1)&1,h=(hc>>2)&7,b=hc>>5;
  __attribute__((address_space(3))) float*tab=(__attribute__((address_space(3))) float*)(lds+LDS_BYTES);
  { const float c15=rel_bias[15*8+h];
    for(int i=threadIdx.x;i<256;i+=512){ const int rel=i-191; const int n=rel<0?-rel:rel;
      int bk=n<8?n:n<12?8:n<16?9:n<23?10:n<32?11:n<46?12:n<64?13:n<91?14:15; if(rel>0)bk+=16;
      tab[i]=(rel_bias[bk*8+h]-c15)*1.4426950408889634f; } }
  asm volatile("s_waitcnt lgkmcnt(0)\n\ts_barrier":::"memory");
  #pragma unroll 1
  for(int i=0;i<4;++i){ const int qb=(i==0)?s:(i==1)?7-s:(i==2)?8+s:15-s;
    attn_unit<THRL>(b,h*128+map*64,h*128+vh*64,h*256+map*128+vh*64,qb,T.Q,T.K,T.V,T.O,lds,tab); }
}
#undef SBAR
#undef WAIT_BAR
}

constexpr int BATCH = 2, SEQ = 4096, T = BATCH * SEQ, D = 2048;
constexpr int NPROJ = 7184, NPROJ_PAD = 7424, SEGW = 1024;
constexpr int NH = 8, CH = 64, NCH = SEQ / CH;
constexpr int NEXP = 32, FE = 512;
constexpr float EPS = 1e-6f, LOG2E = 1.4426950408889634f;
constexpr float QSCALE = 0.125f * LOG2E;
static_assert(T == pg8::kT, "token count");

constexpr size_t MiB = 1u << 20;
constexpr size_t WS_CTL = 0, CTL_ZERO_BYTES = 1 * MiB;
constexpr size_t WS_WIN = 1 * MiB, WS_WOUT = 30 * MiB, WS_WGU = 38 * MiB, WS_WD = 166 * MiB;
constexpr size_t WS_XN = 230 * MiB, WS_SEG = 262 * MiB, WS_GATES = 374 * MiB, WS_OA = 375 * MiB, WS_QC = 407 * MiB, WS_KC = 423 * MiB, WS_CLOC = 439 * MiB, WS_MISC = 503 * MiB, WS_END = 505 * MiB;
constexpr size_t SEG_BYTES = (size_t)T * SEGW * 2;
constexpr size_t WS_QD = WS_SEG, WS_KD = WS_SEG + SEG_BYTES, WS_VD = WS_SEG + 2 * SEG_BYTES, WS_QM = WS_SEG + 3 * SEG_BYTES, WS_KM = WS_SEG + 4 * SEG_BYTES, WS_VM = WS_SEG + 5 * SEG_BYTES, WS_OM = WS_SEG + 6 * SEG_BYTES;
constexpr size_t WS_BCUM = WS_MISC, WS_NLOC = WS_MISC + 256 * 1024, WS_G = WS_MISC + MiB, WS_MLOC = WS_G + 4096, WS_MPREV = WS_G + 8192;
constexpr size_t WS_A2 = WS_XN, WS_X1 = 262 * MiB, WS_H2 = 326 * MiB, WS_LIST = 358 * MiB, WS_LISTW = 359 * MiB, WS_ROWTOK = 360 * MiB, WS_ROWW = 360 * MiB + 512 * 1024, WS_TAB = 361 * MiB;
constexpr size_t WS_HS = 375 * MiB, WS_HID = 471 * MiB, WS_Y0 = 230 * MiB, WS_Y1 = 326 * MiB;
constexpr int MAXROWS = 24576;
constexpr int CW_CNT = 32768;

struct Params {
    const float *x, *rel_bias, *ln_mix_g, *w_in, *conv_w, *conv_b, *b_i, *b_f, *lam_q1, *lam_k1, *lam_q2, *lam_k2, *diff_norm_g, *mlstm_norm_g, *w_out, *ln_ffn_g,
                *w_group, *b_group, *w_router, *b_router, *w_gate, *w_up, *w_down, *ln_f_g;
    float* out; unsigned char* ws;
    int ph_lo, ph_hi, li, pad;
};

__device__ __forceinline__ float bf2f(unsigned short v) { return __uint_as_float((unsigned)v << 16); }
__device__ __forceinline__ float wave_sum(float v) {
#pragma unroll
    for (int o = 1; o < 64; o <<= 1) v += __shfl_xor(v, o);
    return v;
}
__device__ __forceinline__ float wave_max(float v) {
#pragma unroll
    for (int o = 1; o < 64; o <<= 1) v = fmaxf(v, __shfl_xor(v, o));
    return v;
}
__device__ __forceinline__ int t5_bucket(int rel) {
    const int n = rel < 0 ? -rel : rel;
    int b = n < 8 ? n : n < 12 ? 8 : n < 16 ? 9 : n < 23 ? 10 : n < 32 ? 11 : n < 46 ? 12 : n < 64 ? 13 : n < 91 ? 14 : 15;
    return b + (rel > 0 ? 16 : 0);
}

__device__ __forceinline__ unsigned cvtpk_rne(float lo, float hi) { typedef float f2_t __attribute__((ext_vector_type(2))); typedef __bf16 b2_t __attribute__((ext_vector_type(2))); f2_t v = {lo, hi}; b2_t b = __builtin_convertvector(v, b2_t); return __builtin_bit_cast(unsigned, b); }
__device__ __forceinline__ void conv_block64(const float* src, size_t ld, bf16* dst, size_t kd, int lane, int nvalid, float sc, LAS unsigned char* scr  ) {
    if (lane < nvalid) {
        const GAS float* s = (const GAS float*)src + lane; float v[64];
#pragma unroll
        for (int i = 0; i < 64; ++i) v[i] = s[(size_t)i * ld];
        LAS v4u* w = (LAS v4u*)(scr + lane * 144);
#pragma unroll
        for (int g = 0; g < 8; ++g) { v4u o; o.x = cvtpk_rne(v[8 * g] * sc, v[8 * g + 1] * sc); o.y = cvtpk_rne(v[8 * g + 2] * sc, v[8 * g + 3] * sc); o.z = cvtpk_rne(v[8 * g + 4] * sc, v[8 * g + 5] * sc); o.w = cvtpk_rne(v[8 * g + 6] * sc, v[8 * g + 7] * sc); w[g] = o; }
    }
    LDS_WAIT(); asm volatile("" ::: "memory");
    const int c = lane & 7;
#pragma unroll
    for (int j = 0; j < 8; ++j) { const int n = (lane >> 3) + 8 * j; if (n < nvalid) { const v4u o = *(const LAS v4u*)(scr + n * 144 + c * 16); *(GAS v4u*)(dst + (size_t)n * kd + 8 * c) = o; } }
    LDS_WAIT(); asm volatile("" ::: "memory");
}
__device__ __forceinline__ void rms_row_to_bf16(const float* xrow, const float* g, bf16* orow, int lane) {
    const GAS f32x4* xr = (const GAS f32x4*)xrow + lane; const GAS f32x4* gr = (const GAS f32x4*)g + lane;
    f32x4 v[8]; float s = 0.f;
#pragma unroll
    for (int j = 0; j < 8; ++j) { v[j] = xr[64 * j]; s += (v[j].x * v[j].x + v[j].y * v[j].y) + (v[j].z * v[j].z + v[j].w * v[j].w); }
    const float rstd = rsqrtf(wave_sum(s) * (1.f / D) + EPS);
    GAS unsigned long long* o8 = (GAS unsigned long long*)orow + lane;
#pragma unroll
    for (int j = 0; j < 8; ++j) { const f32x4 gv = gr[64 * j];
        o8[64 * j] = (unsigned long long)pk2(v[j].x * rstd * gv.x, v[j].y * rstd * gv.y) | ((unsigned long long)pk2(v[j].z * rstd * gv.z, v[j].w * rstd * gv.w) << 32); }
}
__device__ __forceinline__ void prologue_body(const Params& p, int gw, int NGW, int lane, LAS unsigned char* scr) {
    bf16* Win = (bf16*)(p.ws + WS_WIN); bf16* XN = (bf16*)(p.ws + WS_XN);
    constexpr int I_IN = 32 * 112, I_ING = 32;
    for (int it = gw; it < I_IN + I_ING; it += NGW) {
        if (it < I_IN) { const int kb = it / 112, nb = it % 112; conv_block64(p.w_in + (size_t)(64 * kb) * NPROJ + 64 * nb, NPROJ, Win + (size_t)(64 * nb) * D + 64 * kb, D, lane, 64, nb < 16 ? QSCALE : 1.f, scr); }
        else { const int kb = it - I_IN; conv_block64(p.w_in + (size_t)(64 * kb) * NPROJ + 7168, NPROJ, Win + (size_t)7168 * D + 64 * kb, D, lane, 16, 1.f, scr); }
    }
    for (int r = gw; r < NPROJ_PAD - NPROJ; r += NGW) { GAS v4u* o = (GAS v4u*)(Win + (size_t)(NPROJ + r) * D) + lane; const v4u z = {0u, 0u, 0u, 0u};
#pragma unroll
        for (int j = 0; j < 4; ++j) o[64 * j] = z; }
    for (int m = gw; m < T; m += NGW) rms_row_to_bf16(p.x + (size_t)m * D, p.ln_mix_g, XN + (size_t)m * D, lane);
}
constexpr int CW_Q = 40960;
struct CvItem { const float* src; bf16* dst; int ld, kd; };
__device__ __forceinline__ CvItem cv_decode(const Params& p, int r) {
    constexpr int I_OUT = 32 * 32, I_G = NEXP * 32 * 8;
    CvItem it;
    if (r < I_OUT) { const int kb = r >> 5, nb = r & 31; it.src = p.w_out + (size_t)(64 * kb) * D + 64 * nb; it.ld = D; it.dst = (bf16*)(p.ws + WS_WOUT) + (size_t)(64 * nb) * D + 64 * kb; it.kd = D; return it; } r -= I_OUT;
    if (r < 2 * I_G) { const int up = (r >= I_G) ? 1 : 0; if (up) r -= I_G; const int e = r >> 8, qq = r & 255, kb = qq >> 3, nb = qq & 7;
        it.src = (up ? p.w_up : p.w_gate) + (size_t)e * D * FE + (size_t)(64 * kb) * FE + 64 * nb; it.ld = FE;
        const int f0 = 64 * nb, rowb = e * 1024 + (f0 >> 7) * 256 + up * 128 + (f0 & 127);
        it.dst = (bf16*)(p.ws + WS_WGU) + (size_t)rowb * D + 64 * kb; it.kd = D; return it; } r -= 2 * I_G;
    { const int e = r >> 8, qq = r & 255, kb = qq >> 5, nb = qq & 31;
      it.src = p.w_down + (size_t)e * FE * D + (size_t)(64 * kb) * D + 64 * nb; it.ld = D; it.dst = (bf16*)(p.ws + WS_WD) + ((size_t)e * 2048 + 64 * nb) * FE + 64 * kb; it.kd = FE; return it; }
}
__device__ __forceinline__ void cv_load(const CvItem& it, int lane, float (&v)[64]) {
    const GAS float* s = (const GAS float*)it.src + lane;
#pragma unroll
    for (int i = 0; i < 64; ++i) v[i] = s[(size_t)i * it.ld];
}
__device__ __forceinline__ void cv_finish(const CvItem& it, int lane, const float (&v)[64], LAS unsigned char* scr) {
    LAS v4u* w = (LAS v4u*)(scr + lane * 144);
#pragma unroll
    for (int g = 0; g < 8; ++g) { v4u o; o.x = cvtpk_rne(v[8 * g], v[8 * g + 1]); o.y = cvtpk_rne(v[8 * g + 2], v[8 * g + 3]); o.z = cvtpk_rne(v[8 * g + 4], v[8 * g + 5]); o.w = cvtpk_rne(v[8 * g + 6], v[8 * g + 7]); w[g] = o; }
    LDS_WAIT(); asm volatile("" ::: "memory");
    const int c = lane & 7;
#pragma unroll
    for (int j = 0; j < 8; ++j) { const int n = (lane >> 3) + 8 * j; const v4u o = *(const LAS v4u*)(scr + n * 144 + c * 16); *(GAS v4u*)(it.dst + (size_t)n * it.kd + 8 * c) = o; }
    LDS_WAIT(); asm volatile("" ::: "memory");
}
__device__ __forceinline__ void convert_queue(const Params& p, int lane, LAS unsigned char* scr) {
    unsigned* q = (unsigned*)(p.ws + WS_CTL) + CW_Q;
    constexpr int NITEMS = 32 * 32 + 2 * NEXP * 32 * 8 + NEXP * 8 * 32;
    static_assert(NITEMS % 8 == 0, "whole batches");
    for (;;) {
        int r0 = 0; if (lane == 0) r0 = (int)__hip_atomic_fetch_add(q, 8u, RLX_AGENT);
        r0 = __builtin_amdgcn_readfirstlane(r0);
        if (r0 >= NITEMS) break;
        float va[64], vb[64];
        CvItem ia = cv_decode(p, r0), ib;
        cv_load(ia, lane, va);
#pragma unroll 1
        for (int i = 0; i < 8; i += 2) {
            ib = cv_decode(p, r0 + i + 1); cv_load(ib, lane, vb);
            cv_finish(ia, lane, va, scr);
            if (i + 2 < 8) { ia = cv_decode(p, r0 + i + 2); cv_load(ia, lane, va); }
            cv_finish(ib, lane, vb, scr);
        }
    }
}
#define ATTN_IN_MEGA 1

constexpr int LDS_BYTES = 147456;
constexpr int LDSCTL_OFF = 146432;
constexpr int GEMM1_WGS = 232;
constexpr int CW_BAR = 4096;

namespace mls {
typedef short bf16x8 __attribute__((ext_vector_type(8)));
typedef float f32x16 __attribute__((ext_vector_type(16)));
typedef float f32x2_t __attribute__((ext_vector_type(2))); typedef __bf16 bf16x2_t __attribute__((ext_vector_type(2)));
__device__ __forceinline__ unsigned cvtpk(float lo, float hi) { f32x2_t v = {lo, hi}; bf16x2_t b = __builtin_convertvector(v, bf16x2_t); return __builtin_bit_cast(unsigned, b); }
__device__ __forceinline__ int crow(int r, int hi) { return (r & 3) + 8 * (r >> 2) + 4 * hi; }
__device__ __forceinline__ bf16x8 pack8(float a0, float a1, float a2, float a3, float a4, float a5, float a6, float a7) {
    v4u w; w.x = cvtpk(a0, a1); w.y = cvtpk(a2, a3); w.z = cvtpk(a4, a5); w.w = cvtpk(a6, a7); return __builtin_bit_cast(bf16x8, w); }
#define MLS_MFMA(a, b, c) __builtin_amdgcn_mfma_f32_32x32x16_bf16((a), (b), (c), 0, 0, 0)
}
constexpr int MO_HT = 132;
__device__ __forceinline__ void ph_mlstm_out(const Params& p, LAS unsigned char* lds, int tid) {
    using namespace mls;
    const int lane = tid & 63, wid = __builtin_amdgcn_readfirstlane(tid >> 6), r32 = lane & 31, hi = lane >> 5, tb = wid & 1, dq = wid >> 1;
    LAS float* Ht = (LAS float*)lds;
    LAS float* wsc = (LAS float*)(lds + 64 * MO_HT * 4) + wid * 256;
    const float* GATES = (const float*)(p.ws + WS_GATES); const bf16* VM = (const bf16*)(p.ws + WS_VM); const bf16* KC = (const bf16*)(p.ws + WS_KC); const bf16* QC = (const bf16*)(p.ws + WS_QC); const bf16* OM = (const bf16*)(p.ws + WS_OM);
    const float* BCUM = (const float*)(p.ws + WS_BCUM); const float* MPREV = (const float*)(p.ws + WS_MPREV);
    bf16* A2 = (bf16*)(p.ws + WS_A2);
    for (int bx = blockIdx.x; bx < 1024; bx += gridDim.x) {
        const int bh = bx >> 6, c = bx & 63, b = bh >> 3, h = bh & 7, hc = h * 128; const size_t row0 = (size_t)b * SEQ + c * 64;
        const bf16* CPREV = (const bf16*)(p.ws + WS_CLOC) + (size_t)bx * 16384; const float* NPREV = (const float*)(p.ws + WS_NLOC) + (size_t)bx * 128;
        const float mprev = MPREV[bx];
        { const float bl = BCUM[(size_t)bx * 64 + lane], al = GATES[(row0 + lane) * 16 + h] + p.b_i[h] - bl;
          float pm = al;
#pragma unroll
          for (int off = 1; off < 64; off <<= 1) { const float o = __shfl_up(pm, off); if (lane >= off) pm = fmaxf(pm, o); }
          wsc[lane] = al; wsc[64 + lane] = fmaxf(pm, mprev); wsc[128 + lane] = bl; }
        const int t = 32 * tb + r32;
        bf16x8 qf[8];
        { const bf16* qp = QC + (row0 + t) * 1024 + hc + 8 * hi;
#pragma unroll
          for (int k = 0; k < 8; ++k) qf[k] = *(const bf16x8*)(qp + 16 * k); }
        f32x16 X[2];
#pragma unroll
        for (int sb = 0; sb < 2; ++sb) {
#pragma unroll
            for (int i = 0; i < 16; ++i) X[sb][i] = 0.f;
            if (sb <= tb) { const bf16* kp = KC + (row0 + 32 * sb + r32) * 1024 + hc + 8 * hi;
                bf16x8 kf[8];
#pragma unroll
                for (int k = 0; k < 8; ++k) kf[k] = *(const bf16x8*)(kp + 16 * k);
#pragma unroll
                for (int k = 0; k < 8; ++k) X[sb] = MLS_MFMA(kf[k], qf[k], X[sb]); } }
        f32x16 acc;
#pragma unroll
        for (int i = 0; i < 16; ++i) acc[i] = 0.f;
        { const bf16* cp = CPREV + (32 * dq + r32) * 128 + 8 * hi;
#pragma unroll
          for (int k = 0; k < 8; ++k) acc = MLS_MFMA(qf[k], *(const bf16x8*)(cp + 16 * k), acc); }
        float qn = 0.f;
        { const float* np = NPREV + 8 * hi;
#pragma unroll
          for (int k = 0; k < 8; ++k) { const f32x4 n0 = *(const f32x4*)(np + 16 * k), n1 = *(const f32x4*)(np + 16 * k + 4);
              qn += bf2f((unsigned short)qf[k][0]) * n0.x + bf2f((unsigned short)qf[k][1]) * n0.y + bf2f((unsigned short)qf[k][2]) * n0.z + bf2f((unsigned short)qf[k][3]) * n0.w
                  + bf2f((unsigned short)qf[k][4]) * n1.x + bf2f((unsigned short)qf[k][5]) * n1.y + bf2f((unsigned short)qf[k][6]) * n1.z + bf2f((unsigned short)qf[k][7]) * n1.w; } }
        qn += __shfl_xor(qn, 32);
        LDS_WAIT(); asm volatile("" ::: "memory");
        const float Mt = wsc[64 + t], bt = wsc[128 + t];
        float den1 = 0.f;
#pragma unroll
        for (int sb = 0; sb < 2; ++sb)
#pragma unroll
            for (int i = 0; i < 16; ++i) { const int s = 32 * sb + crow(i, hi); const float w = (s <= t) ? __expf(wsc[s] - Mt) : 0.f; X[sb][i] *= w; den1 += X[sb][i]; }
        den1 += __shfl_xor(den1, 32);
        const float inter_t = __expf(mprev - Mt);
        const float rd = 1.f / fmaxf(fabsf(den1 + inter_t * qn), __expf(-(bt + Mt)));
        if (hi == 0) wsc[192 + t] = rd;
#pragma unroll
        for (int i = 0; i < 16; ++i) acc[i] *= __expf(mprev - wsc[64 + 32 * tb + crow(i, hi)]);
#pragma unroll
        for (int sb = 0; sb < 2; ++sb) if (sb <= tb) {
#pragma unroll
            for (int st = 0; st < 2; ++st) {
                const bf16* vp = VM + (row0 + 32 * sb + 16 * st + 4 * hi) * 1024 + hc + 32 * dq + r32;
                unsigned short v[8];
#pragma unroll
                for (int j = 0; j < 8; ++j) v[j] = vp[(size_t)(8 * (j >> 2) + (j & 3)) * 1024];
                v4u w; w.x = v[0] | ((unsigned)v[1] << 16); w.y = v[2] | ((unsigned)v[3] << 16); w.z = v[4] | ((unsigned)v[5] << 16); w.w = v[6] | ((unsigned)v[7] << 16);
                const bf16x8 xa = pack8(X[sb][8 * st], X[sb][8 * st + 1], X[sb][8 * st + 2], X[sb][8 * st + 3], X[sb][8 * st + 4], X[sb][8 * st + 5], X[sb][8 * st + 6], X[sb][8 * st + 7]);
                acc = MLS_MFMA(xa, __builtin_bit_cast(bf16x8, w), acc); } }
        LDS_WAIT(); asm volatile("" ::: "memory");
#pragma unroll
        for (int i = 0; i < 16; ++i) { const int tr = 32 * tb + crow(i, hi); Ht[tr * MO_HT + 32 * dq + r32] = acc[i] * wsc[192 + tr]; }
        __syncthreads();
        { const int tt = tid >> 3, dg = tid & 7; const LAS float* hp = Ht + tt * MO_HT + 16 * dg;
          f32x4 hv[4]; float ss = 0.f;
#pragma unroll
          for (int j = 0; j < 4; ++j) { hv[j] = *(const LAS f32x4*)(hp + 4 * j); ss += (hv[j].x * hv[j].x + hv[j].y * hv[j].y) + (hv[j].z * hv[j].z + hv[j].w * hv[j].w); }
          ss += __shfl_xor(ss, 1); ss += __shfl_xor(ss, 2); ss += __shfl_xor(ss, 4);
          const float rstd = rsqrtf(ss * (1.f / 128.f) + EPS);
          const v4u o0 = *(const v4u*)(OM + (row0 + tt) * 1024 + hc + 16 * dg), o1 = *(const v4u*)(OM + (row0 + tt) * 1024 + hc + 16 * dg + 8);
          const float* gp = p.mlstm_norm_g + hc + 16 * dg;
          float y[16];
#pragma unroll
          for (int j = 0; j < 4; ++j) { const f32x4 g4 = *(const f32x4*)(gp + 4 * j); y[4 * j] = hv[j].x * rstd * g4.x; y[4 * j + 1] = hv[j].y * rstd * g4.y; y[4 * j + 2] = hv[j].z * rstd * g4.z; y[4 * j + 3] = hv[j].w * rstd * g4.w; }
          const unsigned ow[8] = {o0.x, o0.y, o0.z, o0.w, o1.x, o1.y, o1.z, o1.w};
          unsigned res[8];
#pragma unroll
          for (int j = 0; j < 8; ++j) { const float g0 = __uint_as_float(ow[j] << 16), g1 = __uint_as_float(ow[j] & 0xffff0000u);
              res[j] = pk2(y[2 * j] / (1.f + __expf(-g0)), y[2 * j + 1] / (1.f + __expf(-g1))); }
          v4u* dst = (v4u*)(A2 + (row0 + tt) * 2048 + 1024 + hc + 16 * dg);
          dst[0] = (v4u){res[0], res[1], res[2], res[3]}; dst[1] = (v4u){res[4], res[5], res[6], res[7]}; }
        __syncthreads();
    }
}
constexpr int ML_S = 144;
constexpr int ML_CS = 272;
__device__ __forceinline__ void ml_conv8(const Params& p, const bf16* src, size_t row, int ts, int ch, int cwoff, float (&a)[8]) {
#pragma unroll
    for (int i = 0; i < 8; ++i) a[i] = p.conv_b[cwoff + i];
#pragma unroll
    for (int j = 0; j < 4; ++j) { if (ts - 3 + j >= 0) { const v4u w = *(const v4u*)(src + (row - 3 + j) * 1024 + ch); const float* cw = p.conv_w + j * 2048 + cwoff;
        a[0] += cw[0] * __uint_as_float(w.x << 16); a[1] += cw[1] * __uint_as_float(w.x & 0xffff0000u); a[2] += cw[2] * __uint_as_float(w.y << 16); a[3] += cw[3] * __uint_as_float(w.y & 0xffff0000u);
        a[4] += cw[4] * __uint_as_float(w.z << 16); a[5] += cw[5] * __uint_as_float(w.z & 0xffff0000u); a[6] += cw[6] * __uint_as_float(w.w << 16); a[7] += cw[7] * __uint_as_float(w.w & 0xffff0000u); } }
#pragma unroll
    for (int i = 0; i < 8; ++i) a[i] = a[i] / (1.f + __expf(-a[i]));
}
__device__ __forceinline__ void ph_mlstm_local(const Params& p, LAS unsigned char* lds, int tid) {
    using namespace mls;
    const int lane = tid & 63, wid = __builtin_amdgcn_readfirstlane(tid >> 6), r32 = lane & 31, hi = lane >> 5, we = wid & 3, wd = wid >> 2;
    LAS unsigned char* KwT = lds; LAS unsigned char* VT = lds + 128 * ML_S; LAS unsigned char* Ct = lds + 2 * 128 * ML_S;
    const float* GATES = (const float*)(p.ws + WS_GATES); const bf16* VM = (const bf16*)(p.ws + WS_VM); const bf16* KM = (const bf16*)(p.ws + WS_KM); const bf16* QM = (const bf16*)(p.ws + WS_QM);
    bf16* KC = (bf16*)(p.ws + WS_KC); bf16* QC = (bf16*)(p.ws + WS_QC);
    float* BCUM = (float*)(p.ws + WS_BCUM); float* Gc = (float*)(p.ws + WS_G); float* MLOC = (float*)(p.ws + WS_MLOC); bf16* CLOC = (bf16*)(p.ws + WS_CLOC); float* NLOC = (float*)(p.ws + WS_NLOC);
    for (int bx = blockIdx.x; bx < 1024; bx += gridDim.x) {
        const int bh = bx >> 6, c = bx & 63, b = bh >> 3, h = bh & 7, hc = h * 128; const size_t row0 = (size_t)b * SEQ + c * 64;
        float wt;
        { const float f = GATES[(row0 + lane) * 16 + 8 + h] + p.b_f[h]; float bc = fminf(f, 0.f) - log1pf(__expf(-fabsf(f)));
#pragma unroll
          for (int off = 1; off < 64; off <<= 1) { const float o = __shfl_up(bc, off); if (lane >= off) bc += o; }
          const float g = __shfl(bc, 63), w = g - bc + GATES[(row0 + lane) * 16 + h] + p.b_i[h]; const float mx = wave_max(w); wt = __expf(w - mx);
          if (wid == 0) { BCUM[(size_t)bx * 64 + lane] = bc; if (lane == 0) { Gc[bx] = g; MLOC[bx] = mx; } } }
        const int ts = c * 64 + lane; const size_t row = row0 + lane;
#pragma unroll
        for (int j = 0; j < 2; ++j) { const int eg = 2 * wid + j, ch = hc + 8 * eg;
            float a[8];
            ml_conv8(p, QM, row, ts, ch, ch, a);
            { v4u o; o.x = cvtpk(a[0], a[1]); o.y = cvtpk(a[2], a[3]); o.z = cvtpk(a[4], a[5]); o.w = cvtpk(a[6], a[7]); *(v4u*)(QC + row * 1024 + ch) = o; }
            ml_conv8(p, KM, row, ts, ch, 1024 + ch, a);
#pragma unroll
            for (int i = 0; i < 8; ++i) a[i] *= 0.08838834764831845f;
            { v4u o; o.x = cvtpk(a[0], a[1]); o.y = cvtpk(a[2], a[3]); o.z = cvtpk(a[4], a[5]); o.w = cvtpk(a[6], a[7]); *(v4u*)(KC + row * 1024 + ch) = o;
              const unsigned kk[4] = {o.x, o.y, o.z, o.w};
#pragma unroll
              for (int i = 0; i < 8; ++i) { const float kv = (i & 1) ? __uint_as_float(kk[i >> 1] & 0xffff0000u) : __uint_as_float(kk[i >> 1] << 16);
                  *(LAS unsigned short*)(KwT + (8 * eg + i) * ML_S + 2 * lane) = (unsigned short)(cvtpk(kv * wt, 0.f) & 0xffffu); } }
            { const v4u w = *(const v4u*)(VM + row * 1024 + ch); const unsigned vv[4] = {w.x, w.y, w.z, w.w};
#pragma unroll
              for (int i = 0; i < 8; ++i) *(LAS unsigned short*)(VT + (8 * eg + i) * ML_S + 2 * lane) = (unsigned short)((i & 1) ? (vv[i >> 1] >> 16) : (vv[i >> 1] & 0xffffu)); }
        }
        __syncthreads();
        f32x16 acc[2];
#pragma unroll
        for (int j = 0; j < 2; ++j)
#pragma unroll
            for (int i = 0; i < 16; ++i) acc[j][i] = 0.f;
#pragma unroll
        for (int ks = 0; ks < 4; ++ks) { const bf16x8 af = *(const LAS bf16x8*)(KwT + (32 * we + r32) * ML_S + (16 * ks + 8 * hi) * 2);
#pragma unroll
            for (int j = 0; j < 2; ++j) { const bf16x8 bfr = *(const LAS bf16x8*)(VT + (64 * wd + 32 * j + r32) * ML_S + (16 * ks + 8 * hi) * 2); acc[j] = MLS_MFMA(af, bfr, acc[j]); } }
        if (tid < 128) { float n = 0.f;
#pragma unroll
            for (int q = 0; q < 8; ++q) { const v4u w = *(const LAS v4u*)(KwT + tid * ML_S + 16 * q);
                n += __uint_as_float(w.x << 16) + __uint_as_float(w.x & 0xffff0000u) + __uint_as_float(w.y << 16) + __uint_as_float(w.y & 0xffff0000u) + __uint_as_float(w.z << 16) + __uint_as_float(w.z & 0xffff0000u) + __uint_as_float(w.w << 16) + __uint_as_float(w.w & 0xffff0000u); }
            NLOC[(size_t)bx * 128 + tid] = n; }
#pragma unroll
        for (int j = 0; j < 2; ++j)
#pragma unroll
            for (int g = 0; g < 4; ++g) { const int d = 64 * wd + 32 * j + r32, e = 32 * we + 8 * g + 4 * hi;
                *(LAS unsigned long long*)(Ct + d * ML_CS + e * 2) = (unsigned long long)cvtpk(acc[j][4 * g], acc[j][4 * g + 1]) | ((unsigned long long)cvtpk(acc[j][4 * g + 2], acc[j][4 * g + 3]) << 32); }
        __syncthreads();
        { bf16* co = CLOC + (size_t)bx * 16384;
#pragma unroll
          for (int q = 0; q < 4; ++q) { const int pi = tid + 512 * q, d = pi >> 4, ck = pi & 15; *(v4u*)(co + d * 128 + 8 * ck) = *(const LAS v4u*)(Ct + d * ML_CS + 16 * ck); } }
        __syncthreads();
    }
}
__device__ __forceinline__ void ph_mlstm_scan(const Params& p, LAS unsigned char* lds, int tid) {
    LAS float* dec = (LAS float*)lds; LAS float* scl = dec + 64;
    const float* Gc = (const float*)(p.ws + WS_G); const float* MLOC = (const float*)(p.ws + WS_MLOC); float* MPREV = (float*)(p.ws + WS_MPREV);
    for (int blk = blockIdx.x; blk < 256; blk += gridDim.x) {
        const int bh = blk >> 4;
        __syncthreads();
        if (tid < 64) { const float gv = Gc[bh * 64 + tid], mlv = MLOC[bh * 64 + tid]; float m = 0.f, myd = 0.f, mys = 0.f, mym = 0.f;
#pragma unroll
            for (int c = 0; c < 64; ++c) { const float g = __shfl(gv, c), ml = __shfl(mlv, c); const float mn = fmaxf(g + m, ml);
                if (tid == c) { mym = m; myd = __expf(g + m - mn); mys = __expf(ml - mn); } m = mn; }
            dec[tid] = myd; scl[tid] = mys; if ((blk & 15) == 0) MPREV[bh * 64 + tid] = mym; }
        __syncthreads();
        { unsigned* base = (unsigned*)((bf16*)(p.ws + WS_CLOC) + (size_t)bh * 64 * 16384) + (blk & 15) * 512 + tid;
          float v0 = 0.f, v1 = 0.f;
#pragma unroll 1
          for (int c0 = 0; c0 < 64; c0 += 16) { unsigned w[16];
#pragma unroll
              for (int i = 0; i < 16; ++i) w[i] = base[(size_t)(c0 + i) * 8192];
#pragma unroll
              for (int i = 0; i < 16; ++i) { base[(size_t)(c0 + i) * 8192] = cvtpk_rne(v0, v1); const float d = dec[c0 + i], s = scl[c0 + i];
                  v0 = d * v0 + s * __uint_as_float(w[i] << 16); v1 = d * v1 + s * __uint_as_float(w[i] & 0xffff0000u); } } }
        if ((blk & 15) == 0 && tid < 128) { float* nb = (float*)(p.ws + WS_NLOC) + (size_t)bh * 64 * 128 + tid; float v = 0.f;
#pragma unroll 1
            for (int c0 = 0; c0 < 64; c0 += 16) { float w[16];
#pragma unroll
                for (int i = 0; i < 16; ++i) w[i] = nb[(c0 + i) * 128];
#pragma unroll
                for (int i = 0; i < 16; ++i) { nb[(c0 + i) * 128] = v; v = dec[c0 + i] * v + scl[c0 + i] * w[i]; } } }
    }
}
__device__ __forceinline__ void ph_diff_combine(const Params& p, int tid) {
    const int lane = tid & 63;
    const float lam = expf(wave_sum(p.lam_q1[lane] * p.lam_k1[lane])) - expf(wave_sum(p.lam_q2[lane] * p.lam_k2[lane])) + 0.2f;
    const bf16* OA = (const bf16*)(p.ws + WS_OA); bf16* A2 = (bf16*)(p.ws + WS_A2);
    for (int gw = blockIdx.x * 8 + (tid >> 6); gw < T * NH; gw += gridDim.x * 8) { const int row = gw >> 3, h = gw & 7;
        const unsigned w1 = *(const unsigned*)(OA + (size_t)row * 2048 + h * 256 + 2 * lane), w2 = *(const unsigned*)(OA + (size_t)row * 2048 + h * 256 + 128 + 2 * lane);
        const float v0 = __uint_as_float(w1 << 16) - lam * __uint_as_float(w2 << 16), v1 = __uint_as_float(w1 & 0xffff0000u) - lam * __uint_as_float(w2 & 0xffff0000u);
        const float rstd = rsqrtf(wave_sum(v0 * v0 + v1 * v1) * (1.f / 128.f) + EPS);
        *(unsigned*)(A2 + (size_t)row * 2048 + h * 128 + 2 * lane) = pk2(v0 * rstd * p.diff_norm_g[h * 128 + 2 * lane] * 0.8f, v1 * rstd * p.diff_norm_g[h * 128 + 2 * lane + 1] * 0.8f); }
}
constexpr size_t WS_WR = WS_MISC + MiB + 65536;
__device__ __forceinline__ void router_weights(const Params& p, int gtid, int nthreads) {
    bf16* WR = (bf16*)(p.ws + WS_WR);
    for (int idx = gtid; idx < 48 * 2048; idx += nthreads) { const int n = idx >> 11, k = idx & 2047;
        float v = 0.f; if (n < 4) v = p.w_group[k * 4 + n]; else if (n < 36) v = p.w_router[((size_t)((n - 4) >> 3) * D + k) * 8 + ((n - 4) & 7)];
        v *= p.ln_ffn_g[k]; const unsigned hi = f2bf(v); const float r = v - __uint_as_float(hi << 16);
        WR[idx] = (bf16)hi; WR[48 * 2048 + idx] = (bf16)f2bf(r); }
}
typedef float f32x4r __attribute__((ext_vector_type(4)));
__device__ __forceinline__ void ph_router(const Params& p, LAS unsigned char* lds, int tid) {
    using namespace mls;
    const int lane = tid & 63, wid = __builtin_amdgcn_readfirstlane(tid >> 6), fr = lane & 15, fq = lane >> 4;
    LAS float* part = (LAS float*)lds;
    LAS float* ssq = part + 8 * 32 * 48;
    LAS float* lg = ssq + 8 * 32;
    LAS float* rs = lg + 32 * 48;
    const float* X1 = (const float*)(p.ws + WS_X1); bf16* H2 = (bf16*)(p.ws + WS_H2); const bf16* WR = (const bf16*)(p.ws + WS_WR);
    for (int rb = blockIdx.x; rb < T / 32; rb += gridDim.x) {
        const int row0 = rb * 32, k0 = 256 * wid;
        f32x4r acc[2][3];
#pragma unroll
        for (int rg = 0; rg < 2; ++rg)
#pragma unroll
            for (int nt = 0; nt < 3; ++nt) acc[rg][nt] = (f32x4r){0.f, 0.f, 0.f, 0.f};
        float sq[2] = {0.f, 0.f};
#pragma unroll
        for (int rg = 0; rg < 2; ++rg) {
            f32x4r xv[8][2]; const float* xp = X1 + (size_t)(row0 + 16 * rg + fr) * D + k0 + 8 * fq;
#pragma unroll
            for (int ks = 0; ks < 8; ++ks) { xv[ks][0] = *(const f32x4r*)(xp + 32 * ks); xv[ks][1] = *(const f32x4r*)(xp + 32 * ks + 4); }
#pragma unroll
            for (int ks = 0; ks < 8; ++ks) {
                bf16x8 bh[3], bl[3];
#pragma unroll
                for (int nt = 0; nt < 3; ++nt) { const bf16* wp = WR + (size_t)(16 * nt + fr) * D + k0 + 32 * ks + 8 * fq; bh[nt] = *(const bf16x8*)wp; bl[nt] = *(const bf16x8*)(wp + 48 * 2048); }
                const f32x4r a = xv[ks][0], b = xv[ks][1];
                sq[rg] += (a.x * a.x + a.y * a.y) + (a.z * a.z + a.w * a.w) + (b.x * b.x + b.y * b.y) + (b.z * b.z + b.w * b.w);
                const unsigned h0 = cvtpk(a.x, a.y), h1 = cvtpk(a.z, a.w), h2 = cvtpk(b.x, b.y), h3 = cvtpk(b.z, b.w);
                const unsigned l0 = cvtpk(a.x - __uint_as_float(h0 << 16), a.y - __uint_as_float(h0 & 0xffff0000u)), l1 = cvtpk(a.z - __uint_as_float(h1 << 16), a.w - __uint_as_float(h1 & 0xffff0000u));
                const unsigned l2 = cvtpk(b.x - __uint_as_float(h2 << 16), b.y - __uint_as_float(h2 & 0xffff0000u)), l3 = cvtpk(b.z - __uint_as_float(h3 << 16), b.w - __uint_as_float(h3 & 0xffff0000u));
                const bf16x8 ah = __builtin_bit_cast(bf16x8, (v4u){h0, h1, h2, h3}), al = __builtin_bit_cast(bf16x8, (v4u){l0, l1, l2, l3});
#pragma unroll
                for (int nt = 0; nt < 3; ++nt) { acc[rg][nt] = __builtin_amdgcn_mfma_f32_16x16x32_bf16(ah, bh[nt], acc[rg][nt], 0, 0, 0);
                    acc[rg][nt] = __builtin_amdgcn_mfma_f32_16x16x32_bf16(al, bh[nt], acc[rg][nt], 0, 0, 0); acc[rg][nt] = __builtin_amdgcn_mfma_f32_16x16x32_bf16(ah, bl[nt], acc[rg][nt], 0, 0, 0); } }
            asm volatile("" ::: "memory"); }
#pragma unroll
        for (int rg = 0; rg < 2; ++rg) { float s = sq[rg]; s += __shfl_xor(s, 16); s += __shfl_xor(s, 32); if (fq == 0) ssq[wid * 32 + 16 * rg + fr] = s;
#pragma unroll
            for (int nt = 0; nt < 3; ++nt)
#pragma unroll
                for (int i = 0; i < 4; ++i) part[(wid * 32 + 16 * rg + 4 * fq + i) * 48 + 16 * nt + fr] = acc[rg][nt][i]; }
        __syncthreads();
        if (tid < 32) { float s = 0.f;
#pragma unroll
            for (int w = 0; w < 8; ++w) s += ssq[w * 32 + tid];
            rs[tid] = rsqrtf(s * (1.f / D) + EPS); }
#pragma unroll
        for (int q = 0; q < 3; ++q) { const int o = tid + 512 * q; float s = 0.f;
#pragma unroll
            for (int w = 0; w < 8; ++w) s += part[w * 1536 + o];
            lg[o] = s; }
        __syncthreads();
#pragma unroll
        for (int rg = 0; rg < 2; ++rg) { const int r = 16 * rg + fr; const float rstd = rs[r]; bf16* hp = H2 + (size_t)(row0 + r) * D + k0 + 8 * fq; const float* gp = p.ln_ffn_g + k0 + 8 * fq;
            const float* xp = X1 + (size_t)(row0 + r) * D + k0 + 8 * fq;
#pragma unroll
            for (int ks = 0; ks < 8; ++ks) { const f32x4r g0 = *(const f32x4r*)(gp + 32 * ks), g1 = *(const f32x4r*)(gp + 32 * ks + 4); const f32x4r a = *(const f32x4r*)(xp + 32 * ks), b = *(const f32x4r*)(xp + 32 * ks + 4);
                v4u o; o.x = cvtpk(a.x * rstd * g0.x, a.y * rstd * g0.y); o.y = cvtpk(a.z * rstd * g0.z, a.w * rstd * g0.w); o.z = cvtpk(b.x * rstd * g1.x, b.y * rstd * g1.y); o.w = cvtpk(b.z * rstd * g1.z, b.w * rstd * g1.w);
                *(v4u*)(hp + 32 * ks) = o; } }
        if (tid < 32) { const int row = row0 + tid; const float rstd = rs[tid]; const LAS float* l = lg + tid * 48;
            float ag[4];
#pragma unroll
            for (int g = 0; g < 4; ++g) ag[g] = l[g] * rstd + p.b_group[g];
            int gs = 0; float gm = ag[0];
#pragma unroll
            for (int g = 1; g < 4; ++g) if (ag[g] > gm) { gm = ag[g]; gs = g; }
            float se = 0.f;
#pragma unroll
            for (int g = 0; g < 4; ++g) se += expf(ag[g] - gm);
            const float gw = 1.f / se;
            float el[8];
#pragma unroll
            for (int e = 0; e < 8; ++e) el[e] = l[4 + gs * 8 + e] * rstd + p.b_router[gs * 8 + e];
            int i0 = 0; float v0 = el[0];
#pragma unroll
            for (int e = 1; e < 8; ++e) if (el[e] > v0) { v0 = el[e]; i0 = e; }
            int i1 = -1; float v1 = -INFINITY;
#pragma unroll
            for (int e = 0; e < 8; ++e) if (e != i0 && el[e] > v1) { v1 = el[e]; i1 = e; }
            const float w0 = 1.f / (1.f + expf(v1 - v0)), w1 = 1.f - w0;
            unsigned* cnt = (unsigned*)(p.ws + WS_CTL) + CW_CNT; int* LIST = (int*)(p.ws + WS_LIST); float* LISTW = (float*)(p.ws + WS_LISTW);
            const int e0 = gs * 8 + i0, e1 = gs * 8 + i1;
            const unsigned p0 = atomicAdd(cnt + e0, 1u); LIST[e0 * 8192 + p0] = row * 2; LISTW[e0 * 8192 + p0] = gw * w0;
            const unsigned p1 = atomicAdd(cnt + e1, 1u); LIST[e1 * 8192 + p1] = row * 2 + 1; LISTW[e1 * 8192 + p1] = gw * w1; }
        __syncthreads();
    }
}
__device__ __forceinline__ void ph_sortcopy(const Params& p, unsigned char* lds, int tid) {
    int* s_cnt = (int*)lds; int* s_rowbase = s_cnt + 32; int* s_tilebase = s_rowbase + 33;
    const int lane = tid & 63, wave = tid >> 6;
    const unsigned* cnt = (const unsigned*)(p.ws + WS_CTL) + CW_CNT;
    __syncthreads();
    if (tid == 0) { int rb = 0, tb = 0; for (int e = 0; e < 32; ++e) { const int n = (int)__hip_atomic_load(cnt + e, RLX_AGENT); s_cnt[e] = n; s_rowbase[e] = rb; s_tilebase[e] = tb; const int nt = (n + 255) >> 8; rb += nt * 256; tb += nt; } s_rowbase[32] = rb; s_tilebase[32] = tb; }
    __syncthreads();
    const int MT = s_tilebase[32]; int* TAB = (int*)(p.ws + WS_TAB);
    if (blockIdx.x == 0) { if (tid == 0) TAB[0] = MT; if (tid < MT) { int e = 0; while (e < 31 && s_tilebase[e + 1] <= tid) ++e; TAB[1 + tid] = e; } }
    const int* LIST = (const int*)(p.ws + WS_LIST); const float* LISTW = (const float*)(p.ws + WS_LISTW); int* ROWTOK = (int*)(p.ws + WS_ROWTOK); float* ROWW = (float*)(p.ws + WS_ROWW);
    const bf16* H2 = (const bf16*)(p.ws + WS_H2); bf16* HS = (bf16*)(p.ws + WS_HS);
    for (int r = blockIdx.x * 8 + wave; r < MT * 256; r += gridDim.x * 8) {
        int e = 0; while (e < 31 && s_rowbase[e + 1] <= r) ++e;
        const int i = r - s_rowbase[e]; const bool valid = i < s_cnt[e];
        int ts = -1; float w = 0.f; if (valid) { ts = LIST[e * 8192 + i]; w = LISTW[e * 8192 + i]; }
        GAS v4u* dst = (GAS v4u*)(HS + (size_t)r * D) + lane;
        if (valid) { const GAS v4u* src = (const GAS v4u*)(H2 + (size_t)(ts >> 1) * D) + lane;
#pragma unroll
            for (int j = 0; j < 4; ++j) dst[64 * j] = src[64 * j]; }
        else { const v4u z = {0u, 0u, 0u, 0u};
#pragma unroll
            for (int j = 0; j < 4; ++j) dst[64 * j] = z; }
        if (lane == 0) { ROWTOK[r] = ts; ROWW[r] = w; }
    }
}
__device__ __forceinline__ void ph_final(const Params& p, int tid) {
    const int lane = tid & 63;
    for (int row = blockIdx.x * 8 + (tid >> 6); row < T; row += gridDim.x * 8) {
        const GAS f32x4* xr = (const GAS f32x4*)((const float*)(p.ws + WS_X1) + (size_t)row * D) + lane; const GAS f32x4* gr = (const GAS f32x4*)p.ln_f_g + lane;
        const GAS unsigned long long* y0 = (const GAS unsigned long long*)((const bf16*)(p.ws + WS_Y0) + (size_t)row * D) + lane; const GAS unsigned long long* y1 = (const GAS unsigned long long*)((const bf16*)(p.ws + WS_Y1) + (size_t)row * D) + lane;
        f32x4 v[8]; float s = 0.f;
#pragma unroll
        for (int j = 0; j < 8; ++j) { v[j] = xr[64 * j]; const unsigned long long a = y0[64 * j], b = y1[64 * j];
            v[j].x += __uint_as_float((unsigned)a << 16) + __uint_as_float((unsigned)b << 16); v[j].y += __uint_as_float((unsigned)a & 0xffff0000u) + __uint_as_float((unsigned)b & 0xffff0000u);
            v[j].z += __uint_as_float((unsigned)(a >> 32) << 16) + __uint_as_float((unsigned)(b >> 32) << 16); v[j].w += __uint_as_float((unsigned)(a >> 32) & 0xffff0000u) + __uint_as_float((unsigned)(b >> 32) & 0xffff0000u);
            s += (v[j].x * v[j].x + v[j].y * v[j].y) + (v[j].z * v[j].z + v[j].w * v[j].w); }
        const float rstd = rsqrtf(wave_sum(s) * (1.f / D) + EPS);
        GAS f32x4* o = (GAS f32x4*)(p.out + (size_t)row * D) + lane;
#pragma unroll
        for (int j = 0; j < 8; ++j) { const f32x4 gv = gr[64 * j]; o[64 * j] = (f32x4){v[j].x * rstd * gv.x, v[j].y * rstd * gv.y, v[j].z * rstd * gv.z, v[j].w * rstd * gv.w}; }
    }
}

__global__ void __launch_bounds__(512, 2) mega_fwd(Params p) {
    extern __shared__ __attribute__((aligned(16))) unsigned char lds[];
    const int tid = threadIdx.x, lane = tid & 63, wave = __builtin_amdgcn_readfirstlane(tid >> 6);
    LAS unsigned char* l3 = (LAS unsigned char*)lds;
    for (int u = tid; u < (LDS_BYTES - LDSCTL_OFF) / 4; u += 512) ((LAS unsigned*)(l3 + LDSCTL_OFF))[u] = 0u;
    __syncthreads();
    XcdBarrier bar = xcd_barrier_post((unsigned*)(p.ws + WS_CTL) + CW_BAR + p.li * XCD_BAR_WORDS, (volatile LAS unsigned*)(l3 + LDSCTL_OFF + 64));
    const int lo = p.ph_lo, hi = p.ph_hi;
#define IN(k) (lo <= (k) && (k) < hi)
#define SEAM(k) do { if (IN(k) && IN((k) + 1)) xcd_barrier(bar); } while (0)
#ifndef REP0
#define REP0 1
#endif
#ifndef REP1
#define REP1 1
#endif
#ifndef REP2
#define REP2 1
#endif
#ifndef REP3A
#define REP3A 1
#endif
#ifndef REP3B
#define REP3B 1
#endif
#ifndef REP5A
#define REP5A 1
#endif
#ifndef REP5B
#define REP5B 1
#endif
#ifndef REP6
#define REP6 1
#endif
#ifndef REP8
#define REP8 1
#endif
#ifndef REP9
#define REP9 1
#endif
#ifndef REP10
#define REP10 1
#endif
#ifndef REP11
#define REP11 1
#endif
#define PH(R, ...) do { __VA_ARGS__; if (R > 1) { __syncthreads(); __VA_ARGS__; } } while (0)
    if (IN(0)) { PH(REP0, prologue_body(p, blockIdx.x * 8 + wave, gridDim.x * 8, lane, l3 + wave * 9216)); router_weights(p, blockIdx.x * 512 + tid, gridDim.x * 512); }
    SEAM(0);
    if (IN(1)) { if (blockIdx.x < GEMM1_WGS) PH(REP1, { pg8::Gemm g{(const pg8::bf16_t*)(p.ws + WS_XN), (const pg8::bf16_t*)(p.ws + WS_WIN), T, NPROJ_PAD, D};
      pg8::StaticOrder S; S.init(T, NPROJ_PAD, GEMM1_WGS, blockIdx.x);
      pg8::EpiInProj E{(pg8::bf16_t*)(p.ws + WS_SEG), (float*)(p.ws + WS_GATES)};
      pg8::gemm_phase<pg8::EpiInProj, pg8::StaticOrder, true, true>(l3, g, S, E); });
      convert_queue(p, lane, l3 + wave * 9216); }
    if (IN(1) && IN(3)) xcd_barrier(bar);
    if (IN(3)) {
        PH(REP3A, { const attn_body::AttnTensors AT{(const attn_body::bf16*)(p.ws + WS_QD), (const attn_body::bf16*)(p.ws + WS_KD), (const attn_body::bf16*)(p.ws + WS_VD), (attn_body::bf16*)(p.ws + WS_OA)};
          const int G = gridDim.x, bx = blockIdx.x; attn_body::attn_phase<8>((char*)lds, AT, (bx % 8) * (G / 8) + bx / 8, p.rel_bias); });
        PH(REP3B, ph_mlstm_local(p, l3, tid)); }
    SEAM(3);
    if (IN(4)) ph_mlstm_scan(p, l3, tid);
    SEAM(4);
    if (IN(5)) { PH(REP5A, ph_mlstm_out(p, l3, tid)); PH(REP5B, ph_diff_combine(p, tid)); }
    SEAM(5);
    if (IN(6)) PH(REP6, { pg8::Gemm g{(const pg8::bf16_t*)(p.ws + WS_A2), (const pg8::bf16_t*)(p.ws + WS_WOUT), T, D, D};
      pg8::StaticOrder S; S.init(T, D, gridDim.x, blockIdx.x);
      pg8::EpiOutProj E{p.x, (float*)(p.ws + WS_X1)};
      pg8::gemm_phase<pg8::EpiOutProj, pg8::StaticOrder, true, true>(l3, g, S, E); });
    SEAM(6);
    if (IN(7)) ph_router(p, l3, tid);
    SEAM(7);
    if (IN(8)) PH(REP8, ph_sortcopy(p, lds, tid));
    SEAM(8);
    if (IN(9)) PH(REP9, { pg8::Gemm g{(const pg8::bf16_t*)(p.ws + WS_HS), (const pg8::bf16_t*)(p.ws + WS_WGU), MAXROWS, NEXP * 1024, D};
      pg8::MoeSched S{(const int*)(p.ws + WS_TAB), 4, (int)gridDim.x, (int)blockIdx.x};
      pg8::EpiGU E{(pg8::bf16_t*)(p.ws + WS_HID), (const float*)(p.ws + WS_ROWW)};
      pg8::gemm_phase<pg8::EpiGU, pg8::MoeSched, true, true>(l3, g, S, E); });
    SEAM(9);
    if (IN(10)) PH(REP10, { pg8::Gemm g{(const pg8::bf16_t*)(p.ws + WS_HID), (const pg8::bf16_t*)(p.ws + WS_WD), MAXROWS, NEXP * 2048, FE};
      pg8::MoeSched S{(const int*)(p.ws + WS_TAB), 8, (int)gridDim.x, (int)blockIdx.x};
      pg8::EpiDown E{(pg8::bf16_t*)(p.ws + WS_Y0), (const int*)(p.ws + WS_ROWTOK), (WS_Y1 - WS_Y0) / 2};
      pg8::gemm_phase<pg8::EpiDown, pg8::MoeSched, true, true>(l3, g, S, E); });
    SEAM(10);
    if (IN(11)) PH(REP11, ph_final(p, tid));
#undef PH
#undef IN
#undef SEAM
}

extern "C" void kernel_launch(void* const* d_in, const int* in_sizes, int n_in, void* d_out, int out_size, void* d_ws, size_t ws_size, hipStream_t stream) {
    static int grid = 0;
    if (grid == 0) {
        if (n_in != 24 || in_sizes[0] != T * D || out_size != T * D || ws_size < WS_END) { fprintf(stderr, "kernel_launch: unexpected shapes (n_in %d, in0 %d, out %d, ws %zu)\n", n_in, n_in > 0 ? in_sizes[0] : -1, out_size, ws_size); grid = -1; return; }
        int dev = 0, cus = 0, per_cu = 0;
        if (hipGetDevice(&dev) != hipSuccess || hipDeviceGetAttribute(&cus, hipDeviceAttributeMultiprocessorCount, dev) != hipSuccess) { grid = -1; return; }
        if (hipFuncSetAttribute((const void*)mega_fwd, hipFuncAttributeMaxDynamicSharedMemorySize, LDS_BYTES) != hipSuccess) { fprintf(stderr, "kernel_launch: hipFuncSetAttribute failed\n"); grid = -1; return; }
        if (hipOccupancyMaxActiveBlocksPerMultiprocessor(&per_cu, (const void*)mega_fwd, 512, LDS_BYTES) != hipSuccess || per_cu < 1) { fprintf(stderr, "kernel_launch: occupancy query reports %d workgroups per CU\n", per_cu); }
        (void)hipGetLastError();
        grid = 256;
        if (cus < 256) { fprintf(stderr, "kernel_launch: %d CUs < 256: the persistent grid would not be resident\n", cus); grid = -1; return; }
    }
    if (grid < 0) return;
    if (hipMemsetAsync((char*)d_ws + WS_CTL, 0, CTL_ZERO_BYTES, stream) != hipSuccess) return;
    Params p{};
    const float** pf = (const float**)&p;
    for (int i = 0; i < 24; ++i) pf[i] = (const float*)d_in[i];
    p.out = (float*)d_out; p.ws = (unsigned char*)d_ws;
    p.ph_lo = 0; p.ph_hi = 12; p.li = 0;
    hipLaunchKernelGGL(mega_fwd, dim3(grid), dim3(512), LDS_BYTES, stream, p);
}
```

```cpp
#include <hip/hip_runtime.h>
#include <cstdio>
#include <cstdint>
#include <cmath>
namespace pg8 {
#define PG8_LAS __attribute__((address_space(3)))
typedef unsigned short bf16_t;
typedef short bf16x8 __attribute__((ext_vector_type(8)));
typedef float f32x4 __attribute__((ext_vector_type(4)));
typedef unsigned u32x4 __attribute__((ext_vector_type(4)));
constexpr int BM = 256, BK = 64, HALF = 128, HTB = HALF * BK * 2  , STAGE_BYTES = 8 * HTB, NXCD = 8, WGM = 8;

__host__ __device__ __forceinline__ int lds_byte(int r, int c) { const int st = (r >> 4) * 2 + (c >> 5), rr = r & 15, cc = c & 31, ob = rr * 64 + cc * 2; return st * 1024 + (ob ^ (((ob >> 9) & 1) << 5)); }
__host__ __device__ __forceinline__ void stage_rc(int b, int& R, int& C) { const int st = b / 1024, sb = b % 1024, swz = sb ^ (((sb >> 9) & 1) << 5); R = (st >> 1) * 16 + swz / 64; C = (st & 1) * 32 + (swz % 64) / 2; }
__host__ __device__ __forceinline__ int perm32(int rho) { const int n = rho >> 4, i = rho & 15; return 8 * (i >> 2) + 4 * n + (i & 3); }

struct Unit { int pm, pn, e, i0, cnt; };
struct Gemm { const bf16_t* A; const bf16_t* Bt; int M, N, K, ld; };

struct StaticOrder {
    int nM, nN, nwg, G, c;
    __host__ __device__ void init(int M, int N, int G_, int c_) { nM = M / BM; nN = N / BM; nwg = nM * nN; G = G_; c = c_; }
    __host__ __device__ bool next(int i, Unit& u) const {
        const long L = (long)i * G + c; if (L >= nwg) return false;
        int wgid = (int)L; { const int q = nwg / NXCD, r = nwg % NXCD, xcd = wgid % NXCD, off = wgid / NXCD; wgid = (xcd < r ? xcd * (q + 1) : r * (q + 1) + (xcd - r) * q) + off; }
        const int nig = WGM * nN, gid = wgid / nig, fm = gid * WGM, gsz = (nM - fm) < WGM ? (nM - fm) : WGM;
        u.pm = fm + ((wgid % nig) % gsz); u.pn = (wgid % nig) / gsz; return true;
    }
    __device__ __forceinline__ void a_ready(const Unit&, int, int) const {}
    __device__ __forceinline__ void done(const Unit&, int) const {}
};

__device__ __forceinline__ unsigned cvt_pk_bf16(float lo, float hi) { unsigned r; asm volatile("v_cvt_pk_bf16_f32 %0, %1, %2" : "=v"(r) : "v"(lo), "v"(hi)); return r; }
typedef float f32x2 __attribute__((ext_vector_type(2)));
constexpr int kT = 8192;
struct MoeSched {
    static constexpr bool GATHER = true;
    static constexpr unsigned TB_ADDR = 146432 + 256, CN_ADDR = 146432 + 512;
    const int* list; unsigned* ready; int G, c;
    __device__ __forceinline__ bool next(int i, Unit& u) const {
        const PG8_LAS int* tb = (const PG8_LAS int*)TB_ADDR; const PG8_LAS int* cn = (const PG8_LAS int*)CN_ADDR;
        const int MT = tb[32]; const int L = i * G + c; if (L >= MT * 4) return false;
        const int mt = L >> 2, pn = L & 3; int e = 0; while (tb[e + 1] <= mt) ++e;
        u.pm = mt; u.pn = e * 4 + pn; u.e = e; u.i0 = (mt - tb[e]) * 256; u.cnt = cn[e]; return true;
    }
    __device__ __forceinline__ int rowidx(const Unit& u, int rr) const { const int i = u.i0 + rr; return (i < u.cnt) ? (list[u.e * 8192 + i] >> 1) : 0; }
    __device__ __forceinline__ void a_ready(const Unit&, int, int) const {}
    __device__ __forceinline__ void done(const Unit& u, int lane) const {
        asm volatile("s_waitcnt vmcnt(0)" ::: "memory");
        if (lane == 0) __hip_atomic_fetch_add(ready + 64 * u.pm, 1u, __ATOMIC_RELAXED, __HIP_MEMORY_SCOPE_AGENT);
    }
};
struct MoeSchedD {
    static constexpr bool GATHER = false;
    const unsigned* ready; unsigned* tmo; int G, c;
    __device__ __forceinline__ bool next(int i, Unit& u) const {
        const PG8_LAS int* tb = (const PG8_LAS int*)MoeSched::TB_ADDR; const PG8_LAS int* cn = (const PG8_LAS int*)MoeSched::CN_ADDR;
        const int MT = tb[32], N2 = 4 * MT - G, N1 = G - N2; int j;
        if (c >= N2) j = (i == 0) ? (c - N2) : (i == 1) ? (c - N2 + N1) : (2 * N1 + (i - 2) * G + c); else j = 2 * N1 + i * G + c;
        if (j >= MT * 8) return false;
        const int mt = j >> 3, pn = j & 7; int e = 0; while (tb[e + 1] <= mt) ++e;
        u.pm = mt; u.pn = e * 8 + pn; u.e = e; u.i0 = (mt - tb[e]) * 256; u.cnt = cn[e]; return true;
    }
    __device__ __forceinline__ void a_ready(const Unit& u, int wid, int lane) const {
        if (wid == 0) {
            unsigned polls = 0;
            while ((unsigned)__builtin_amdgcn_readfirstlane(__hip_atomic_load(ready + 64 * u.pm, __ATOMIC_RELAXED, __HIP_MEMORY_SCOPE_AGENT)) < 32u) {
                if (++polls > (1u << 20)) { if (lane == 0) __hip_atomic_store(tmo, 1u, __ATOMIC_RELAXED, __HIP_MEMORY_SCOPE_AGENT); break; }
                __builtin_amdgcn_s_sleep(2); }
            __builtin_amdgcn_fence(__ATOMIC_ACQUIRE, "agent");
            asm volatile("s_waitcnt vmcnt(0)" ::: "memory");
        }
        asm volatile("" ::: "memory"); __builtin_amdgcn_s_barrier(); asm volatile("" ::: "memory");
    }
    __device__ __forceinline__ void done(const Unit&, int) const {}
};
__device__ __forceinline__ u32x4 pack8(const f32x4 v0, const f32x4 v1) { u32x4 w; w.x = cvt_pk_bf16(v0[0], v0[1]); w.y = cvt_pk_bf16(v0[2], v0[3]); w.z = cvt_pk_bf16(v1[0], v1[1]); w.w = cvt_pk_bf16(v1[2], v1[3]); return w; }
struct EpiInProj {
    static constexpr bool PERM = true, AFTER_DRAIN = false;
    bf16_t* seg;
    __device__ __forceinline__ void operator()(const f32x4 (&acc)[2][2][4][2], const Unit& u, int wr, int wc, int fr, int fq) const {
        const int row0 = u.pm * BM + wr * 64 + fr;
        const int s = u.pn >> 2; bf16_t* base = seg + (size_t)s * ((size_t)kT * 1024);
        const int col0 = (u.pn & 3) * BM + wc * 32 + 8 * fq;
#pragma unroll
        for (int ai = 0; ai < 2; ++ai)
#pragma unroll
            for (int m = 0; m < 4; ++m) { bf16_t* rowp = base + (size_t)(row0 + ai * HALF + m * 16) * 1024 + col0;
#pragma unroll
                for (int bj = 0; bj < 2; ++bj) *(u32x4*)(rowp + bj * HALF) = pack8(acc[ai][bj][m][0], acc[ai][bj][m][1]); }
    }
};
struct EpiOutProj {
    static constexpr bool PERM = true, AFTER_DRAIN = false;
    const float* x; bf16_t* x1;
    __device__ __forceinline__ void operator()(const f32x4 (&acc)[2][2][4][2], const Unit& u, int wr, int wc, int fr, int fq) const {
        const int col0 = u.pn * BM + wc * 32 + 8 * fq;
#pragma unroll
        for (int ai = 0; ai < 2; ++ai)
#pragma unroll
            for (int m = 0; m < 4; ++m) { const size_t off = (size_t)(u.pm * BM + ai * HALF + wr * 64 + m * 16 + fr) * 2048 + col0;
#pragma unroll
                for (int bj = 0; bj < 2; ++bj) { const f32x4 x0 = *(const f32x4*)(x + off + bj * HALF), x1v = *(const f32x4*)(x + off + bj * HALF + 4);
                    *(u32x4*)(x1 + off + bj * HALF) = pack8(acc[ai][bj][m][0] + x0, acc[ai][bj][m][1] + x1v); } }
    }
};
__device__ __forceinline__ float silu_f(float g) { return g / (1.f + __expf(-g)); }
__device__ __forceinline__ float clamp8(float v) { return __builtin_fminf(__builtin_fmaxf(v, -448.f), 448.f); }
__device__ __forceinline__ unsigned pk4_fp8(float a, float b, float c, float d) { int w = 0; w = __builtin_amdgcn_cvt_pk_fp8_f32(clamp8(a), clamp8(b), w, false); w = __builtin_amdgcn_cvt_pk_fp8_f32(clamp8(c), clamp8(d), w, true); return (unsigned)w; }
constexpr float W8_GU = 32.f, W8_D = 16.f, H8 = 16.f;
struct EpiGU {
    static constexpr bool PERM = true, AFTER_DRAIN = false;
    unsigned char* hid; const float* listw;
    __device__ __forceinline__ void operator()(const f32x4 (&acc)[2][2][4][2], const Unit& u, int wr, int wc, int fr, int fq) const {
        const int pnl = u.pn & 3, row0 = u.pm * BM + wr * 64 + fr, col0 = pnl * 128 + wc * 32 + 8 * fq; constexpr float ws = 1.f / W8_GU;
        const __amdgpu_buffer_rsrc_t rsrc = __builtin_amdgcn_make_buffer_rsrc(hid, 0, 24576 * 512, 0x00020000);
#pragma unroll
        for (int ai = 0; ai < 2; ++ai)
#pragma unroll
            for (int m = 0; m < 4; ++m) { const int r = row0 + ai * HALF + m * 16; const float w = H8 * ws; f32x4 h0, h1;
#pragma unroll
                for (int q = 0; q < 4; ++q) { h0[q] = silu_f(acc[ai][0][m][0][q] * ws) * acc[ai][1][m][0][q] * w; h1[q] = silu_f(acc[ai][0][m][1][q] * ws) * acc[ai][1][m][1][q] * w; }
                typedef unsigned u32x2 __attribute__((ext_vector_type(2)));
                __builtin_amdgcn_raw_buffer_store_b64((u32x2){pk4_fp8(h0[0], h0[1], h0[2], h0[3]), pk4_fp8(h1[0], h1[1], h1[2], h1[3])}, rsrc, (unsigned)(r * 512 + col0), 0, 16); }
    }
};
struct EpiDown {
    static constexpr bool PERM = true, AFTER_DRAIN = false;
    bf16_t* y;
    __device__ __forceinline__ void operator()(const f32x4 (&acc)[2][2][4][2], const Unit& u, int wr, int wc, int fr, int fq) const {
        const int pnl = u.pn & 7, row0 = u.pm * BM + wr * 64 + fr, col0 = pnl * BM + wc * 32 + 8 * fq;
#pragma unroll
        for (int ai = 0; ai < 2; ++ai)
#pragma unroll
            for (int m = 0; m < 4; ++m) { bf16_t* dst = y + (size_t)(row0 + ai * HALF + m * 16) * 2048 + col0;
#pragma unroll
                for (int bj = 0; bj < 2; ++bj) *(u32x4*)(dst + bj * HALF) = pack8(acc[ai][bj][m][0], acc[ai][bj][m][1]); }
    }
};
template <class Epi, class Sched, bool ALIGN_EPI = false, bool SP2 = false>
__device__ __forceinline__ void gemm_phase(PG8_LAS unsigned char* lds, const Gemm g, const Sched& S, const Epi& E, const int tid) {
    const int wid = __builtin_amdgcn_readfirstlane(tid >> 6), lane = tid & 63, wr = wid >> 2, wc = wid & 3, fr = lane & 15, fq = lane >> 4;
    const int K = g.K, nt = K / BK;
    unsigned voffA[2], voffB[2];
#pragma unroll
    for (int i = 0; i < 2; ++i) { int R, C; stage_rc(tid * 16 + i * 8192, R, C); const int Rb = Epi::PERM ? ((R & ~31) + perm32(R & 31)) : R;
        voffA[i] = (unsigned)(R * g.ld + C) * 2u; voffB[i] = (unsigned)(Rb * g.ld + C) * 2u; }
    const size_t kstep = (size_t)(BK * 2);
    const size_t hstep = (size_t)HALF * g.ld * 2;
    const size_t tstep = 2 * hstep;
    const unsigned ldsw = (unsigned)wid * 1024u;
    const int aoff = lds_byte(wr * 64 + fr, fq * 8), boff = lds_byte(wc * 32 + fr, fq * 8);
#define PG8_SA(b, h) (((b) * 2 + (h)) * HTB)
#define PG8_SB(b, h) ((4 + (b) * 2 + (h)) * HTB)
#define PG8_STAGE(bufoff, gbase, voff) do { _Pragma("unroll") for (int _i = 0; _i < 2; ++_i) \
        __builtin_amdgcn_global_load_lds((const unsigned*)((const char*)(gbase) + (voff)[_i]), (PG8_LAS unsigned*)(lds + (bufoff) + ldsw + _i * 8192), 16, 0, 0); } while (0)
#define PG8_LDA(dst, b, h) do { _Pragma("unroll") for (int m = 0; m < 4; ++m) _Pragma("unroll") for (int k = 0; k < 2; ++k) dst[m][k] = *(const PG8_LAS bf16x8*)(lds + PG8_SA(b, h) + aoff + m * 2048 + k * 1024); } while (0)
#define PG8_LDB(dst, b, h) do { _Pragma("unroll") for (int n = 0; n < 2; ++n) _Pragma("unroll") for (int k = 0; k < 2; ++k) dst[n][k] = *(const PG8_LAS bf16x8*)(lds + PG8_SB(b, h) + boff + n * 2048 + k * 1024); } while (0)
#define PG8_MMA(ai, bj, At, Bt) do { __builtin_amdgcn_s_setprio(1); _Pragma("unroll") for (int m = 0; m < 4; ++m) _Pragma("unroll") for (int n = 0; n < 2; ++n) _Pragma("unroll") for (int k = 0; k < 2; ++k) \
        acc[ai][bj][m][n] = __builtin_amdgcn_mfma_f32_16x16x32_bf16(Bt[n][k], At[m][k], acc[ai][bj][m][n], 0, 0, 0); __builtin_amdgcn_s_setprio(0); } while (0)
#define PG8_WAIT_V(n) asm volatile("s_waitcnt vmcnt(" #n ")" ::: "memory")
#define PG8_WAIT_L(n) asm volatile("s_waitcnt lgkmcnt(" #n ")" ::: "memory")
#define PG8_BAR __builtin_amdgcn_s_barrier()
#define PG8_SCHED __builtin_amdgcn_sched_barrier(0)
    Unit cur, nxt; int ui = 0;
    if (!S.next(0, cur)) return;
    f32x4 acc[2][2][4][2];
#pragma unroll
    for (int a = 0; a < 2; ++a)
#pragma unroll
        for (int b = 0; b < 2; ++b)
#pragma unroll
            for (int m = 0; m < 4; ++m)
#pragma unroll
                for (int n = 0; n < 2; ++n) acc[a][b][m][n] = (f32x4){0.f, 0.f, 0.f, 0.f};
    bf16x8 At[4][2], B0[2][2], B1[2][2];
    const char* cA = (const char*)g.A + (size_t)cur.pm * tstep; const char* cB = (const char*)g.Bt + (size_t)cur.pn * tstep;
    S.a_ready(cur, wid, lane);
    if constexpr (SP2) {
        PG8_STAGE(PG8_SB(0, 0), cB, voffB); PG8_STAGE(PG8_SB(0, 1), cB + hstep, voffB); PG8_STAGE(PG8_SA(0, 0), cA, voffA); PG8_STAGE(PG8_SA(0, 1), cA + hstep, voffA);
        if (wr == 1) PG8_BAR;
        PG8_WAIT_V(2); PG8_BAR;
        PG8_STAGE(PG8_SB(1, 0), cB + kstep, voffB); PG8_STAGE(PG8_SA(1, 0), cA + kstep, voffA); PG8_STAGE(PG8_SB(1, 1), cB + hstep + kstep, voffB);
        PG8_WAIT_V(6); PG8_BAR;
    } else {
        PG8_STAGE(PG8_SB(0, 0), cB, voffB); PG8_STAGE(PG8_SA(0, 0), cA, voffA); PG8_STAGE(PG8_SB(0, 1), cB + hstep, voffB); PG8_STAGE(PG8_SA(0, 1), cA + hstep, voffA);
        if (wr == 1) PG8_BAR;
        PG8_WAIT_V(4); PG8_BAR;
        PG8_STAGE(PG8_SB(1, 0), cB + kstep, voffB); PG8_STAGE(PG8_SA(1, 0), cA + kstep, voffA); PG8_STAGE(PG8_SB(1, 1), cB + hstep + kstep, voffB);
        PG8_WAIT_V(6); PG8_BAR;
    }
    for (;;) {
        const bool has_next = S.next(ui + 1, nxt);
        const char* nA = has_next ? (const char*)g.A + (size_t)nxt.pm * tstep : cA; const char* nB = has_next ? (const char*)g.Bt + (size_t)nxt.pn * tstep : cB;
        for (int t = 0; t < nt; t += 2) {
            const bool last = (t == nt - 2);
            const char* a1 = cA + (size_t)(t + 1) * kstep;
            const char* a2 = last ? nA : cA + (size_t)(t + 2) * kstep; const char* b2 = last ? nB : cB + (size_t)(t + 2) * kstep;
            const char* a3 = a2 + kstep; const char* b3 = b2 + kstep;
            if (last && has_next) S.a_ready(nxt, wid, lane);
            if constexpr (SP2) {
            PG8_LDB(B0, 0, 0); PG8_LDB(B1, 0, 1); PG8_SCHED; PG8_LDA(At, 0, 0); PG8_STAGE(PG8_SA(1, 1), a1 + hstep, voffA);
            PG8_WAIT_V(8); PG8_WAIT_L(0); PG8_BAR; PG8_MMA(0, 0, At, B0); PG8_MMA(0, 1, At, B1); PG8_BAR; PG8_SCHED;
            PG8_LDA(At, 0, 1); PG8_STAGE(PG8_SB(0, 0), b2, voffB); PG8_STAGE(PG8_SB(0, 1), b2 + hstep, voffB); PG8_STAGE(PG8_SA(0, 0), a2, voffA);
            PG8_WAIT_V(8); PG8_WAIT_L(0); PG8_BAR; PG8_MMA(1, 0, At, B0); PG8_MMA(1, 1, At, B1); PG8_BAR; PG8_SCHED;
            PG8_LDB(B0, 1, 0); PG8_LDB(B1, 1, 1); PG8_SCHED; PG8_LDA(At, 1, 0); PG8_STAGE(PG8_SA(0, 1), a2 + hstep, voffA);
            PG8_WAIT_V(8); PG8_WAIT_L(0); PG8_BAR; PG8_MMA(0, 0, At, B0); PG8_MMA(0, 1, At, B1); PG8_BAR; PG8_SCHED;
            PG8_LDA(At, 1, 1); PG8_STAGE(PG8_SB(1, 0), b3, voffB); PG8_STAGE(PG8_SB(1, 1), b3 + hstep, voffB); PG8_STAGE(PG8_SA(1, 0), a3, voffA);
            PG8_WAIT_V(8); PG8_WAIT_L(0); PG8_BAR; PG8_MMA(1, 0, At, B0); PG8_MMA(1, 1, At, B1); PG8_BAR; PG8_SCHED;
            } else {
            PG8_LDB(B0, 0, 0); PG8_SCHED; PG8_LDA(At, 0, 0); PG8_STAGE(PG8_SA(1, 1), a1 + hstep, voffA);
            PG8_WAIT_L(8); PG8_BAR; PG8_WAIT_L(0); PG8_MMA(0, 0, At, B0); PG8_BAR; PG8_SCHED;
            PG8_LDB(B1, 0, 1); PG8_STAGE(PG8_SB(0, 0), b2, voffB);
            PG8_BAR; PG8_WAIT_L(0); PG8_MMA(0, 1, At, B1); PG8_BAR;
            PG8_LDA(At, 0, 1); PG8_STAGE(PG8_SA(0, 0), a2, voffA);
            PG8_BAR; PG8_WAIT_L(0); PG8_MMA(1, 0, At, B0); PG8_BAR; PG8_SCHED;
            PG8_STAGE(PG8_SB(0, 1), b2 + hstep, voffB);
            PG8_WAIT_V(6); PG8_BAR; PG8_MMA(1, 1, At, B1); PG8_BAR;
            PG8_LDB(B0, 1, 0); PG8_SCHED; PG8_LDA(At, 1, 0); PG8_STAGE(PG8_SA(0, 1), a2 + hstep, voffA);
            PG8_WAIT_L(8); PG8_BAR; PG8_WAIT_L(0); PG8_MMA(0, 0, At, B0); PG8_BAR; PG8_SCHED;
            PG8_LDB(B1, 1, 1); PG8_STAGE(PG8_SB(1, 0), b3, voffB);
            PG8_BAR; PG8_WAIT_L(0); PG8_MMA(0, 1, At, B1); PG8_BAR;
            PG8_LDA(At, 1, 1); PG8_STAGE(PG8_SA(1, 0), a3, voffA);
            PG8_BAR; PG8_WAIT_L(0); PG8_MMA(1, 0, At, B0); PG8_BAR; PG8_SCHED;
            PG8_STAGE(PG8_SB(1, 1), b3 + hstep, voffB);
            PG8_WAIT_V(6); PG8_BAR; PG8_MMA(1, 1, At, B1); PG8_BAR;
            }
        }
        if constexpr (ALIGN_EPI) { if (wr == 0) PG8_BAR; }
        if constexpr (!Epi::AFTER_DRAIN) { E(acc, cur, wr, wc, fr, fq); S.done(cur, lane); }
        if (!has_next) break;
#pragma unroll
        for (int a = 0; a < 2; ++a)
#pragma unroll
            for (int b = 0; b < 2; ++b)
#pragma unroll
                for (int m = 0; m < 4; ++m)
#pragma unroll
                    for (int n = 0; n < 2; ++n) acc[a][b][m][n] = (f32x4){0.f, 0.f, 0.f, 0.f};
        cur = nxt; cA = nA; cB = nB; ++ui;
        if constexpr (ALIGN_EPI) { if (wr == 1) PG8_BAR; }
    }
    PG8_WAIT_V(0);
    if constexpr (!ALIGN_EPI) { if (wr == 0) PG8_BAR; }
    PG8_BAR;
    if constexpr (Epi::AFTER_DRAIN) { E.fused(acc, cur, wr, wc, fr, fq, lds, wid, lane); S.done(cur, lane); }
#undef PG8_SA
#undef PG8_SB
#undef PG8_STAGE
#undef PG8_LDA
#undef PG8_LDB
#undef PG8_MMA
#undef PG8_WAIT_V
#undef PG8_WAIT_L
#undef PG8_BAR
#undef PG8_SCHED
}
typedef int i32x4g __attribute__((ext_vector_type(4))); typedef int i32x8g __attribute__((ext_vector_type(8)));
__device__ __forceinline__ i32x8g cat8(bf16x8 a, bf16x8 b) { const i32x4g x = __builtin_bit_cast(i32x4g, a), y = __builtin_bit_cast(i32x4g, b); return __builtin_shufflevector(x, y, 0, 1, 2, 3, 4, 5, 6, 7); }
template <class Epi, class Sched, bool FP8 = false>
__device__ __forceinline__ void gemm_phase_g(PG8_LAS unsigned char* lds, const Gemm g, const Sched& S, const Epi& E, const int tid) {
    const int wid = __builtin_amdgcn_readfirstlane(tid >> 6), lane = tid & 63, wr = wid >> 2, wc = wid & 3, fr = lane & 15, fq = lane >> 4;
    constexpr bool GATHER = Sched::GATHER;
    constexpr int ESZ = FP8 ? 1 : 2;
    const int K = g.K, nt = K * ESZ / (BK * 2);
    unsigned voffB[2]; int RA[2], CA[2];
#pragma unroll
    for (int i = 0; i < 2; ++i) { int R, C; stage_rc(tid * 16 + i * 8192, R, C); const int Rb = Epi::PERM ? ((R & ~31) + perm32(R & 31)) : R; RA[i] = R; CA[i] = C; voffB[i] = (unsigned)(Rb * g.ld * ESZ) + (unsigned)C * 2u; }
    const size_t kstep = (size_t)(BK * 2);
    const size_t hstep = (size_t)HALF * g.ld * ESZ;
    const size_t tstep = 2 * hstep;
    const unsigned ldsw = (unsigned)wid * 1024u;
    const int aoff = lds_byte(wr * 64 + fr, fq * 8), boff = lds_byte(wc * 32 + fr, fq * 8);
#define PG8_SA(b, h) (((b) * 2 + (h)) * HTB)
#define PG8_SB(b, h) ((4 + (b) * 2 + (h)) * HTB)
#define PG8_STAGE(bufoff, gbase, voff) do { _Pragma("unroll") for (int _i = 0; _i < 2; ++_i) { unsigned o_ = (voff)[_i]; asm volatile("" : "+v"(o_));     \
        __builtin_amdgcn_global_load_lds((const unsigned*)((const char*)(gbase) + o_), (PG8_LAS unsigned*)(lds + (bufoff) + ldsw + _i * 8192), 16, 0, 0); } } while (0)
#define PG8_GOFF(V0, V1, U) do { _Pragma("unroll") for (int _i = 0; _i < 2; ++_i) { \
        V0[_i] = (unsigned)S.rowidx(U, RA[_i]) * (unsigned)(g.ld * ESZ) + (unsigned)CA[_i] * 2u; V1[_i] = (unsigned)S.rowidx(U, HALF + RA[_i]) * (unsigned)(g.ld * ESZ) + (unsigned)CA[_i] * 2u; } } while (0)
#define PG8_LD8(p_) __builtin_shufflevector(*(const PG8_LAS i32x4g*)(p_), *(const PG8_LAS i32x4g*)((p_) + 1024), 0, 1, 2, 3, 4, 5, 6, 7)
#define PG8_LDA(dst, b, h) do { _Pragma("unroll") for (int m = 0; m < 4; ++m) dst[m] = PG8_LD8(lds + PG8_SA(b, h) + aoff + m * 2048); } while (0)
#define PG8_LDB(dst, b, h) do { _Pragma("unroll") for (int n = 0; n < 2; ++n) dst[n] = PG8_LD8(lds + PG8_SB(b, h) + boff + n * 2048); } while (0)
#define PG8_LO(v) __builtin_bit_cast(bf16x8, __builtin_shufflevector(v, v, 0, 1, 2, 3))
#define PG8_HI(v) __builtin_bit_cast(bf16x8, __builtin_shufflevector(v, v, 4, 5, 6, 7))
#define PG8_MMA(ai, bj, At, Bt) do { __builtin_amdgcn_s_setprio(1); if constexpr (FP8) { \
          \
        asm volatile("s_nop 1\n\tv_mfma_f32_16x16x128_f8f6f4 %0, %8, %12, %0\n\tv_mfma_f32_16x16x128_f8f6f4 %1, %9, %12, %1\n\tv_mfma_f32_16x16x128_f8f6f4 %2, %8, %13, %2\n\tv_mfma_f32_16x16x128_f8f6f4 %3, %9, %13, %3\n\t" \
                     "v_mfma_f32_16x16x128_f8f6f4 %4, %8, %14, %4\n\tv_mfma_f32_16x16x128_f8f6f4 %5, %9, %14, %5\n\tv_mfma_f32_16x16x128_f8f6f4 %6, %8, %15, %6\n\tv_mfma_f32_16x16x128_f8f6f4 %7, %9, %15, %7" \
                     : "+v"(acc[ai][bj][0][0]), "+v"(acc[ai][bj][0][1]), "+v"(acc[ai][bj][1][0]), "+v"(acc[ai][bj][1][1]), "+v"(acc[ai][bj][2][0]), "+v"(acc[ai][bj][2][1]), "+v"(acc[ai][bj][3][0]), "+v"(acc[ai][bj][3][1]) \
                     : "v"(Bt[0]), "v"(Bt[1]), "v"(Bt[0]), "v"(Bt[1]), "v"(At[0]), "v"(At[1]), "v"(At[2]), "v"(At[3])); } else { \
        _Pragma("unroll") for (int m = 0; m < 4; ++m) _Pragma("unroll") for (int n = 0; n < 2; ++n) { \
        acc[ai][bj][m][n] = __builtin_amdgcn_mfma_f32_16x16x32_bf16(PG8_LO(Bt[n]), PG8_LO(At[m]), acc[ai][bj][m][n], 0, 0, 0); \
        acc[ai][bj][m][n] = __builtin_amdgcn_mfma_f32_16x16x32_bf16(PG8_HI(Bt[n]), PG8_HI(At[m]), acc[ai][bj][m][n], 0, 0, 0); } } __builtin_amdgcn_s_setprio(0); } while (0)
#define PG8_WAIT_V(n) asm volatile("s_waitcnt vmcnt(" #n ")" ::: "memory")
#define PG8_WAIT_L(n) asm volatile("s_waitcnt lgkmcnt(" #n ")" ::: "memory")
#define PG8_BAR __builtin_amdgcn_s_barrier()
#define PG8_SCHED __builtin_amdgcn_sched_barrier(0)
    Unit cur, nxt; int ui = 0;
    if (!S.next(0, cur)) return;
    f32x4 acc[2][2][4][2];
#pragma unroll
    for (int a = 0; a < 2; ++a)
#pragma unroll
        for (int b = 0; b < 2; ++b)
#pragma unroll
            for (int m = 0; m < 4; ++m)
#pragma unroll
                for (int n = 0; n < 2; ++n) acc[a][b][m][n] = (f32x4){0.f, 0.f, 0.f, 0.f};
    i32x8g At[4], B0[2], B1[2];
    unsigned vo0[2], vo1[2];
    if constexpr (GATHER) { PG8_GOFF(vo0, vo1, cur); } else {
#pragma unroll
        for (int _i = 0; _i < 2; ++_i) { vo0[_i] = (unsigned)(RA[_i] * g.ld * ESZ) + (unsigned)CA[_i] * 2u; vo1[_i] = vo0[_i]; } }
    const size_t ah = GATHER ? 0 : hstep;
    const char* cA = GATHER ? (const char*)g.A : (const char*)g.A + (size_t)cur.pm * tstep; const char* cB = (const char*)g.Bt + (size_t)cur.pn * tstep;
    S.a_ready(cur, wid, lane);
    PG8_STAGE(PG8_SB(0, 0), cB, voffB); PG8_STAGE(PG8_SB(0, 1), cB + hstep, voffB); PG8_STAGE(PG8_SA(0, 0), cA, vo0); PG8_STAGE(PG8_SA(0, 1), cA + ah, vo1);
    if (wr == 1) PG8_BAR;
    PG8_WAIT_V(2); PG8_BAR;
    PG8_STAGE(PG8_SB(1, 0), cB + kstep, voffB); PG8_STAGE(PG8_SA(1, 0), cA + kstep, vo0); PG8_STAGE(PG8_SB(1, 1), cB + hstep + kstep, voffB);
    PG8_WAIT_V(6); PG8_BAR;
    for (;;) {
        const bool has_next = S.next(ui + 1, nxt);
        const char* nB = has_next ? (const char*)g.Bt + (size_t)nxt.pn * tstep : cB;
        const char* nA = (GATHER || !has_next) ? cA : (const char*)g.A + (size_t)nxt.pm * tstep;
#pragma unroll 1
        for (int t = 0; t < nt; t += 2) {
            const bool last = (t == nt - 2);
            const char* a1 = cA + (size_t)(t + 1) * kstep;
            const char* a2 = last ? nA : cA + (size_t)(t + 2) * kstep; const char* b2 = last ? nB : cB + (size_t)(t + 2) * kstep;
            const char* a3 = a2 + kstep; const char* b3 = b2 + kstep;
            if (last && has_next) S.a_ready(nxt, wid, lane);
            PG8_LDB(B0, 0, 0); PG8_LDB(B1, 0, 1); PG8_SCHED; PG8_LDA(At, 0, 0); PG8_STAGE(PG8_SA(1, 1), a1 + ah, vo1);
            PG8_WAIT_V(8); PG8_WAIT_L(0); PG8_BAR; PG8_MMA(0, 0, At, B0); PG8_MMA(0, 1, At, B1); PG8_BAR; PG8_SCHED;
            if constexpr (GATHER) if (last && has_next) { PG8_GOFF(vo0, vo1, nxt); }
            PG8_LDA(At, 0, 1); PG8_STAGE(PG8_SB(0, 0), b2, voffB); PG8_STAGE(PG8_SB(0, 1), b2 + hstep, voffB); PG8_STAGE(PG8_SA(0, 0), a2, vo0);
            PG8_WAIT_V(8); PG8_WAIT_L(0); PG8_BAR; PG8_MMA(1, 0, At, B0); PG8_MMA(1, 1, At, B1); PG8_BAR; PG8_SCHED;
            PG8_LDB(B0, 1, 0); PG8_LDB(B1, 1, 1); PG8_SCHED; PG8_LDA(At, 1, 0); PG8_STAGE(PG8_SA(0, 1), a2 + ah, vo1);
            PG8_WAIT_V(8); PG8_WAIT_L(0); PG8_BAR; PG8_MMA(0, 0, At, B0); PG8_MMA(0, 1, At, B1); PG8_BAR; PG8_SCHED;
            PG8_LDA(At, 1, 1); PG8_STAGE(PG8_SB(1, 0), b3, voffB); PG8_STAGE(PG8_SB(1, 1), b3 + hstep, voffB); PG8_STAGE(PG8_SA(1, 0), a3, vo0);
            PG8_WAIT_V(8); PG8_WAIT_L(0); PG8_BAR; PG8_MMA(1, 0, At, B0); PG8_MMA(1, 1, At, B1); PG8_BAR; PG8_SCHED;
        }
        if (wr == 0) PG8_BAR;
        if constexpr (FP8) asm volatile("s_nop 15\n\ts_nop 3" ::: "memory");
        E(acc, cur, wr, wc, fr, fq); S.done(cur, lane);
        if (!has_next) break;
#pragma unroll
        for (int a = 0; a < 2; ++a)
#pragma unroll
            for (int b = 0; b < 2; ++b)
#pragma unroll
                for (int m = 0; m < 4; ++m)
#pragma unroll
                    for (int n = 0; n < 2; ++n) acc[a][b][m][n] = (f32x4){0.f, 0.f, 0.f, 0.f};
        cur = nxt; cB = nB; cA = nA; ++ui;
        if (wr == 1) PG8_BAR;
    }
    PG8_WAIT_V(0);
    PG8_BAR;
#undef PG8_SA
#undef PG8_SB
#undef PG8_STAGE
#undef PG8_GOFF
#undef PG8_LDA
#undef PG8_LD8
#undef PG8_LO
#undef PG8_HI
#undef PG8_LDB
#undef PG8_MMA
#undef PG8_WAIT_V
#undef PG8_WAIT_L
#undef PG8_BAR
#undef PG8_SCHED
}
}
#define GAS __attribute__((address_space(1)))
#define LAS __attribute__((address_space(3)))
typedef unsigned short bf16;
typedef unsigned v4u __attribute__((ext_vector_type(4)));
typedef float f32x4 __attribute__((ext_vector_type(4)));
typedef short bf16x8 __attribute__((ext_vector_type(8)));
typedef GAS unsigned gu32;
typedef GAS unsigned long long gu64;
#define RLX_AGENT __ATOMIC_RELAXED, __HIP_MEMORY_SCOPE_AGENT
#define LDS_WAIT() asm volatile("s_waitcnt lgkmcnt(0)" ::: "memory")
#define VM_WAIT() asm volatile("s_waitcnt vmcnt(0)" ::: "memory")
__device__ __forceinline__ unsigned long long rt() { return __builtin_amdgcn_s_memrealtime(); }
__device__ __forceinline__ unsigned f2bf(float f) { unsigned u = __builtin_bit_cast(unsigned, f); return (u + 0x7fffu + ((u >> 16) & 1u)) >> 16; }
__device__ __forceinline__ unsigned pk2(float lo, float hi) { return f2bf(lo) | (f2bf(hi) << 16); }

#define XB_TMO      128
#define XB_XCNT(j)  (256  + 64 * (j))
#define XB_XSUB(j)  (1280 + 64 * (j))
#define XB_XGEN(j)  (2304 + 64 * (j))
#define XB_TOP      3328
#define XB_TOPGEN   3392
#define XCD_BAR_WORDS 3456
#define XB_SPIN_CAP (1u << 18)

__device__ __forceinline__ unsigned xb_ld(unsigned* p)              { return __hip_atomic_load(p, __ATOMIC_RELAXED, __HIP_MEMORY_SCOPE_AGENT); }
__device__ __forceinline__ unsigned xb_add(unsigned* p, unsigned v) { return __hip_atomic_fetch_add(p, v, __ATOMIC_RELAXED, __HIP_MEMORY_SCOPE_AGENT); }
__device__ __forceinline__ unsigned xb_xcc_id() { return (unsigned)__builtin_amdgcn_s_getreg((3 << 11) | 20) & 0xFu; }
#define XB_SPIN(cond, bar) do { unsigned _sp = 0; while (cond) { __builtin_amdgcn_s_sleep(1); \
    if ((++_sp & 255u) == 0u) { if (xb_ld(&(bar)[XB_TMO])) break; if (_sp > XB_SPIN_CAP) { atomicAdd(&(bar)[XB_TMO], 1u); break; } } } } while (0)

struct XcdBarrier {
    unsigned* bar; unsigned x;
    volatile LAS unsigned* st;
};

__device__ __forceinline__ XcdBarrier xcd_barrier_post(unsigned* bar, volatile LAS unsigned* st, const int tid) {
    XcdBarrier b; b.bar = bar; b.x = xb_xcc_id(); b.st = st;
    if (tid == 0) (void)xb_add(&bar[XB_XCNT(b.x)], 1u);
    return b;
}
__device__ __forceinline__ void xcd_barrier_complete(unsigned* bar, unsigned x, unsigned& nloc, unsigned& nx) {
    const unsigned G = gridDim.x * gridDim.y * gridDim.z;
    unsigned sum, cnt, mine, sp = 0u;
    for (;;) {
        sum = 0u; cnt = 0u; mine = 0u;
#pragma unroll
        for (unsigned j = 0; j < 16; ++j) { const unsigned c = xb_ld(&bar[XB_XCNT(j)]); sum += c; cnt += (c > 0u) ? 1u : 0u; mine = (j == x) ? c : mine; }
        if (sum == G) break;
        __builtin_amdgcn_s_sleep(1);
        if ((++sp & 255u) == 0u) { if (xb_ld(&bar[XB_TMO])) break; if (sp > XB_SPIN_CAP) { atomicAdd(&bar[XB_TMO], 1u); break; } }
    }
    nloc = mine > 0u ? mine : 1u; nx = cnt > 0u ? cnt : 1u;
}

__device__ __forceinline__ void xcd_barrier(const XcdBarrier& b, const int tid) {
    asm volatile("s_waitcnt vmcnt(0)" ::: "memory");
    __syncthreads();
    if (tid == 0) {
        unsigned* bar = b.bar;
        __builtin_amdgcn_s_waitcnt(0);
        unsigned nloc = b.st[0], nx = b.st[1];
        if (nloc == 0u) { xcd_barrier_complete(bar, b.x, nloc, nx); b.st[0] = nloc; b.st[1] = nx; }
        const unsigned old = xb_add(&bar[XB_XSUB(b.x)], 1u);
        const unsigned gen = old / nloc;
        if (old + 1u == (gen + 1u) * nloc) {
            __builtin_amdgcn_fence(__ATOMIC_RELEASE, "agent");
            asm volatile("s_waitcnt vmcnt(0)" ::: "memory");
            const unsigned og = xb_add(&bar[XB_TOP], 1u);
            const unsigned tg = og / nx;
            if (og + 1u == (tg + 1u) * nx) xb_add(&bar[XB_TOPGEN], 1u);
            else XB_SPIN(xb_ld(&bar[XB_TOPGEN]) == tg, bar);
            __builtin_amdgcn_fence(__ATOMIC_ACQUIRE, "agent");
            xb_add(&bar[XB_XGEN(b.x)], 1u);
            asm volatile("s_waitcnt vmcnt(0)" ::: "memory");
        } else {
            XB_SPIN(xb_ld(&bar[XB_XGEN(b.x)]) == gen, bar);
            __builtin_amdgcn_fence(__ATOMIC_ACQUIRE, "agent");
            asm volatile("s_waitcnt vmcnt(0)" ::: "memory");
        }
    }
    __syncthreads();
}
#include <hip/hip_bf16.h>
#include <cmath>
namespace attn_body {
using bf16=__hip_bfloat16;
using bf16x8=__attribute__((ext_vector_type(8)))short;
using s16x4=__attribute__((ext_vector_type(4)))short;
using f32x16=__attribute__((ext_vector_type(16)))float;
using u32x4=__attribute__((ext_vector_type(4)))unsigned;
constexpr int BATCH=2,SEQ=4096,D=64,DM=1024,OP=2048;
constexpr int NW=8,QBLK=32,QB=QBLK*NW,KVBLK=64,NQB=SEQ/QB;
constexpr int ATTN_PITCH=DM, ATTN_UNIT_ROWS=QB;
__device__ __forceinline__ int crow(int r,int hi){return (r&3)+8*(r>>2)+4*hi;}
#define SBAR() __builtin_amdgcn_sched_barrier(0)
__device__ __forceinline__ void cmask(f32x16&p0,f32x16&p1,int t,int NT,int wid,int qw,int r32,int hi,const __attribute__((address_space(3))) float*tab){
  const float NEG=-INFINITY; const int jb=t-(NT-4);
  if(jb>(wid>>1)){
    #pragma unroll
    for(int r=0;r<16;++r){p0[r]=NEG;p1[r]=NEG;}
  } else if(64*t>qw-154){
    const __attribute__((address_space(3))) float*tb=tab+(64*t+4*hi-(qw+r32)+191);
    #pragma unroll
    for(int g=0;g<4;++g){
      #pragma unroll
      for(int q=0;q<4;++q){const int r=4*g+q; p0[r]+=tb[(r&3)+8*(r>>2)];p1[r]+=tb[(r&3)+8*(r>>2)+32];}
      asm volatile("":"+v"(p0),"+v"(p1)); }
  }
}

constexpr int NSLOT=3, SLOTB=8192;
constexpr int LDS_K=0, LDS_V=NSLOT*SLOTB, LDS_WS=LDS_V+NSLOT*2*SLOTB, LDS_OST=LDS_WS+NW*64*4, LDS_BYTES=LDS_OST+NW*8192;
constexpr float C2=0.125f*1.4426950408889634f;
__device__ __forceinline__ void glds16(const void*gsrc,unsigned lds_dst){unsigned keep;
  asm volatile("s_mov_b32 %0, m0\n\ts_mov_b32 m0, %2\n\ts_nop 0\n\tglobal_load_lds_dwordx4 %1, off\n\ts_mov_b32 m0, %0":"=&s"(keep):"v"(gsrc),"s"(lds_dst):"memory");}
__device__ __forceinline__ float max3f(float a,float b,float c){float r;asm("v_max3_f32 %0, %1, %2, %3":"=v"(r):"v"(a),"v"(b),"v"(c));return r;}
__device__ __forceinline__ float max2f(float a,float b){float r;asm("v_max_f32_e32 %0, %1, %2":"=v"(r):"v"(a),"v"(b));return r;}
__device__ __forceinline__ float fadd_s(float a,float b){float r;asm("v_add_f32_e32 %0, %1, %2":"=v"(r):"v"(a),"v"(b));return r;}
__device__ __forceinline__ float fsub_s(float a,float b){float r;asm("v_sub_f32_e32 %0, %1, %2":"=v"(r):"v"(a),"v"(b));return r;}
typedef float f32x2_t __attribute__((ext_vector_type(2))); typedef __bf16 bf16x2_t __attribute__((ext_vector_type(2)));
__device__ __forceinline__ unsigned cvtpk_s(float lo,float hi){f32x2_t v={lo,hi};bf16x2_t b=__builtin_convertvector(v,bf16x2_t);return __builtin_bit_cast(unsigned,b);}
#define WAIT_BAR(N) asm volatile("s_waitcnt vmcnt(" #N ") lgkmcnt(0)\n\ts_barrier":::"memory")

__device__ __forceinline__ void qkt(f32x16&p0,f32x16&p1,const char*Kslot,const bf16x8*qr,int r32,int hi){
  const f32x16 negm={};
  const char*kb=Kslot+hi*1024+r32*16;
  #pragma unroll
  for(int d0=0;d0<4;++d0){
    const bf16x8 b0=*reinterpret_cast<const bf16x8*>(kb+d0*2048);
    const bf16x8 b1=*reinterpret_cast<const bf16x8*>(kb+d0*2048+512);
    if(d0==0){p0=__builtin_amdgcn_mfma_f32_32x32x16_bf16(b0,qr[0],negm,0,0,0);p1=__builtin_amdgcn_mfma_f32_32x32x16_bf16(b1,qr[0],negm,0,0,0);}
    else{p0=__builtin_amdgcn_mfma_f32_32x32x16_bf16(b0,qr[d0],p0,0,0,0);p1=__builtin_amdgcn_mfma_f32_32x32x16_bf16(b1,qr[d0],p1,0,0,0);}}
}
typedef __attribute__((address_space(3))) const char* lds_cptr;
typedef short v4i16_t __attribute__((ext_vector_type(4)));
__device__ __forceinline__ void kload8(bf16x8*kf,lds_cptr kp){
  kf[0]=*(const __attribute__((address_space(3))) bf16x8*)(kp);      kf[1]=*(const __attribute__((address_space(3))) bf16x8*)(kp+512);
  kf[2]=*(const __attribute__((address_space(3))) bf16x8*)(kp+2048); kf[3]=*(const __attribute__((address_space(3))) bf16x8*)(kp+2560);
  kf[4]=*(const __attribute__((address_space(3))) bf16x8*)(kp+4096); kf[5]=*(const __attribute__((address_space(3))) bf16x8*)(kp+4608);
  kf[6]=*(const __attribute__((address_space(3))) bf16x8*)(kp+6144); kf[7]=*(const __attribute__((address_space(3))) bf16x8*)(kp+6656);
}
__device__ __forceinline__ void kload2(bf16x8*kf,lds_cptr kp,int j){ kf[2*j]=*(const __attribute__((address_space(3))) bf16x8*)(kp+j*2048); kf[2*j+1]=*(const __attribute__((address_space(3))) bf16x8*)(kp+j*2048+512); }
__device__ __forceinline__ s16x4 vtr(lds_cptr p){ return __builtin_bit_cast(s16x4,__builtin_amdgcn_ds_read_tr16_b64_v4i16((__attribute__((address_space(3))) v4i16_t*)p)); }
__device__ __forceinline__ float rowmax(const f32x16&p0,const f32x16&p1){
  float a=max3f(p0[0],p0[1],p1[0]),b=max3f(p0[2],p0[3],p1[1]);a=max3f(a,p1[2],p1[3]);
  #pragma unroll
  for(int r=4;r<16;r+=4){a=max3f(a,p0[r],p0[r+1]);b=max3f(b,p0[r+2],p0[r+3]);a=max3f(a,p1[r],p1[r+1]);b=max3f(b,p1[r+2],p1[r+3]);}
  const float m=max2f(a,b);
  auto rr=__builtin_amdgcn_permlane32_swap(__float_as_uint(m),__float_as_uint(m),false,false);
  return max2f(__uint_as_float(rr[0]),__uint_as_float(rr[1]));
}
__device__ __forceinline__ void pv(f32x16*o,int vb,bf16x8 pa0,bf16x8 pa1,bf16x8 pa2,bf16x8 pa3){
  #pragma unroll
  for(int d0=0;d0<4;++d0){s16x4 lo[4],hi[4];
    #pragma unroll
    for(int ks=0;ks<4;++ks){
      asm volatile("ds_read_b64_tr_b16 %0,%1 offset:%c2":"=&v"(lo[ks]):"v"(vb),"i"(d0*4096+ks*1024):"memory");
      asm volatile("ds_read_b64_tr_b16 %0,%1 offset:%c2":"=&v"(hi[ks]):"v"(vb),"i"(d0*4096+ks*1024+512):"memory");}
    asm volatile("s_waitcnt lgkmcnt(0)":::"memory");SBAR();
    #define PK(k) (bf16x8){lo[k][0],lo[k][1],lo[k][2],lo[k][3],hi[k][0],hi[k][1],hi[k][2],hi[k][3]}
    o[d0]=__builtin_amdgcn_mfma_f32_32x32x16_bf16(pa0,PK(0),o[d0],0,0,0);
    o[d0]=__builtin_amdgcn_mfma_f32_32x32x16_bf16(pa1,PK(1),o[d0],0,0,0);
    o[d0]=__builtin_amdgcn_mfma_f32_32x32x16_bf16(pa2,PK(2),o[d0],0,0,0);
    o[d0]=__builtin_amdgcn_mfma_f32_32x32x16_bf16(pa3,PK(3),o[d0],0,0,0);
    #undef PK
  }
}

#ifndef ATTN_STORE16
#define ATTN_STORE16(p,v) (*(u32x4*)(p)=(v))
#endif
template<int THRL> __device__ __forceinline__ void attn_unit(int b,int qcol,int vcol,int ocol,int qb,const bf16*Q,const bf16*__restrict__ K,const bf16*__restrict__ V,bf16*O,char*shm,const __attribute__((address_space(3))) float*tab,const int tid){
  const int lane=tid&63,r32=lane&31,hi=lane>>5; const int wid=__builtin_amdgcn_readfirstlane(tid>>6);
  const long rowbase=(long)b*SEQ; const int q0=qb*QB;
  const bf16*Qw=Q+(rowbase+q0+wid*QBLK)*DM+qcol;
  const bf16*Kh=K+rowbase*DM+qcol,*Vh=V+rowbase*DM+vcol;
  const unsigned lds0=(unsigned)(uintptr_t)shm;
  float*wsf=(float*)(shm+LDS_WS)+wid*64;
  const bf16*ksrc=Kh+(long)lane*DM+wid*8;
  const bf16*vsrc=Vh+(long)(16*(wid&3)+(lane>>2))*DM+(wid>>2)*32+(lane&3)*8;
  const unsigned kdst=lds0+LDS_K+wid*1024, vdst=lds0+LDS_V+wid*1024;
  #define DMA_K(t,slot) glds16(ksrc+(long)(t)*KVBLK*DM,(unsigned)__builtin_amdgcn_readfirstlane(kdst+(slot)))
  #define DMA_V(t,slot) do{ glds16(vsrc+(long)(t)*KVBLK*DM,(unsigned)__builtin_amdgcn_readfirstlane(vdst+2*(slot))); glds16(vsrc+64+(long)(t)*KVBLK*DM,(unsigned)__builtin_amdgcn_readfirstlane(vdst+8192+2*(slot))); }while(0)
  const int vb0=(int)(lds0+LDS_V)+((lane>>4)&1)*32+(lane&3)*8+(4*hi+((lane&15)>>2))*64;
  const char*Kbase=shm+LDS_K; bf16x8 kf[8];
  const lds_cptr shm3=(lds_cptr)shm; const lds_cptr kp0=shm3+LDS_K+hi*1024+r32*16; const lds_cptr vp0=shm3+LDS_V+((lane>>4)&1)*32+(lane&3)*8+(4*hi+((lane&15)>>2))*64;
  const int NT=(q0+QB)/KVBLK;
  DMA_K(0,0);DMA_V(0,0);DMA_K(1,SLOTB);
  bf16x8 qr[4];
  #pragma unroll
  for(int d0=0;d0<4;++d0)qr[d0]=*reinterpret_cast<const bf16x8*>(&Qw[(long)r32*DM+d0*16+hi*8]);
  float mhat=0.f,l_reg=0.f;f32x16 o[4];
  const int qw=q0+wid*QBLK;
  #define CMASK(P0,P1,t) cmask(P0,P1,(t),NT,wid,qw,r32,hi,tab)
  bool resc=false;
  #define START(P0,P1) do{ const float rm=rowmax(P0,P1); resc=false; mhat=rm; \
      _Pragma("unroll") for(int r=0;r<16;++r){P0[r]=fsub_s(P0[r],rm);P1[r]=fsub_s(P1[r],rm);} \
    _Pragma("unroll") for(int r=0;r<16;++r)P0[r]=__builtin_amdgcn_exp2f(P0[r]); }while(0)
  #define RESC() do{ if(resc){ asm volatile("s_waitcnt lgkmcnt(0)":::"memory"); \
      _Pragma("unroll") for(int r=0;r<16;++r){ const float f_=wsf[crow(r,hi)]; o[0][r]*=f_; o[1][r]*=f_; o[2][r]*=f_; o[3][r]*=f_; } } }while(0)
  f32x16 pA0,pA1,pB0,pB1;
  int sl_prev=0,sl_cur=0,sl_next=SLOTB;
  #define ROT() do{sl_prev=sl_cur;sl_cur=sl_next;sl_next=(sl_next==(NSLOT-1)*SLOTB)?0:sl_next+SLOTB;}while(0)
  DMA_K(2,2*SLOTB);
  WAIT_BAR(4);
  qkt(pA0,pA1,Kbase,qr,r32,hi);asm volatile("s_nop 15\n\ts_nop 7":"+v"(pA0),"+v"(pA1));CMASK(pA0,pA1,0);
  START(pA0,pA1);
  _Pragma("unroll") for(int r=0;r<16;++r)pA1[r]=__builtin_amdgcn_exp2f(pA1[r]);
  WAIT_BAR(0);
  DMA_K(3,0);DMA_V(1,SLOTB);
  ROT();
  kload8(kf,kp0+sl_cur);
  WAIT_BAR(3);
  { float z_; asm volatile("v_mov_b32 %0, 0":"=v"(z_)); _Pragma("unroll") for(int r=0;r<16;++r){o[0][r]=z_;o[1][r]=z_;o[2][r]=z_;o[3][r]=z_;} }
  s16x4 vlo[8],vhi[8]; u32x4 pw0,pw1,pw2,pw3;
  #define PKW(P,B) cvtpk_s(P[B],P[B+1])
  #define PAF(k) __builtin_bit_cast(bf16x8,pw##k)
  #define VFR(i) (bf16x8){vlo[i][0],vlo[i][1],vlo[i][2],vlo[i][3],vhi[i][0],vhi[i][1],vhi[i][2],vhi[i][3]}
  #define PIN(x) asm volatile("":"+v"(x))
  #define MX3(a,b,c) __builtin_fmaxf(__builtin_fmaxf((a),(b)),(c))
  #define GAPA(MF,A0,A1,A2,A3,W0,W1,PW) do{ MF; sacc+=A0; sacc+=A1; sacc+=A2; sacc+=A3; PIN(sacc); W0; W1; PIN(PW); SBAR(); }while(0)
  #define EX(v) __builtin_amdgcn_exp2f(v)
  #define GAPB(MF,X,B) do{ MF; X[B]=EX(X[B]); X[B+1]=EX(X[B+1]); PIN(X); SBAR(); }while(0)
  #define VRD(s,f) do{ vlo[s]=vtr(vp_+(((f)>>2)*4096+((f)&3)*1024)); vhi[s]=vtr(vp_+(((f)>>2)*4096+((f)&3)*1024+512)); }while(0)
  #define KRD(G,j) do{ if(G){ kload2(kf,kp0+sl_next,j); SBAR(); } }while(0)
  #define ZC (f32x16){}
  #define STEP(C0,C1,P0,P1,t,GK,GV,GL) do{ SBAR(); \
    const lds_cptr vp_=vp0+2*sl_prev; \
    VRD(0,0); SBAR(); float sacc=(P0[0]+P0[1]); \
    GAPA(C0=__builtin_amdgcn_mfma_f32_32x32x16_bf16(kf[0],qr[0],ZC,0,0,0), P0[2],P0[3],P0[4],P0[5],     pw0[0]=PKW(P0,0), pw0[1]=PKW(P0,2), pw0); \
    VRD(1,4); SBAR(); GAPA(C1=__builtin_amdgcn_mfma_f32_32x32x16_bf16(kf[1],qr[0],ZC,0,0,0), P0[6],P0[7],P0[8],P0[9],     pw0[2]=PKW(P0,4), pw0[3]=PKW(P0,6), pw0); \
    VRD(2,1); SBAR(); GAPA(C0=__builtin_amdgcn_mfma_f32_32x32x16_bf16(kf[2],qr[1],C0,0,0,0),   P0[10],P0[11],P0[12],P0[13], pw1[0]=PKW(P0,8), pw1[1]=PKW(P0,10), pw1); \
    VRD(3,5); SBAR(); GAPA(C1=__builtin_amdgcn_mfma_f32_32x32x16_bf16(kf[3],qr[1],C1,0,0,0),   P0[14],P0[15],P1[0],P1[1],   pw1[2]=PKW(P0,12),pw1[3]=PKW(P0,14), pw1); \
    GAPA(C0=__builtin_amdgcn_mfma_f32_32x32x16_bf16(kf[4],qr[2],C0,0,0,0),   P1[2],P1[3],P1[4],P1[5],     pw2[0]=PKW(P1,0), pw2[1]=PKW(P1,2), pw2); \
    GAPA(C1=__builtin_amdgcn_mfma_f32_32x32x16_bf16(kf[5],qr[2],C1,0,0,0),   P1[6],P1[7],P1[8],P1[9],     pw2[2]=PKW(P1,4), pw2[3]=PKW(P1,6), pw2); \
    GAPA(C0=__builtin_amdgcn_mfma_f32_32x32x16_bf16(kf[6],qr[3],C0,0,0,0),   P1[10],P1[11],P1[12],P1[13], pw3[0]=PKW(P1,8), pw3[1]=PKW(P1,10), pw3); \
    GAPA(C1=__builtin_amdgcn_mfma_f32_32x32x16_bf16(kf[7],qr[3],C1,0,0,0),   P1[14],P1[15],0.f,0.f,       pw3[2]=PKW(P1,12),pw3[3]=PKW(P1,14), pw3); \
    l_reg+=sacc; \
    if(GK){DMA_K((t)+3,sl_cur);} if(GV){DMA_V((t)+1,sl_next);} \
    CMASK(C0,C1,t); \
    { float a=MX3(C0[0],C0[1],C1[0]),b_=MX3(C0[2],C0[3],C1[1]); a=MX3(a,C1[2],C1[3]); \
      _Pragma("unroll") for(int r=4;r<16;r+=4){a=MX3(a,C0[r],C0[r+1]);b_=MX3(b_,C0[r+2],C0[r+3]);a=MX3(a,C1[r],C1[r+1]);b_=MX3(b_,C1[r+2],C1[r+3]);} \
      float rm=__builtin_fmaxf(a,b_); { auto rr=__builtin_amdgcn_permlane32_swap(__float_as_uint(rm),__float_as_uint(rm),false,false); rm=__builtin_fmaxf(__uint_as_float(rr[0]),__uint_as_float(rr[1])); } \
      rm-=mhat; resc=false; \
      if(__builtin_expect(__any(rm>(float)THRL),0)){ const float dl=__builtin_fmaxf(rm,0.f); mhat+=dl; \
        const float f=__builtin_amdgcn_exp2f(-dl); l_reg*=f; if(hi==0)wsf[r32]=f; resc=true; } \
      _Pragma("unroll") for(int r=0;r<16;++r){C0[r]-=mhat;C1[r]-=mhat;} } \
    SBAR(); \
    GAPB(o[0]=__builtin_amdgcn_mfma_f32_32x32x16_bf16(PAF(0),VFR(0),o[0],0,0,0), C0,0);  VRD(4,2); SBAR(); \
    GAPB(o[1]=__builtin_amdgcn_mfma_f32_32x32x16_bf16(PAF(0),VFR(1),o[1],0,0,0), C0,2);  VRD(5,6); SBAR(); \
    KRD(GL,0); GAPB(o[0]=__builtin_amdgcn_mfma_f32_32x32x16_bf16(PAF(1),VFR(2),o[0],0,0,0), C0,4);  VRD(6,3); SBAR(); \
    KRD(GL,1); GAPB(o[1]=__builtin_amdgcn_mfma_f32_32x32x16_bf16(PAF(1),VFR(3),o[1],0,0,0), C0,6);  VRD(7,7); SBAR(); \
    KRD(GL,2); GAPB(o[0]=__builtin_amdgcn_mfma_f32_32x32x16_bf16(PAF(2),VFR(4),o[0],0,0,0), C0,8);  VRD(0,8); SBAR(); \
    KRD(GL,3); GAPB(o[1]=__builtin_amdgcn_mfma_f32_32x32x16_bf16(PAF(2),VFR(5),o[1],0,0,0), C0,10); VRD(1,12); SBAR(); \
    GAPB(o[0]=__builtin_amdgcn_mfma_f32_32x32x16_bf16(PAF(3),VFR(6),o[0],0,0,0), C0,12); VRD(2,9); SBAR(); \
    GAPB(o[1]=__builtin_amdgcn_mfma_f32_32x32x16_bf16(PAF(3),VFR(7),o[1],0,0,0), C0,14); VRD(3,13); SBAR(); \
    GAPB(o[2]=__builtin_amdgcn_mfma_f32_32x32x16_bf16(PAF(0),VFR(0),o[2],0,0,0), C1,0);  VRD(4,10); SBAR(); \
    GAPB(o[3]=__builtin_amdgcn_mfma_f32_32x32x16_bf16(PAF(0),VFR(1),o[3],0,0,0), C1,2);  VRD(5,14); SBAR(); \
    GAPB(o[2]=__builtin_amdgcn_mfma_f32_32x32x16_bf16(PAF(1),VFR(2),o[2],0,0,0), C1,4);  VRD(6,11); SBAR(); \
    GAPB(o[3]=__builtin_amdgcn_mfma_f32_32x32x16_bf16(PAF(1),VFR(3),o[3],0,0,0), C1,6);  VRD(7,15); SBAR(); \
    GAPB(o[2]=__builtin_amdgcn_mfma_f32_32x32x16_bf16(PAF(2),VFR(4),o[2],0,0,0), C1,8); \
    GAPB(o[3]=__builtin_amdgcn_mfma_f32_32x32x16_bf16(PAF(2),VFR(5),o[3],0,0,0), C1,10); \
    GAPB(o[2]=__builtin_amdgcn_mfma_f32_32x32x16_bf16(PAF(3),VFR(6),o[2],0,0,0), C1,12); \
    GAPB(o[3]=__builtin_amdgcn_mfma_f32_32x32x16_bf16(PAF(3),VFR(7),o[3],0,0,0), C1,14); \
    }while(0)
  int t=1;
  #undef CMASK
  #define CMASK(P0,P1,t) do{}while(0)
  for(;t+7<NT;t+=2){
    STEP(pB0,pB1,pA0,pA1,t,true,true,true);     WAIT_BAR(3); RESC(); ROT();
    STEP(pA0,pA1,pB0,pB1,t+1,true,true,true);   WAIT_BAR(3); RESC(); ROT();
  }
  #undef CMASK
  #define CMASK(P0,P1,t) cmask(P0,P1,(t),NT,wid,qw,r32,hi,tab)
  #define ENDW(tt) do{ if((tt)+3<NT){WAIT_BAR(3);} else if((tt)+2<NT){WAIT_BAR(2);} else {WAIT_BAR(0);} }while(0)
  for(;t+1<NT;t+=2){
    STEP(pB0,pB1,pA0,pA1,t,(t+3<NT),(t+1<NT),(t+1<NT));       ENDW(t);   RESC(); ROT();
    STEP(pA0,pA1,pB0,pB1,t+1,(t+4<NT),(t+2<NT),(t+2<NT));     ENDW(t+1); RESC(); ROT();
  }
  STEP(pB0,pB1,pA0,pA1,NT-1,false,false,false); RESC();
  { float sacc=pB0[0]+pB0[1]; _Pragma("unroll") for(int r=2;r<16;++r)sacc+=pB0[r]; _Pragma("unroll") for(int r=0;r<16;++r)sacc+=pB1[r]; l_reg+=sacc;
    pw0=(u32x4){PKW(pB0,0),PKW(pB0,2),PKW(pB0,4),PKW(pB0,6)};pw1=(u32x4){PKW(pB0,8),PKW(pB0,10),PKW(pB0,12),PKW(pB0,14)};pw2=(u32x4){PKW(pB1,0),PKW(pB1,2),PKW(pB1,4),PKW(pB1,6)};pw3=(u32x4){PKW(pB1,8),PKW(pB1,10),PKW(pB1,12),PKW(pB1,14)};
    SBAR(); pv(o,vb0+2*sl_cur,PAF(0),PAF(1),PAF(2),PAF(3)); }
  #undef PKW
  #undef PAF
  #undef VFR
  #undef PIN
  #undef MX3
  #undef GAPA
  #undef GAPB
  #undef EX
  #undef VRD
  #undef KRD
  #undef ZC
  #undef STEP
  #undef ENDW
  {auto rr=__builtin_amdgcn_permlane32_swap(__float_as_uint(l_reg),__float_as_uint(l_reg),false,false);l_reg=__uint_as_float(rr[0])+__uint_as_float(rr[1]);}
  if(hi==0)wsf[32+r32]=l_reg;asm volatile("s_waitcnt lgkmcnt(0)":::"memory");
  float rli[16];
  #pragma unroll
  for(int r=0;r<16;++r)rli[r]=__builtin_amdgcn_rcpf(wsf[32+crow(r,hi)]);
  bf16*Ow=O+(rowbase+q0+wid*QBLK)*OP+ocol;
  { bf16*stg=(bf16*)(shm+LDS_OST)+wid*4096;
    #pragma unroll
    for(int r=0;r<16;++r){const int orow=crow(r,hi);
      #pragma unroll
      for(int d0=0;d0<4;++d0)stg[orow*128+d0*32+r32]=__float2bfloat16(o[d0][r]*rli[r]);}
    asm volatile("s_waitcnt lgkmcnt(0)":::"memory");
    const bf16*sp=stg+(lane>>4)*128+(lane&15)*8; __attribute__((address_space(1))) bf16*gp=(__attribute__((address_space(1))) bf16*)(Ow+(long)(lane>>4)*OP+(lane&15)*8);
    #pragma unroll
    for(int i=0;i<8;++i){ const u32x4 v=*(const u32x4*)(sp+i*512); *(__attribute__((address_space(1))) u32x4*)gp=v; gp+=4*OP; asm volatile("":"+v"(gp)); } }
  asm volatile("s_waitcnt lgkmcnt(0)\n\ts_barrier":::"memory");
  #undef DMA_K
  #undef DMA_V
  #undef CMASK
  #undef START
  #undef RESC
  #undef ROT
}
constexpr int ATTN_LDS_BYTES=LDS_BYTES;
struct AttnTensors { const bf16* Q; const bf16* K; const bf16* V; bf16* O; };
template<int THRL=8> __device__ __forceinline__ void attn_phase(char*lds,const AttnTensors&T,int vcu,const float*rel_bias,const int tid){
  const int hc=vcu>>3,s=vcu&7,map=hc&1,h=(hc>>1)&7,b=hc>>4;
  __attribute__((address_space(3))) float*tab=(__attribute__((address_space(3))) float*)(lds+LDS_BYTES);
  { const float c15=rel_bias[15*8+h];
    for(int i=tid;i<256;i+=512){ const int rel=i-191; const int n=rel<0?-rel:rel;
      int bk=n<8?n:n<12?8:n<16?9:n<23?10:n<32?11:n<46?12:n<64?13:n<91?14:15; if(rel>0)bk+=16;
      tab[i]=(rel_bias[bk*8+h]-c15)*1.4426950408889634f; } }
  asm volatile("s_waitcnt lgkmcnt(0)\n\ts_barrier":::"memory");
  #pragma unroll 1
  for(int i=0;i<2;++i){ const int qb=(i==0)?s:15-s;
    attn_unit<THRL>(b,h*128+map*64,h*128,h*256+map*128,qb,T.Q,T.K,T.V,T.O,lds,tab,tid); }
}
#undef SBAR
#undef WAIT_BAR
}

constexpr int BATCH = 2, SEQ = 4096, T = BATCH * SEQ, D = 2048;
constexpr int NPROJ = 7184, NPROJ_PAD = 7424, SEGW = 1024;
constexpr int NH = 8, CH = 64, NCH = SEQ / CH;
constexpr int NEXP = 32, FE = 512;
constexpr float EPS = 1e-6f, LOG2E = 1.4426950408889634f;
constexpr float QSCALE = 0.125f * LOG2E;
static_assert(T == pg8::kT, "token count");

constexpr size_t MiB = 1u << 20;
constexpr size_t WS_CTL = 0, CTL_ZERO_BYTES = 1 * MiB;
constexpr size_t WS_WIN = 1 * MiB, WS_WOUT = 30 * MiB, WS_WGU = 38 * MiB, WS_WD = 166 * MiB;
constexpr size_t WS_XN = 230 * MiB, WS_SEG = 262 * MiB, WS_GATES = 374 * MiB, WS_OA = 375 * MiB, WS_QC = 407 * MiB, WS_KC = 423 * MiB, WS_CLOC = 439 * MiB, WS_MISC = 503 * MiB, WS_END = 505 * MiB;
constexpr size_t SEG_BYTES = (size_t)T * SEGW * 2;
constexpr size_t WS_QD = WS_SEG, WS_KD = WS_SEG + SEG_BYTES, WS_VD = WS_SEG + 2 * SEG_BYTES, WS_QM = WS_SEG + 3 * SEG_BYTES, WS_KM = WS_SEG + 4 * SEG_BYTES, WS_VM = WS_SEG + 5 * SEG_BYTES, WS_OM = WS_SEG + 6 * SEG_BYTES;
constexpr size_t WS_BCUM = WS_MISC, WS_NLOC = WS_MISC + 256 * 1024, WS_G = WS_MISC + MiB, WS_MLOC = WS_G + 4096, WS_MPREV = WS_G + 8192;
constexpr size_t WS_A2 = WS_XN, WS_X1 = 262 * MiB, WS_H2 = 326 * MiB, WS_LIST = 358 * MiB, WS_LISTW = 359 * MiB, WS_ROWTOK = 360 * MiB, WS_ROWW = 360 * MiB + 512 * 1024, WS_TAB = 361 * MiB;
constexpr size_t WS_HS = 375 * MiB, WS_HID = 471 * MiB, WS_Y0 = 230 * MiB, WS_Y1 = 326 * MiB;
constexpr int LDP = 2112;
constexpr size_t WS_XNP = WS_CLOC;
constexpr int MAXROWS = 24576;
constexpr int CW_CNT = 32768;

struct Params {
    const float *x, *rel_bias, *ln_mix_g, *w_in, *conv_w, *conv_b, *b_i, *b_f, *lam_q1, *lam_k1, *lam_q2, *lam_k2, *diff_norm_g, *mlstm_norm_g, *w_out, *ln_ffn_g,
                *w_group, *b_group, *w_router, *b_router, *w_gate, *w_up, *w_down, *ln_f_g;
    float* out; unsigned char* ws;
    int ph_lo, ph_hi, li, pad;
};

__device__ __forceinline__ float bf2f(unsigned short v) { return __uint_as_float((unsigned)v << 16); }
__device__ __forceinline__ float wave_sum(float v) {
#pragma unroll
    for (int o = 1; o < 64; o <<= 1) v += __shfl_xor(v, o);
    return v;
}
__device__ __forceinline__ float wave_max(float v) {
#pragma unroll
    for (int o = 1; o < 64; o <<= 1) v = fmaxf(v, __shfl_xor(v, o));
    return v;
}
__device__ __forceinline__ int t5_bucket(int rel) {
    const int n = rel < 0 ? -rel : rel;
    int b = n < 8 ? n : n < 12 ? 8 : n < 16 ? 9 : n < 23 ? 10 : n < 32 ? 11 : n < 46 ? 12 : n < 64 ? 13 : n < 91 ? 14 : 15;
    return b + (rel > 0 ? 16 : 0);
}

__device__ __forceinline__ unsigned cvtpk_rne(float lo, float hi) { typedef float f2_t __attribute__((ext_vector_type(2))); typedef __bf16 b2_t __attribute__((ext_vector_type(2))); f2_t v = {lo, hi}; b2_t b = __builtin_convertvector(v, b2_t); return __builtin_bit_cast(unsigned, b); }
__device__ __forceinline__ void conv_block64(const float* src, size_t ld, bf16* dst, size_t kd, int lane, int nvalid, float sc, LAS unsigned char* scr  ) {
    if (lane < nvalid) {
        const GAS float* s = (const GAS float*)src + lane; float v[64];
#pragma unroll
        for (int i = 0; i < 64; ++i) v[i] = s[(size_t)i * ld];
        LAS v4u* w = (LAS v4u*)(scr + lane * 144);
#pragma unroll
        for (int g = 0; g < 8; ++g) { v4u o; o.x = cvtpk_rne(v[8 * g] * sc, v[8 * g + 1] * sc); o.y = cvtpk_rne(v[8 * g + 2] * sc, v[8 * g + 3] * sc); o.z = cvtpk_rne(v[8 * g + 4] * sc, v[8 * g + 5] * sc); o.w = cvtpk_rne(v[8 * g + 6] * sc, v[8 * g + 7] * sc); w[g] = o; }
    }
    LDS_WAIT(); asm volatile("" ::: "memory");
    const int c = lane & 7;
#pragma unroll
    for (int j = 0; j < 8; ++j) { const int n = (lane >> 3) + 8 * j; if (n < nvalid) { const v4u o = *(const LAS v4u*)(scr + n * 144 + c * 16); *(GAS v4u*)(dst + (size_t)n * kd + 8 * c) = o; } }
    LDS_WAIT(); asm volatile("" ::: "memory");
}
__device__ __forceinline__ void rms_row_to_bf16(const float* xrow, const float* g, bf16* orow, int lane) {
    const GAS f32x4* xr = (const GAS f32x4*)xrow + lane; const GAS f32x4* gr = (const GAS f32x4*)g + lane;
    f32x4 v[8]; float s = 0.f;
#pragma unroll
    for (int j = 0; j < 8; ++j) { v[j] = xr[64 * j]; s += (v[j].x * v[j].x + v[j].y * v[j].y) + (v[j].z * v[j].z + v[j].w * v[j].w); }
    const float rstd = rsqrtf(wave_sum(s) * (1.f / D) + EPS);
    GAS unsigned long long* o8 = (GAS unsigned long long*)orow + lane;
#pragma unroll
    for (int j = 0; j < 8; ++j) { const f32x4 gv = gr[64 * j];
        o8[64 * j] = (unsigned long long)pk2(v[j].x * rstd * gv.x, v[j].y * rstd * gv.y) | ((unsigned long long)pk2(v[j].z * rstd * gv.z, v[j].w * rstd * gv.w) << 32); }
}
__device__ __forceinline__ void prologue_body(const Params& p, int gw, int NGW, int lane, LAS unsigned char* scr) {
    bf16* Win = (bf16*)(p.ws + WS_WIN); bf16* XN = (bf16*)(p.ws + WS_XNP);
    constexpr int I_IN = 32 * 112, I_ING = 32;
    for (int it = gw; it < I_IN + I_ING; it += NGW) {
        if (it < I_IN) { const int kb = it / 112, nb = it % 112; conv_block64(p.w_in + (size_t)(64 * kb) * NPROJ + 64 * nb, NPROJ, Win + (size_t)(64 * nb) * LDP + 64 * kb, LDP, lane, 64, nb < 16 ? QSCALE : 1.f, scr); }
        else { const int kb = it - I_IN; conv_block64(p.w_in + (size_t)(64 * kb) * NPROJ + 7168, NPROJ, Win + (size_t)7168 * LDP + 64 * kb, LDP, lane, 16, 1.f, scr); }
    }
    for (int m = gw; m < T; m += NGW) rms_row_to_bf16(p.x + (size_t)m * D, p.ln_mix_g, XN + (size_t)m * LDP, lane);
}
constexpr int CW_Q = 40960;
struct CvItem { const float* src; unsigned char* dst; int ld, kd; float sc; int k0; };
__device__ __forceinline__ CvItem cv_decode(const Params& p, int r) {
    constexpr int I_OUT = 32 * 32, I_G = NEXP * 32 * 8;
    CvItem it;
    if (r < I_OUT) { const int kb = r >> 5, nb = r & 31; it.src = p.w_out + (size_t)(64 * kb) * D + 64 * nb; it.ld = D; it.dst = p.ws + WS_WOUT + ((size_t)(64 * nb) * D + 64 * kb) * 2; it.kd = D * 2; it.sc = 0.f; it.k0 = 0; return it; } r -= I_OUT;
    if (r < 2 * I_G) { const int up = (r >= I_G) ? 1 : 0; if (up) r -= I_G; const int e = r >> 8, qq = r & 255, kb = qq >> 3, nb = qq & 7;
        it.src = (up ? p.w_up : p.w_gate) + (size_t)e * D * FE + (size_t)(64 * kb) * FE + 64 * nb; it.ld = FE;
        const int f0 = 64 * nb, rowb = e * 1024 + (f0 >> 7) * 256 + up * 128 + (f0 & 127);
        it.dst = p.ws + WS_WGU + (size_t)rowb * D + 64 * kb; it.kd = D; it.sc = 32.f; it.k0 = 64 * kb; return it; } r -= 2 * I_G;
    { const int e = r >> 8, qq = r & 255, kb = qq >> 5, nb = qq & 31;
      it.src = p.w_down + (size_t)e * FE * D + (size_t)(64 * kb) * D + 64 * nb; it.ld = D; it.dst = p.ws + WS_WD + ((size_t)e * 2048 + 64 * nb) * FE + 64 * kb; it.kd = FE; it.sc = 16.f; it.k0 = -1; return it; }
}
__device__ __forceinline__ void cv_load(const CvItem& it, int lane, float (&v)[64]) {
    const GAS float* s = (const GAS float*)it.src + lane;
#pragma unroll
    for (int i = 0; i < 64; ++i) v[i] = __builtin_nontemporal_load(s + (size_t)i * it.ld);
}
__device__ __forceinline__ void cv_finish(const Params& p, const CvItem& it, int lane, const float (&v)[64], LAS unsigned char* scr) {
    if (it.sc == 0.f) {
        LAS v4u* w = (LAS v4u*)(scr + lane * 144);
#pragma unroll
        for (int g = 0; g < 8; ++g) { v4u o; o.x = cvtpk_rne(v[8 * g], v[8 * g + 1]); o.y = cvtpk_rne(v[8 * g + 2], v[8 * g + 3]); o.z = cvtpk_rne(v[8 * g + 4], v[8 * g + 5]); o.w = cvtpk_rne(v[8 * g + 6], v[8 * g + 7]); w[g] = o; }
        LDS_WAIT(); asm volatile("" ::: "memory");
        const int c = lane & 7;
#pragma unroll
        for (int j = 0; j < 8; ++j) { const int n = (lane >> 3) + 8 * j; const v4u o = *(const LAS v4u*)(scr + n * 144 + c * 16); __builtin_nontemporal_store(o, (GAS v4u*)(it.dst + (size_t)n * it.kd + 16 * c)); }
    } else {
        LAS v4u* w = (LAS v4u*)(scr + lane * 80); const float sc = it.sc; const bool hasg = it.k0 >= 0; const float* gk = p.ln_ffn_g + (hasg ? it.k0 : 0);
#pragma unroll
        for (int g = 0; g < 4; ++g) { v4u o; unsigned tt[4];
#pragma unroll
            for (int q = 0; q < 4; ++q) { const int i0 = 16 * g + 4 * q; int t_ = 0;
                const float g0 = hasg ? gk[i0] : 1.f, g1 = hasg ? gk[i0 + 1] : 1.f, g2 = hasg ? gk[i0 + 2] : 1.f, g3 = hasg ? gk[i0 + 3] : 1.f;
                t_ = __builtin_amdgcn_cvt_pk_fp8_f32(v[i0] * (sc * g0), v[i0 + 1] * (sc * g1), t_, false); t_ = __builtin_amdgcn_cvt_pk_fp8_f32(v[i0 + 2] * (sc * g2), v[i0 + 3] * (sc * g3), t_, true); tt[q] = (unsigned)t_; }
            o.x = tt[0]; o.y = tt[1]; o.z = tt[2]; o.w = tt[3]; w[g] = o; }
        LDS_WAIT(); asm volatile("" ::: "memory");
        const int c = lane & 3;
#pragma unroll
        for (int j = 0; j < 4; ++j) { const int n = (lane >> 2) + 16 * j; const v4u o = *(const LAS v4u*)(scr + n * 80 + c * 16); __builtin_nontemporal_store(o, (GAS v4u*)(it.dst + (size_t)n * it.kd + 16 * c)); }
    }
    LDS_WAIT(); asm volatile("" ::: "memory");
}
constexpr int CVB = 4;
__device__ __forceinline__ void cv_load2(const CvItem& ia, const CvItem& ib, int lane, float (&va)[64], float (&vb)[64]) {
    const GAS float* sa = (const GAS float*)ia.src + lane; const GAS float* sb = (const GAS float*)ib.src + lane;
#pragma unroll
    for (int i = 0; i < 64; ++i) { va[i] = __builtin_nontemporal_load(sa + (size_t)i * ia.ld); vb[i] = __builtin_nontemporal_load(sb + (size_t)i * ib.ld); }
}
__device__ __forceinline__ void convert_queue(const Params& p, int lane, LAS unsigned char* scr) {
    unsigned* q = (unsigned*)(p.ws + WS_CTL) + CW_Q;
    constexpr int NITEMS = 32 * 32 + 2 * NEXP * 32 * 8 + NEXP * 8 * 32, PERQ = NITEMS / 8;
    static_assert(NITEMS % 16 == 0, "whole pairs per queue");
    int xq = blockIdx.x & 7;
    for (int tries = 0; tries < 8;) {
        int r0 = 0; if (lane == 0) r0 = (int)__hip_atomic_fetch_add(q + 64 * xq, 2u, RLX_AGENT);
        r0 = __builtin_amdgcn_readfirstlane(r0);
        if (r0 >= PERQ) { xq = (xq + 1) & 7; ++tries; continue; }
        r0 += PERQ * xq;
        float va[64], vb[64];
        const CvItem ia = cv_decode(p, r0), ib = cv_decode(p, r0 + 1);
        cv_load2(ia, ib, lane, va, vb);
        cv_finish(p, ia, lane, va, scr);
        cv_finish(p, ib, lane, vb, scr);
    }
}
#define ATTN_IN_MEGA 1

constexpr int LDS_BYTES = 147456;
constexpr int LDSCTL_OFF = 146432;
constexpr int GEMM1_WGS = 224;
constexpr int CW_HC = 49152, CW_TMO = 2048;
constexpr int CW_BAR = 4096;

namespace mls {
typedef short bf16x8 __attribute__((ext_vector_type(8)));
typedef float f32x16 __attribute__((ext_vector_type(16)));
typedef float f32x2_t __attribute__((ext_vector_type(2))); typedef __bf16 bf16x2_t __attribute__((ext_vector_type(2)));
__device__ __forceinline__ unsigned cvtpk(float lo, float hi) { f32x2_t v = {lo, hi}; bf16x2_t b = __builtin_convertvector(v, bf16x2_t); return __builtin_bit_cast(unsigned, b); }
__device__ __forceinline__ int crow(int r, int hi) { return (r & 3) + 8 * (r >> 2) + 4 * hi; }
__device__ __forceinline__ bf16x8 pack8(float a0, float a1, float a2, float a3, float a4, float a5, float a6, float a7) {
    v4u w; w.x = cvtpk(a0, a1); w.y = cvtpk(a2, a3); w.z = cvtpk(a4, a5); w.w = cvtpk(a6, a7); return __builtin_bit_cast(bf16x8, w); }
#define MLS_MFMA(a, b, c) __builtin_amdgcn_mfma_f32_32x32x16_bf16((a), (b), (c), 0, 0, 0)
}
constexpr int MO_HT = 132;
constexpr int MO_UNIT_LDS = 64 * MO_HT * 4 + 4 * 1024;
__device__ __forceinline__ void ph_mlstm_out(const Params& p, LAS unsigned char* lds, int tid) {
    using namespace mls;
    const int lane = tid & 63, wid = __builtin_amdgcn_readfirstlane(tid >> 6), half = wid >> 2, lw = wid & 3, ltid = tid & 255, r32 = lane & 31, hi = lane >> 5, tb = lw & 1, dp = lw >> 1;
    LAS float* Ht = (LAS float*)(lds + half * MO_UNIT_LDS);
    LAS float* wsc = (LAS float*)(lds + half * MO_UNIT_LDS + 64 * MO_HT * 4) + lw * 256;
    const float* GATES = (const float*)(p.ws + WS_GATES); const bf16* VM = (const bf16*)(p.ws + WS_VM); const bf16* KC = (const bf16*)(p.ws + WS_KC); const bf16* QC = (const bf16*)(p.ws + WS_QC); const bf16* OM = (const bf16*)(p.ws + WS_OM);
    const float* BCUM = (const float*)(p.ws + WS_BCUM); const float* MPREV = (const float*)(p.ws + WS_MPREV);
    bf16* A2 = (bf16*)(p.ws + WS_A2);
    const float lam = expf(wave_sum(p.lam_q1[lane] * p.lam_k1[lane])) - expf(wave_sum(p.lam_q2[lane] * p.lam_k2[lane])) + 0.2f;
    for (int base = 0; base < 1024; base += 2 * gridDim.x) {
        const int bx = base + half * gridDim.x + blockIdx.x;
        const int bh = bx >> 6, c = bx & 63, b = bh >> 3, h = bh & 7, hc = h * 128; const size_t row0 = (size_t)b * SEQ + c * 64;
        const bf16* CPREV = (const bf16*)(p.ws + WS_CLOC) + (size_t)bx * 16384; const float* NPREV = (const float*)(p.ws + WS_NLOC) + (size_t)bx * 128;
        const float mprev = MPREV[bx];
        const int ctt = ltid >> 2, cdg = ltid & 3;
        v4u co1[4], co2[4];
        { const bf16* oa = (const bf16*)(p.ws + WS_OA) + (row0 + ctt) * 2048 + h * 256 + 32 * cdg;
#pragma unroll
          for (int q = 0; q < 4; ++q) { co1[q] = *(const v4u*)(oa + 8 * q); co2[q] = *(const v4u*)(oa + 128 + 8 * q); } }
        { const float bl = BCUM[(size_t)bx * 64 + lane], al = GATES[(row0 + lane) * 16 + h] + p.b_i[h] - bl;
          float pm = al;
#pragma unroll
          for (int off = 1; off < 64; off <<= 1) { const float o = __shfl_up(pm, off); if (lane >= off) pm = fmaxf(pm, o); }
          wsc[lane] = al; wsc[64 + lane] = fmaxf(pm, mprev); wsc[128 + lane] = bl; }
        const int t = 32 * tb + r32;
        bf16x8 qf[8];
        { const bf16* qp = QC + (row0 + t) * 1024 + hc + 8 * hi;
#pragma unroll
          for (int k = 0; k < 8; ++k) qf[k] = *(const bf16x8*)(qp + 16 * k); }
        f32x16 X[2];
#pragma unroll
        for (int sb = 0; sb < 2; ++sb) {
#pragma unroll
            for (int i = 0; i < 16; ++i) X[sb][i] = 0.f;
            if (sb <= tb) { const bf16* kp = KC + (row0 + 32 * sb + r32) * 1024 + hc + 8 * hi;
                bf16x8 kf[8];
#pragma unroll
                for (int k = 0; k < 8; ++k) kf[k] = *(const bf16x8*)(kp + 16 * k);
#pragma unroll
                for (int k = 0; k < 8; ++k) X[sb] = MLS_MFMA(kf[k], qf[k], X[sb]); } }
        v4u vfr[2][2][2];
#pragma unroll
        for (int sb = 0; sb < 2; ++sb) if (sb <= tb) {
#pragma unroll
            for (int st = 0; st < 2; ++st)
#pragma unroll
                for (int dj = 0; dj < 2; ++dj) { const bf16* vp = VM + (row0 + 32 * sb + 16 * st + 4 * hi) * 1024 + hc + 64 * dp + 32 * dj + r32;
                    unsigned short v[8];
#pragma unroll
                    for (int j = 0; j < 8; ++j) v[j] = vp[(size_t)(8 * (j >> 2) + (j & 3)) * 1024];
                    vfr[sb][st][dj] = (v4u){v[0] | ((unsigned)v[1] << 16), v[2] | ((unsigned)v[3] << 16), v[4] | ((unsigned)v[5] << 16), v[6] | ((unsigned)v[7] << 16)}; } }
        else { vfr[sb][0][0] = vfr[sb][0][1] = vfr[sb][1][0] = vfr[sb][1][1] = (v4u){0u, 0u, 0u, 0u}; }
        f32x16 acc[2];
#pragma unroll
        for (int dj = 0; dj < 2; ++dj) {
#pragma unroll
            for (int i = 0; i < 16; ++i) acc[dj][i] = 0.f;
            const bf16* cp = CPREV + (64 * dp + 32 * dj + r32) * 128 + 8 * hi;
#pragma unroll
            for (int k = 0; k < 8; ++k) acc[dj] = MLS_MFMA(qf[k], *(const bf16x8*)(cp + 16 * k), acc[dj]); }
        float qn = 0.f;
        { const float* np = NPREV + 8 * hi;
#pragma unroll
          for (int k = 0; k < 8; ++k) { const f32x4 n0 = *(const f32x4*)(np + 16 * k), n1 = *(const f32x4*)(np + 16 * k + 4);
              qn += bf2f((unsigned short)qf[k][0]) * n0.x + bf2f((unsigned short)qf[k][1]) * n0.y + bf2f((unsigned short)qf[k][2]) * n0.z + bf2f((unsigned short)qf[k][3]) * n0.w
                  + bf2f((unsigned short)qf[k][4]) * n1.x + bf2f((unsigned short)qf[k][5]) * n1.y + bf2f((unsigned short)qf[k][6]) * n1.z + bf2f((unsigned short)qf[k][7]) * n1.w; } }
        qn += __shfl_xor(qn, 32);
        LDS_WAIT(); asm volatile("" ::: "memory");
        const float Mt = wsc[64 + t], bt = wsc[128 + t];
        float den1 = 0.f;
#pragma unroll
        for (int sb = 0; sb < 2; ++sb)
#pragma unroll
            for (int i = 0; i < 16; ++i) { const int s = 32 * sb + crow(i, hi); const float w = (s <= t) ? __expf(wsc[s] - Mt) : 0.f; X[sb][i] *= w; den1 += X[sb][i]; }
        den1 += __shfl_xor(den1, 32);
        const float inter_t = __expf(mprev - Mt);
        const float rd = 1.f / fmaxf(fabsf(den1 + inter_t * qn), __expf(-(bt + Mt)));
        if (hi == 0) wsc[192 + t] = rd;
#pragma unroll
        for (int i = 0; i < 16; ++i) { const float it_ = __expf(mprev - wsc[64 + 32 * tb + crow(i, hi)]); acc[0][i] *= it_; acc[1][i] *= it_; }
#pragma unroll
        for (int sb = 0; sb < 2; ++sb) if (sb <= tb) {
#pragma unroll
            for (int st = 0; st < 2; ++st) {
                const bf16x8 xa = pack8(X[sb][8 * st], X[sb][8 * st + 1], X[sb][8 * st + 2], X[sb][8 * st + 3], X[sb][8 * st + 4], X[sb][8 * st + 5], X[sb][8 * st + 6], X[sb][8 * st + 7]);
#pragma unroll
                for (int dj = 0; dj < 2; ++dj) acc[dj] = MLS_MFMA(xa, __builtin_bit_cast(bf16x8, vfr[sb][st][dj]), acc[dj]); } }
        LDS_WAIT(); asm volatile("" ::: "memory");
#pragma unroll
        for (int dj = 0; dj < 2; ++dj)
#pragma unroll
            for (int i = 0; i < 16; ++i) { const int tr = 32 * tb + crow(i, hi); Ht[tr * MO_HT + 64 * dp + 32 * dj + r32] = acc[dj][i] * wsc[192 + tr]; }
        __syncthreads();
        { const int tt = ltid >> 2, dg = ltid & 3; const LAS float* hp = Ht + tt * MO_HT + 32 * dg;
          f32x4 hv[8]; float ss = 0.f;
#pragma unroll
          for (int j = 0; j < 8; ++j) { hv[j] = *(const LAS f32x4*)(hp + 4 * j); ss += (hv[j].x * hv[j].x + hv[j].y * hv[j].y) + (hv[j].z * hv[j].z + hv[j].w * hv[j].w); }
          ss += __shfl_xor(ss, 1); ss += __shfl_xor(ss, 2);
          const float rstd = rsqrtf(ss * (1.f / 128.f) + EPS);
          const float* gp = p.mlstm_norm_g + hc + 32 * dg; const bf16* op_ = OM + (row0 + tt) * 1024 + hc + 32 * dg; bf16* dst = A2 + (row0 + tt) * 2048 + 1024 + hc + 32 * dg;
#pragma unroll
          for (int q = 0; q < 4; ++q) { const v4u o = *(const v4u*)(op_ + 8 * q); const f32x4 g0 = *(const f32x4*)(gp + 8 * q), g1 = *(const f32x4*)(gp + 8 * q + 4); const f32x4 a = hv[2 * q], bq = hv[2 * q + 1];
              const unsigned ow[4] = {o.x, o.y, o.z, o.w}; const float y[8] = {a.x * rstd * g0.x, a.y * rstd * g0.y, a.z * rstd * g0.z, a.w * rstd * g0.w, bq.x * rstd * g1.x, bq.y * rstd * g1.y, bq.z * rstd * g1.z, bq.w * rstd * g1.w};
              unsigned res[4];
#pragma unroll
              for (int j = 0; j < 4; ++j) { const float s0 = __uint_as_float(ow[j] << 16), s1 = __uint_as_float(ow[j] & 0xffff0000u); res[j] = pk2(y[2 * j] / (1.f + __expf(-s0)), y[2 * j + 1] / (1.f + __expf(-s1))); }
              *(v4u*)(dst + 8 * q) = (v4u){res[0], res[1], res[2], res[3]}; }
          float cv[32]; float css = 0.f;
#pragma unroll
          for (int q = 0; q < 4; ++q) { const unsigned w1[4] = {co1[q].x, co1[q].y, co1[q].z, co1[q].w}, w2[4] = {co2[q].x, co2[q].y, co2[q].z, co2[q].w};
#pragma unroll
              for (int j = 0; j < 4; ++j) { const float a0 = __uint_as_float(w1[j] << 16) - lam * __uint_as_float(w2[j] << 16), a1 = __uint_as_float(w1[j] & 0xffff0000u) - lam * __uint_as_float(w2[j] & 0xffff0000u);
                  cv[8 * q + 2 * j] = a0; cv[8 * q + 2 * j + 1] = a1; css += a0 * a0 + a1 * a1; } }
          css += __shfl_xor(css, 1); css += __shfl_xor(css, 2);
          const float crs = rsqrtf(css * (1.f / 128.f) + EPS) * 0.8f; const float* cg = p.diff_norm_g + hc + 32 * dg; bf16* cdst = A2 + (row0 + tt) * 2048 + hc + 32 * dg;
#pragma unroll
          for (int q = 0; q < 4; ++q) { const f32x4 g0 = *(const f32x4*)(cg + 8 * q), g1 = *(const f32x4*)(cg + 8 * q + 4);
              *(v4u*)(cdst + 8 * q) = (v4u){pk2(cv[8 * q] * crs * g0.x, cv[8 * q + 1] * crs * g0.y), pk2(cv[8 * q + 2] * crs * g0.z, cv[8 * q + 3] * crs * g0.w), pk2(cv[8 * q + 4] * crs * g1.x, cv[8 * q + 5] * crs * g1.y), pk2(cv[8 * q + 6] * crs * g1.z, cv[8 * q + 7] * crs * g1.w)}; } }
        __syncthreads();
    }
}
constexpr int ML_S = 144;
constexpr int ML_CS = 272;
__device__ __forceinline__ void ml_conv8r(const Params& p, const v4u (&rw)[4], int cwoff, float (&a)[8]) {
#pragma unroll
    for (int i = 0; i < 8; ++i) a[i] = p.conv_b[cwoff + i];
#pragma unroll
    for (int j = 0; j < 4; ++j) { const v4u w = rw[j]; const float* cw = p.conv_w + j * 2048 + cwoff;
        a[0] += cw[0] * __uint_as_float(w.x << 16); a[1] += cw[1] * __uint_as_float(w.x & 0xffff0000u); a[2] += cw[2] * __uint_as_float(w.y << 16); a[3] += cw[3] * __uint_as_float(w.y & 0xffff0000u);
        a[4] += cw[4] * __uint_as_float(w.z << 16); a[5] += cw[5] * __uint_as_float(w.z & 0xffff0000u); a[6] += cw[6] * __uint_as_float(w.w << 16); a[7] += cw[7] * __uint_as_float(w.w & 0xffff0000u); }
#pragma unroll
    for (int i = 0; i < 8; ++i) a[i] = a[i] / (1.f + __expf(-a[i]));
}
__device__ __forceinline__ int ml_sw(int r, int lg) { return r * ML_S + 16 * (lg ^ ((r >> 3) & 7)); }
struct MlRaw { v4u q[2][4], k[2][4], v[2]; float gf, gi; };
__device__ __forceinline__ void ml_load(const Params& p, int bx, int tid, MlRaw& R) {
    const int lane = tid & 63, eg = tid & 15, bh = bx >> 6, c = bx & 63, b = bh >> 3, h = bh & 7, ch = h * 128 + 8 * eg; const size_t row0 = (size_t)b * SEQ + c * 64;
    const float* GATES = (const float*)(p.ws + WS_GATES); const bf16* VM = (const bf16*)(p.ws + WS_VM); const bf16* KM = (const bf16*)(p.ws + WS_KM); const bf16* QM = (const bf16*)(p.ws + WS_QM);
    R.gf = GATES[(row0 + lane) * 16 + 8 + h]; R.gi = GATES[(row0 + lane) * 16 + h];
#pragma unroll
    for (int j = 0; j < 2; ++j) { const int l = (tid >> 4) + 32 * j, ts = c * 64 + l; const size_t row = row0 + l;
#pragma unroll
        for (int i = 0; i < 4; ++i) { const bool ok = ts - 3 + i >= 0; const v4u z = {0u, 0u, 0u, 0u};
            R.q[j][i] = ok ? *(const v4u*)(QM + (row - 3 + i) * 1024 + ch) : z; R.k[j][i] = ok ? *(const v4u*)(KM + (row - 3 + i) * 1024 + ch) : z; }
        R.v[j] = *(const v4u*)(VM + row * 1024 + ch); }
}
__device__ __forceinline__ void ph_mlstm_local(const Params& p, LAS unsigned char* lds, int tid) {
    using namespace mls;
    const int lane = tid & 63, wid = __builtin_amdgcn_readfirstlane(tid >> 6), r32 = lane & 31, hi = lane >> 5, we = wid & 3, wd = wid >> 2;
    LAS unsigned char* KwT = lds; LAS unsigned char* VT = lds + 128 * ML_S; LAS unsigned char* Ct = lds + 2 * 128 * ML_S;
    bf16* KC = (bf16*)(p.ws + WS_KC); bf16* QC = (bf16*)(p.ws + WS_QC);
    float* BCUM = (float*)(p.ws + WS_BCUM); float* Gc = (float*)(p.ws + WS_G); float* MLOC = (float*)(p.ws + WS_MLOC); bf16* CLOC = (bf16*)(p.ws + WS_CLOC); float* NLOC = (float*)(p.ws + WS_NLOC);
    const int eg = tid & 15;
    MlRaw R; if ((int)blockIdx.x < 1024) ml_load(p, blockIdx.x, tid, R);
    for (int bx = blockIdx.x; bx < 1024; bx += gridDim.x) {
        const int bh = bx >> 6, c = bx & 63, b = bh >> 3, h = bh & 7, hc = h * 128, ch = hc + 8 * eg; const size_t row0 = (size_t)b * SEQ + c * 64;
        float wt;
        { const float f = R.gf + p.b_f[h]; float bc = fminf(f, 0.f) - log1pf(__expf(-fabsf(f)));
#pragma unroll
          for (int off = 1; off < 64; off <<= 1) { const float o = __shfl_up(bc, off); if (lane >= off) bc += o; }
          const float g = __shfl(bc, 63), w = g - bc + R.gi + p.b_i[h]; const float mx = wave_max(w); wt = __expf(w - mx);
          if (wid == 0) { BCUM[(size_t)bx * 64 + lane] = bc; if (lane == 0) { Gc[bx] = g; MLOC[bx] = mx; } } }
#pragma unroll
        for (int j = 0; j < 2; ++j) { const int l = (tid >> 4) + 32 * j; const size_t row = row0 + l; const float wl = __shfl(wt, l);
            float a[8];
            ml_conv8r(p, R.q[j], ch, a);
            { v4u o; o.x = cvtpk(a[0], a[1]); o.y = cvtpk(a[2], a[3]); o.z = cvtpk(a[4], a[5]); o.w = cvtpk(a[6], a[7]); *(v4u*)(QC + row * 1024 + ch) = o; }
            ml_conv8r(p, R.k[j], 1024 + ch, a);
#pragma unroll
            for (int i = 0; i < 8; ++i) a[i] *= 0.08838834764831845f;
            { v4u o; o.x = cvtpk(a[0], a[1]); o.y = cvtpk(a[2], a[3]); o.z = cvtpk(a[4], a[5]); o.w = cvtpk(a[6], a[7]); *(v4u*)(KC + row * 1024 + ch) = o;
              const unsigned kk[4] = {o.x, o.y, o.z, o.w};
#pragma unroll
              for (int i = 0; i < 8; ++i) { const float kv = (i & 1) ? __uint_as_float(kk[i >> 1] & 0xffff0000u) : __uint_as_float(kk[i >> 1] << 16);
                  *(LAS unsigned short*)(KwT + ml_sw(8 * eg + i, l >> 3) + 2 * (l & 7)) = (unsigned short)(cvtpk(kv * wl, 0.f) & 0xffffu); } }
            { const v4u w = R.v[j]; const unsigned vv[4] = {w.x, w.y, w.z, w.w};
#pragma unroll
              for (int i = 0; i < 8; ++i) *(LAS unsigned short*)(VT + ml_sw(8 * eg + i, l >> 3) + 2 * (l & 7)) = (unsigned short)((i & 1) ? (vv[i >> 1] >> 16) : (vv[i >> 1] & 0xffffu)); }
        }
        __syncthreads();
        if (bx + (int)gridDim.x < 1024) ml_load(p, bx + gridDim.x, tid, R);
        f32x16 acc[2];
#pragma unroll
        for (int j = 0; j < 2; ++j)
#pragma unroll
            for (int i = 0; i < 16; ++i) acc[j][i] = 0.f;
#pragma unroll
        for (int ks = 0; ks < 4; ++ks) { const bf16x8 af = *(const LAS bf16x8*)(KwT + ml_sw(32 * we + r32, 2 * ks + hi));
#pragma unroll
            for (int j = 0; j < 2; ++j) { const bf16x8 bfr = *(const LAS bf16x8*)(VT + ml_sw(64 * wd + 32 * j + r32, 2 * ks + hi)); acc[j] = MLS_MFMA(af, bfr, acc[j]); } }
        if (tid < 128) { float n = 0.f;
#pragma unroll
            for (int q = 0; q < 8; ++q) { const v4u w = *(const LAS v4u*)(KwT + tid * ML_S + 16 * q);
                n += __uint_as_float(w.x << 16) + __uint_as_float(w.x & 0xffff0000u) + __uint_as_float(w.y << 16) + __uint_as_float(w.y & 0xffff0000u) + __uint_as_float(w.z << 16) + __uint_as_float(w.z & 0xffff0000u) + __uint_as_float(w.w << 16) + __uint_as_float(w.w & 0xffff0000u); }
            NLOC[(size_t)bx * 128 + tid] = n; }
#pragma unroll
        for (int j = 0; j < 2; ++j)
#pragma unroll
            for (int g = 0; g < 4; ++g) { const int d = 64 * wd + 32 * j + r32, e = 32 * we + 8 * g + 4 * hi;
                *(LAS unsigned long long*)(Ct + d * ML_CS + e * 2) = (unsigned long long)cvtpk(acc[j][4 * g], acc[j][4 * g + 1]) | ((unsigned long long)cvtpk(acc[j][4 * g + 2], acc[j][4 * g + 3]) << 32); }
        __syncthreads();
        { bf16* co = CLOC + (size_t)bx * 16384;
#pragma unroll
          for (int q = 0; q < 4; ++q) { const int pi = tid + 512 * q, d = pi >> 4, ck = pi & 15; *(v4u*)(co + d * 128 + 8 * ck) = *(const LAS v4u*)(Ct + d * ML_CS + 16 * ck); } }
        __syncthreads();
    }
}
__device__ __forceinline__ void ph_mlstm_scan(const Params& p, LAS unsigned char* lds, int tid) {
    LAS float* dec = (LAS float*)lds; LAS float* scl = dec + 64;
    const float* Gc = (const float*)(p.ws + WS_G); const float* MLOC = (const float*)(p.ws + WS_MLOC); float* MPREV = (float*)(p.ws + WS_MPREV);
    for (int blk = blockIdx.x; blk < 256; blk += gridDim.x) {
        const int bh = blk >> 4;
        __syncthreads();
        if (tid < 64) { const float gv = Gc[bh * 64 + tid], mlv = MLOC[bh * 64 + tid]; float m = 0.f, myd = 0.f, mys = 0.f, mym = 0.f;
#pragma unroll
            for (int c = 0; c < 64; ++c) { const float g = __shfl(gv, c), ml = __shfl(mlv, c); const float mn = fmaxf(g + m, ml);
                if (tid == c) { mym = m; myd = __expf(g + m - mn); mys = __expf(ml - mn); } m = mn; }
            dec[tid] = myd; scl[tid] = mys; if ((blk & 15) == 0) MPREV[bh * 64 + tid] = mym; }
        __syncthreads();
        { unsigned* base = (unsigned*)((bf16*)(p.ws + WS_CLOC) + (size_t)bh * 64 * 16384) + (blk & 15) * 512 + tid;
          float v0 = 0.f, v1 = 0.f;
#pragma unroll 1
          for (int c0 = 0; c0 < 64; c0 += 32) { unsigned w[32];
#pragma unroll
              for (int i = 0; i < 32; ++i) w[i] = base[(size_t)(c0 + i) * 8192];
#pragma unroll
              for (int i = 0; i < 32; ++i) { base[(size_t)(c0 + i) * 8192] = cvtpk_rne(v0, v1); const float d = dec[c0 + i], s = scl[c0 + i];
                  v0 = d * v0 + s * __uint_as_float(w[i] << 16); v1 = d * v1 + s * __uint_as_float(w[i] & 0xffff0000u); } } }
        if ((blk & 15) == 0 && tid < 128) { float* nb = (float*)(p.ws + WS_NLOC) + (size_t)bh * 64 * 128 + tid; float v = 0.f;
#pragma unroll 1
            for (int c0 = 0; c0 < 64; c0 += 16) { float w[16];
#pragma unroll
                for (int i = 0; i < 16; ++i) w[i] = nb[(c0 + i) * 128];
#pragma unroll
                for (int i = 0; i < 16; ++i) { nb[(c0 + i) * 128] = v; v = dec[c0 + i] * v + scl[c0 + i] * w[i]; } } }
    }
}
__device__ __forceinline__ void ph_diff_combine(const Params& p, int tid) {
    const int lane = tid & 63;
    const float lam = expf(wave_sum(p.lam_q1[lane] * p.lam_k1[lane])) - expf(wave_sum(p.lam_q2[lane] * p.lam_k2[lane])) + 0.2f;
    const bf16* OA = (const bf16*)(p.ws + WS_OA); bf16* A2 = (bf16*)(p.ws + WS_A2);
    for (int gw = blockIdx.x * 8 + (tid >> 6); gw < T * NH; gw += gridDim.x * 8) { const int row = gw >> 3, h = gw & 7;
        const unsigned w1 = *(const unsigned*)(OA + (size_t)row * 2048 + h * 256 + 2 * lane), w2 = *(const unsigned*)(OA + (size_t)row * 2048 + h * 256 + 128 + 2 * lane);
        const float v0 = __uint_as_float(w1 << 16) - lam * __uint_as_float(w2 << 16), v1 = __uint_as_float(w1 & 0xffff0000u) - lam * __uint_as_float(w2 & 0xffff0000u);
        const float rstd = rsqrtf(wave_sum(v0 * v0 + v1 * v1) * (1.f / 128.f) + EPS);
        *(unsigned*)(A2 + (size_t)row * 2048 + h * 128 + 2 * lane) = pk2(v0 * rstd * p.diff_norm_g[h * 128 + 2 * lane] * 0.8f, v1 * rstd * p.diff_norm_g[h * 128 + 2 * lane + 1] * 0.8f); }
}
constexpr size_t WS_WR = WS_MISC + MiB + 65536;
__device__ __forceinline__ void router_weights(const Params& p, int gtid, int nthreads) {
    bf16* WR = (bf16*)(p.ws + WS_WR);
    for (int idx = gtid; idx < 48 * 2048; idx += nthreads) { const int n = idx >> 11, k = idx & 2047;
        float v = 0.f; if (n < 4) v = p.w_group[k * 4 + n]; else if (n < 36) v = p.w_router[((size_t)((n - 4) >> 3) * D + k) * 8 + ((n - 4) & 7)];
        v *= p.ln_ffn_g[k]; const unsigned hi = f2bf(v); const float r = v - __uint_as_float(hi << 16);
        WR[idx] = (bf16)hi; WR[48 * 2048 + idx] = (bf16)f2bf(r); }
}
typedef float f32x4r __attribute__((ext_vector_type(4)));
__device__ __forceinline__ void ph_router(const Params& p, LAS unsigned char* lds, int tid) {
    using namespace mls;
    const int lane = tid & 63, wid = __builtin_amdgcn_readfirstlane(tid >> 6), fr = lane & 15, fq = lane >> 4;
    LAS float* part = (LAS float*)lds;
    LAS float* ssq = part + 8 * 32 * 48;
    LAS float* lg = ssq + 8 * 32;
    LAS float* rs = lg + 32 * 48;
    const bf16* X1 = (const bf16*)(p.ws + WS_X1); const bf16* WR = (const bf16*)(p.ws + WS_WR);
    for (int rb = blockIdx.x; rb < T / 32; rb += gridDim.x) {
        const int row0 = rb * 32, k0 = 256 * wid;
        f32x4r acc[2][3];
#pragma unroll
        for (int rg = 0; rg < 2; ++rg)
#pragma unroll
            for (int nt = 0; nt < 3; ++nt) acc[rg][nt] = (f32x4r){0.f, 0.f, 0.f, 0.f};
        float sq[2] = {0.f, 0.f}; bf16x8 xv[2][8];
#pragma unroll
        for (int rg = 0; rg < 2; ++rg) { const bf16* xp = X1 + (size_t)(row0 + 16 * rg + fr) * D + k0 + 8 * fq;
#pragma unroll
            for (int ks = 0; ks < 8; ++ks) xv[rg][ks] = *(const bf16x8*)(xp + 32 * ks); }
#pragma unroll
        for (int ks = 0; ks < 8; ++ks) {
            bf16x8 bh[3];
#pragma unroll
            for (int nt = 0; nt < 3; ++nt) bh[nt] = *(const bf16x8*)(WR + (size_t)(16 * nt + fr) * D + k0 + 32 * ks + 8 * fq);
#pragma unroll
            for (int rg = 0; rg < 2; ++rg) {
#pragma unroll
                for (int j = 0; j < 8; ++j) { const float xf = bf2f((unsigned short)xv[rg][ks][j]); sq[rg] += xf * xf; }
#pragma unroll
                for (int nt = 0; nt < 3; ++nt) acc[rg][nt] = __builtin_amdgcn_mfma_f32_16x16x32_bf16(xv[rg][ks], bh[nt], acc[rg][nt], 0, 0, 0); }
            if (ks & 1) asm volatile("" ::: "memory"); }
#pragma unroll
        for (int rg = 0; rg < 2; ++rg) { float s = sq[rg]; s += __shfl_xor(s, 16); s += __shfl_xor(s, 32); if (fq == 0) ssq[wid * 32 + 16 * rg + fr] = s;
#pragma unroll
            for (int nt = 0; nt < 3; ++nt)
#pragma unroll
                for (int i = 0; i < 4; ++i) part[(wid * 32 + 16 * rg + 4 * fq + i) * 48 + 16 * nt + fr] = acc[rg][nt][i]; }
        __syncthreads();
        if (tid < 32) { float s = 0.f;
#pragma unroll
            for (int w = 0; w < 8; ++w) s += ssq[w * 32 + tid];
            rs[tid] = rsqrtf(s * (1.f / D) + EPS); }
#pragma unroll
        for (int q = 0; q < 3; ++q) { const int o = tid + 512 * q; float s = 0.f;
#pragma unroll
            for (int w = 0; w < 8; ++w) s += part[w * 1536 + o];
            lg[o] = s; }
        __syncthreads();
#pragma unroll
        for (int rg = 0; rg < 2; ++rg) { const int r = 16 * rg + fr; const float rstd = rs[r]; unsigned char* hp = (unsigned char*)(p.ws + WS_H2) + (size_t)(row0 + r) * D + k0 + 8 * fq;
#pragma unroll
            for (int ks = 0; ks < 8; ++ks) { const v4u xw = __builtin_bit_cast(v4u, xv[rg][ks]);
                typedef unsigned u32x2r __attribute__((ext_vector_type(2)));
                *(u32x2r*)(hp + 32 * ks) = (u32x2r){pg8::pk4_fp8(__uint_as_float(xw.x << 16) * rstd, __uint_as_float(xw.x & 0xffff0000u) * rstd, __uint_as_float(xw.y << 16) * rstd, __uint_as_float(xw.y & 0xffff0000u) * rstd),
                                                   pg8::pk4_fp8(__uint_as_float(xw.z << 16) * rstd, __uint_as_float(xw.z & 0xffff0000u) * rstd, __uint_as_float(xw.w << 16) * rstd, __uint_as_float(xw.w & 0xffff0000u) * rstd)}; } }
        LAS int* se = (LAS int*)(rs + 32);
        LAS int* sbase = se + 64;
        if (tid < 32) { const int row = row0 + tid; const float rstd = rs[tid]; const LAS float* l = lg + tid * 48;
            float ag[4];
#pragma unroll
            for (int g = 0; g < 4; ++g) ag[g] = l[g] * rstd + p.b_group[g];
            int gs = 0; float gm = ag[0];
#pragma unroll
            for (int g = 1; g < 4; ++g) if (ag[g] > gm) { gm = ag[g]; gs = g; }
            float se_ = 0.f;
#pragma unroll
            for (int g = 0; g < 4; ++g) se_ += expf(ag[g] - gm);
            const float gw = 1.f / se_;
            float el[8];
#pragma unroll
            for (int e = 0; e < 8; ++e) el[e] = l[4 + gs * 8 + e] * rstd + p.b_router[gs * 8 + e];
            int i0 = 0; float v0 = el[0];
#pragma unroll
            for (int e = 1; e < 8; ++e) if (el[e] > v0) { v0 = el[e]; i0 = e; }
            int i1 = -1; float v1 = -INFINITY;
#pragma unroll
            for (int e = 0; e < 8; ++e) if (e != i0 && el[e] > v1) { v1 = el[e]; i1 = e; }
            const float w0 = 1.f / (1.f + expf(v1 - v0)), w1 = 1.f - w0;
            float* LISTW = (float*)(p.ws + WS_LISTW); LISTW[row * 2] = gw * w0; LISTW[row * 2 + 1] = gw * w1;
            se[2 * tid] = gs * 8 + i0; se[2 * tid + 1] = gs * 8 + i1;
            LDS_WAIT(); asm volatile("" ::: "memory");
            const int me = tid; int n = 0;
#pragma unroll 8
            for (int q = 0; q < 64; ++q) n += (se[q] == me) ? 1 : 0;
            unsigned base = 0; unsigned* cnt = (unsigned*)(p.ws + WS_CTL) + CW_CNT;
            if (n > 0) base = atomicAdd(cnt + me, (unsigned)n);
            int* LIST = (int*)(p.ws + WS_LIST); int* TOKEP = (int*)(p.ws + WS_ROWTOK);
            if (n > 0) { int k = 0;
#pragma unroll 8
                for (int q = 0; q < 64; ++q) if (se[q] == me) { const int ts = (row0 + (q >> 1)) * 2 + (q & 1); LIST[me * 8192 + (int)base + k] = ts; TOKEP[ts] = me * 8192 + (int)base + k; ++k; } }
            (void)sbase; }
        __syncthreads();
    }
}
__device__ __forceinline__ void ph_final(const Params& p, const LAS int* s_tb, int tid) {
    const int lane = tid & 63;
    for (int row = blockIdx.x * 8 + (tid >> 6); row < T; row += gridDim.x * 8) {
        const GAS unsigned long long* xr = (const GAS unsigned long long*)((const bf16*)(p.ws + WS_X1) + (size_t)row * D) + lane; const GAS f32x4* gr = (const GAS f32x4*)p.ln_f_g + lane;
        const int* TOKEP = (const int*)(p.ws + WS_ROWTOK); const int v0 = TOKEP[row * 2], v1 = TOKEP[row * 2 + 1];
        const float* TOKW = (const float*)(p.ws + WS_LISTW); const float cw0 = TOKW[row * 2] * (1.f / (pg8::H8 * pg8::W8_D)), cw1 = TOKW[row * 2 + 1] * (1.f / (pg8::H8 * pg8::W8_D));
        const size_t r0 = (size_t)s_tb[v0 >> 13] * 256 + (v0 & 8191), r1 = (size_t)s_tb[v1 >> 13] * 256 + (v1 & 8191);
        const GAS unsigned long long* y0 = (const GAS unsigned long long*)((const bf16*)(p.ws + WS_HS) + r0 * D) + lane; const GAS unsigned long long* y1 = (const GAS unsigned long long*)((const bf16*)(p.ws + WS_HS) + r1 * D) + lane;
        f32x4 v[8]; float s = 0.f;
#pragma unroll
        for (int j = 0; j < 8; ++j) { const unsigned long long xw = xr[64 * j]; v[j] = (f32x4){__uint_as_float((unsigned)xw << 16), __uint_as_float((unsigned)xw & 0xffff0000u), __uint_as_float((unsigned)(xw >> 32) << 16), __uint_as_float((unsigned)(xw >> 32) & 0xffff0000u)};
            const unsigned long long a = y0[64 * j], b = y1[64 * j];
            v[j].x += __uint_as_float((unsigned)a << 16) * cw0 + __uint_as_float((unsigned)b << 16) * cw1; v[j].y += __uint_as_float((unsigned)a & 0xffff0000u) * cw0 + __uint_as_float((unsigned)b & 0xffff0000u) * cw1;
            v[j].z += __uint_as_float((unsigned)(a >> 32) << 16) * cw0 + __uint_as_float((unsigned)(b >> 32) << 16) * cw1; v[j].w += __uint_as_float((unsigned)(a >> 32) & 0xffff0000u) * cw0 + __uint_as_float((unsigned)(b >> 32) & 0xffff0000u) * cw1;
            s += (v[j].x * v[j].x + v[j].y * v[j].y) + (v[j].z * v[j].z + v[j].w * v[j].w); }
        const float rstd = rsqrtf(wave_sum(s) * (1.f / D) + EPS);
        GAS f32x4* o = (GAS f32x4*)(p.out + (size_t)row * D) + lane;
#pragma unroll
        for (int j = 0; j < 8; ++j) { const f32x4 gv = gr[64 * j]; o[64 * j] = (f32x4){v[j].x * rstd * gv.x, v[j].y * rstd * gv.y, v[j].z * rstd * gv.z, v[j].w * rstd * gv.w}; }
    }
}

__device__ __forceinline__ void gate_gemm(const Params& p, int slab, int tid) {
    using namespace mls;
    const int lane = tid & 63, wid = tid >> 6, fr = lane & 15, fq = lane >> 4;
    const bf16* XN = (const bf16*)(p.ws + WS_XNP); const bf16* Wg = (const bf16*)(p.ws + WS_WIN) + (size_t)7168 * LDP; float* GATES = (float*)(p.ws + WS_GATES);
    const int row0 = slab * 256 + wid * 32;
    typedef float f32x4g __attribute__((ext_vector_type(4)));
    f32x4g acc[2] = {(f32x4g){0.f, 0.f, 0.f, 0.f}, (f32x4g){0.f, 0.f, 0.f, 0.f}};
    const bf16* a0 = XN + (size_t)(row0 + fr) * LDP + 8 * fq; const bf16* a1 = a0 + (size_t)16 * LDP; const bf16* bp = Wg + (size_t)fr * LDP + 8 * fq;
#pragma unroll 1
    for (int k0 = 0; k0 < D; k0 += 256) {
        bf16x8 af[2][8], bfv[8];
#pragma unroll
        for (int j = 0; j < 8; ++j) { af[0][j] = *(const bf16x8*)(a0 + k0 + 32 * j); af[1][j] = *(const bf16x8*)(a1 + k0 + 32 * j); bfv[j] = *(const bf16x8*)(bp + k0 + 32 * j); }
#pragma unroll
        for (int j = 0; j < 8; ++j) { acc[0] = __builtin_amdgcn_mfma_f32_16x16x32_bf16(af[0][j], bfv[j], acc[0], 0, 0, 0); acc[1] = __builtin_amdgcn_mfma_f32_16x16x32_bf16(af[1][j], bfv[j], acc[1], 0, 0, 0); }
    }
#pragma unroll
    for (int rg = 0; rg < 2; ++rg)
#pragma unroll
        for (int i = 0; i < 4; ++i) GATES[(size_t)(row0 + 16 * rg + 4 * fq + i) * 16 + fr] = acc[rg][i];
}
__device__ __forceinline__ int k_lane() { int l; asm volatile("v_mbcnt_lo_u32_b32 %0, -1, 0\n\tv_mbcnt_hi_u32_b32 %0, -1, %0" : "=v"(l)); return l; }
__global__ void __launch_bounds__(512, 2) mega_fwd(Params p) {
    extern __shared__ __attribute__((aligned(16))) unsigned char lds[];
    const int wave = __builtin_amdgcn_readfirstlane((int)threadIdx.x >> 6);
#define lane k_lane()
#define tid (wave * 64 + lane)
    LAS unsigned char* l3 = (LAS unsigned char*)lds;
    for (int u = tid; u < (LDS_BYTES - LDSCTL_OFF) / 4; u += 512) ((LAS unsigned*)(l3 + LDSCTL_OFF))[u] = 0u;
    __syncthreads();
    XcdBarrier bar = xcd_barrier_post((unsigned*)(p.ws + WS_CTL) + CW_BAR + p.li * XCD_BAR_WORDS, (volatile LAS unsigned*)(l3 + LDSCTL_OFF + 64), tid);
    const int lo = p.ph_lo, hi = p.ph_hi;
#define IN(k) (lo <= (k) && (k) < hi)
#define SEAM(k) do { if (IN(k) && IN((k) + 1)) xcd_barrier(bar, tid); } while (0)
#ifndef REP0
#define REP0 1
#endif
#ifndef REP1
#define REP1 1
#endif
#ifndef REP2
#define REP2 1
#endif
#ifndef REP3A
#define REP3A 1
#endif
#ifndef REP3B
#define REP3B 1
#endif
#ifndef REP5A
#define REP5A 1
#endif
#ifndef REP5B
#define REP5B 1
#endif
#ifndef REP6
#define REP6 1
#endif
#ifndef REP8
#define REP8 1
#endif
#ifndef REP9
#define REP9 1
#endif
#ifndef REP10
#define REP10 1
#endif
#ifndef REP11
#define REP11 1
#endif
#define PH(R, ...) do { __VA_ARGS__; if (R > 1) { __syncthreads(); __VA_ARGS__; } } while (0)
    if (IN(0)) { PH(REP0, prologue_body(p, blockIdx.x * 8 + wave, gridDim.x * 8, lane, l3 + wave * 9216)); router_weights(p, blockIdx.x * 512 + tid, gridDim.x * 512); }
    SEAM(0);
    if (IN(1)) { if (blockIdx.x < GEMM1_WGS) PH(REP1, { pg8::Gemm g{(const pg8::bf16_t*)(p.ws + WS_XNP), (const pg8::bf16_t*)(p.ws + WS_WIN), T, 7168, D, LDP};
      pg8::StaticOrder S; S.init(T, 7168, GEMM1_WGS, blockIdx.x);
      pg8::EpiInProj E{(pg8::bf16_t*)(p.ws + WS_SEG)};
      pg8::gemm_phase<pg8::EpiInProj, pg8::StaticOrder, true, true>(l3, g, S, E, tid); });
      else gate_gemm(p, (int)blockIdx.x - GEMM1_WGS, tid);
      convert_queue(p, lane, l3 + wave * 9216); }
    if (IN(1) && IN(3)) xcd_barrier(bar, tid);
    if (IN(3)) {
        PH(REP3A, { const attn_body::AttnTensors AT{(const attn_body::bf16*)(p.ws + WS_QD), (const attn_body::bf16*)(p.ws + WS_KD), (const attn_body::bf16*)(p.ws + WS_VD), (attn_body::bf16*)(p.ws + WS_OA)};
          const int G = gridDim.x, bx = blockIdx.x; attn_body::attn_phase<8>((char*)lds, AT, (bx % 8) * (G / 8) + bx / 8, p.rel_bias, tid); });
        PH(REP3B, ph_mlstm_local(p, l3, tid)); }
    SEAM(3);
    if (IN(4)) ph_mlstm_scan(p, l3, tid);
    SEAM(4);
    if (IN(5)) { PH(REP5A, ph_mlstm_out(p, l3, tid)); }
    SEAM(5);
    if (IN(6)) PH(REP6, { pg8::Gemm g{(const pg8::bf16_t*)(p.ws + WS_A2), (const pg8::bf16_t*)(p.ws + WS_WOUT), T, D, D, D};
      pg8::StaticOrder S; S.init(T, D, gridDim.x, blockIdx.x);
      pg8::EpiOutProj E{p.x, (pg8::bf16_t*)(p.ws + WS_X1)};
      pg8::gemm_phase<pg8::EpiOutProj, pg8::StaticOrder, true, true>(l3, g, S, E, tid); });
    SEAM(6);
    if (IN(7)) ph_router(p, l3, tid);
    if (IN(7) && IN(9)) xcd_barrier(bar, tid);
    if (IN(9)) {
        LAS int* s_tb = (LAS int*)(l3 + LDSCTL_OFF + 256); LAS int* s_cn = (LAS int*)(l3 + LDSCTL_OFF + 512);
        if (tid < 32) s_cn[tid] = (int)__hip_atomic_load((unsigned*)(p.ws + WS_CTL) + CW_CNT + tid, RLX_AGENT);
        __syncthreads();
        if (tid == 0) { int tb = 0; for (int e = 0; e < 32; ++e) { s_tb[e] = tb; tb += (s_cn[e] + 255) >> 8; } s_tb[32] = tb; }
        __syncthreads();
        PH(REP9, { pg8::Gemm g{(const pg8::bf16_t*)(p.ws + WS_H2), (const pg8::bf16_t*)(p.ws + WS_WGU), T, NEXP * 1024, D, D};
          static_assert(pg8::MoeSched::TB_ADDR == LDSCTL_OFF + 256 && pg8::MoeSched::CN_ADDR == LDSCTL_OFF + 512, "MoE tables");
          pg8::MoeSched S{(const int*)(p.ws + WS_LIST), (unsigned*)(p.ws + WS_CTL) + CW_HC, (int)gridDim.x, (int)((blockIdx.x & 7) * (gridDim.x >> 3) + (blockIdx.x >> 3))};
          pg8::EpiGU E{(unsigned char*)(p.ws + WS_HID), (const float*)(p.ws + WS_LISTW)};
          pg8::gemm_phase_g<pg8::EpiGU, pg8::MoeSched, true>(l3, g, S, E, tid); }); }
    if (IN(10)) PH(REP10, { pg8::Gemm g{(const pg8::bf16_t*)(p.ws + WS_HID), (const pg8::bf16_t*)(p.ws + WS_WD), MAXROWS, NEXP * 2048, FE, FE};
      pg8::MoeSchedD S{(const unsigned*)(p.ws + WS_CTL) + CW_HC, (unsigned*)(p.ws + WS_CTL) + CW_TMO, (int)gridDim.x, (int)((blockIdx.x & 7) * (gridDim.x >> 3) + (blockIdx.x >> 3))};
      pg8::EpiDown E{(pg8::bf16_t*)(p.ws + WS_HS)};
      pg8::gemm_phase_g<pg8::EpiDown, pg8::MoeSchedD, true>(l3, g, S, E, tid); });
    SEAM(10);
    if (IN(11)) PH(REP11, ph_final(p, (const LAS int*)(l3 + LDSCTL_OFF + 256), tid));
#undef PH
#undef IN
#undef SEAM
#undef lane
#undef tid
}

extern "C" void kernel_launch(void* const* d_in, const int* in_sizes, int n_in, void* d_out, int out_size, void* d_ws, size_t ws_size, hipStream_t stream) {
    static int grid = 0;
    if (grid == 0) {
        if (n_in != 24 || in_sizes[0] != T * D || out_size != T * D || ws_size < WS_END) { fprintf(stderr, "kernel_launch: unexpected shapes (n_in %d, in0 %d, out %d, ws %zu)\n", n_in, n_in > 0 ? in_sizes[0] : -1, out_size, ws_size); grid = -1; return; }
        int dev = 0, cus = 0, per_cu = 0;
        if (hipGetDevice(&dev) != hipSuccess || hipDeviceGetAttribute(&cus, hipDeviceAttributeMultiprocessorCount, dev) != hipSuccess) { grid = -1; return; }
        if (hipFuncSetAttribute((const void*)mega_fwd, hipFuncAttributeMaxDynamicSharedMemorySize, LDS_BYTES) != hipSuccess) { fprintf(stderr, "kernel_launch: hipFuncSetAttribute failed\n"); grid = -1; return; }
        if (hipOccupancyMaxActiveBlocksPerMultiprocessor(&per_cu, (const void*)mega_fwd, 512, LDS_BYTES) != hipSuccess || per_cu < 1) { fprintf(stderr, "kernel_launch: occupancy query reports %d workgroups per CU\n", per_cu); }
        (void)hipGetLastError();
        grid = 256;
        if (cus < 256) { fprintf(stderr, "kernel_launch: %d CUs < 256: the persistent grid would not be resident\n", cus); grid = -1; return; }
    }
    if (grid < 0) return;
    if (hipMemsetAsync((char*)d_ws + WS_CTL, 0, CTL_ZERO_BYTES, stream) != hipSuccess) return;
    Params p{};
    const float** pf = (const float**)&p;
    for (int i = 0; i < 24; ++i) pf[i] = (const float*)d_in[i];
    p.out = (float*)d_out; p.ws = (unsigned char*)d_ws;
    p.ph_lo = 0; p.ph_hi = 12; p.li = 0;
    hipLaunchKernelGGL(mega_fwd, dim3(grid), dim3(512), LDS_BYTES, stream, p);
}
```

```cpp
#include <hip/hip_runtime.h>
#include <cstdio>
#include <cstdint>
#include <cmath>
namespace pg8 {
#define PG8_LAS __attribute__((address_space(3)))
typedef unsigned short bf16_t;
typedef short bf16x8 __attribute__((ext_vector_type(8)));
typedef float f32x4 __attribute__((ext_vector_type(4)));
typedef unsigned u32x4 __attribute__((ext_vector_type(4)));
constexpr int BM = 256, BK = 64, HALF = 128, HTB = HALF * BK * 2  , STAGE_BYTES = 8 * HTB, NXCD = 8, WGM = 8;

__host__ __device__ __forceinline__ int lds_byte(int r, int c) { const int st = (r >> 4) * 2 + (c >> 5), rr = r & 15, cc = c & 31, ob = rr * 64 + cc * 2; return st * 1024 + (ob ^ (((ob >> 9) & 1) << 5)); }
__host__ __device__ __forceinline__ void stage_rc(int b, int& R, int& C) { const int st = b / 1024, sb = b % 1024, swz = sb ^ (((sb >> 9) & 1) << 5); R = (st >> 1) * 16 + swz / 64; C = (st & 1) * 32 + (swz % 64) / 2; }
__host__ __device__ __forceinline__ int perm32(int rho) { const int n = rho >> 4, i = rho & 15; return 8 * (i >> 2) + 4 * n + (i & 3); }

struct Unit { int pm, pn, e, i0, cnt; };
struct Gemm { const bf16_t* A; const bf16_t* Bt; int M, N, K, ld; };

struct StaticOrder {
    int nM, nN, nwg, G, c;
    __host__ __device__ void init(int M, int N, int G_, int c_) { nM = M / BM; nN = N / BM; nwg = nM * nN; G = G_; c = c_; }
    __host__ __device__ bool next(int i, Unit& u) const {
        const long L = (long)i * G + c; if (L >= nwg) return false;
        int wgid = (int)L; { const int q = nwg / NXCD, r = nwg % NXCD, xcd = wgid % NXCD, off = wgid / NXCD; wgid = (xcd < r ? xcd * (q + 1) : r * (q + 1) + (xcd - r) * q) + off; }
        const int nig = WGM * nN, gid = wgid / nig, fm = gid * WGM, gsz = (nM - fm) < WGM ? (nM - fm) : WGM;
        u.pm = fm + ((wgid % nig) % gsz); u.pn = (wgid % nig) / gsz; return true;
    }
    __device__ __forceinline__ void a_ready(const Unit&, int, int) const {}
    __device__ __forceinline__ void done(const Unit&, int) const {}
};

__device__ __forceinline__ unsigned cvt_pk_bf16(float lo, float hi) { unsigned r; asm volatile("v_cvt_pk_bf16_f32 %0, %1, %2" : "=v"(r) : "v"(lo), "v"(hi)); return r; }
typedef float f32x2 __attribute__((ext_vector_type(2)));
constexpr int kT = 8192;
struct MoeSched {
    static constexpr bool GATHER = true;
    static constexpr unsigned TB_ADDR = 146432 + 256, CN_ADDR = 146432 + 512;
    const int* list; unsigned* ready; int G, c;
    __device__ __forceinline__ bool next(int i, Unit& u) const {
        const PG8_LAS int* tb = (const PG8_LAS int*)TB_ADDR; const PG8_LAS int* cn = (const PG8_LAS int*)CN_ADDR;
        const int MT = tb[32]; const int L = i * G + c; if (L >= MT * 4) return false;
        const int mt = L >> 2, pn = L & 3; int e = 0; while (tb[e + 1] <= mt) ++e;
        u.pm = mt; u.pn = e * 4 + pn; u.e = e; u.i0 = (mt - tb[e]) * 256; u.cnt = cn[e]; return true;
    }
    __device__ __forceinline__ int rowidx(const Unit& u, int rr) const { const int i = u.i0 + rr; return (i < u.cnt) ? (list[u.e * 8192 + i] >> 1) : 0; }
    __device__ __forceinline__ void a_ready(const Unit&, int, int) const {}
    __device__ __forceinline__ void done(const Unit& u, int lane) const {
        asm volatile("s_waitcnt vmcnt(0)" ::: "memory");
        if (lane == 0) __hip_atomic_fetch_add(ready + 64 * u.pm, 1u, __ATOMIC_RELAXED, __HIP_MEMORY_SCOPE_AGENT);
    }
};
struct MoeSchedD {
    static constexpr bool GATHER = false;
    const unsigned* ready; unsigned* tmo; int G, c;
    __device__ __forceinline__ bool next(int i, Unit& u) const {
        const PG8_LAS int* tb = (const PG8_LAS int*)MoeSched::TB_ADDR; const PG8_LAS int* cn = (const PG8_LAS int*)MoeSched::CN_ADDR;
        const int MT = tb[32], N2 = 4 * MT - G, N1 = G - N2; int j;
        if (c >= N2) j = (i == 0) ? (c - N2) : (i == 1) ? (c - N2 + N1) : (2 * N1 + (i - 2) * G + c); else j = 2 * N1 + i * G + c;
        if (j >= MT * 8) return false;
        const int mt = j >> 3, pn = j & 7; int e = 0; while (tb[e + 1] <= mt) ++e;
        u.pm = mt; u.pn = e * 8 + pn; u.e = e; u.i0 = (mt - tb[e]) * 256; u.cnt = cn[e]; return true;
    }
    __device__ __forceinline__ void a_ready(const Unit& u, int wid, int lane) const {
        if (wid == 0) {
            unsigned polls = 0;
            while ((unsigned)__builtin_amdgcn_readfirstlane(__hip_atomic_load(ready + 64 * u.pm, __ATOMIC_RELAXED, __HIP_MEMORY_SCOPE_AGENT)) < 32u) {
                if (++polls > (1u << 20)) { if (lane == 0) __hip_atomic_store(tmo, 1u, __ATOMIC_RELAXED, __HIP_MEMORY_SCOPE_AGENT); break; }
                __builtin_amdgcn_s_sleep(2); }
            __builtin_amdgcn_fence(__ATOMIC_ACQUIRE, "agent");
            asm volatile("s_waitcnt vmcnt(0)" ::: "memory");
        }
        asm volatile("" ::: "memory"); __builtin_amdgcn_s_barrier(); asm volatile("" ::: "memory");
    }
    __device__ __forceinline__ void done(const Unit&, int) const {}
};
__device__ __forceinline__ u32x4 pack8(const f32x4 v0, const f32x4 v1) { u32x4 w; w.x = cvt_pk_bf16(v0[0], v0[1]); w.y = cvt_pk_bf16(v0[2], v0[3]); w.z = cvt_pk_bf16(v1[0], v1[1]); w.w = cvt_pk_bf16(v1[2], v1[3]); return w; }
struct EpiInProj {
    static constexpr bool PERM = true, AFTER_DRAIN = false;
    bf16_t* seg;
    __device__ __forceinline__ void operator()(const f32x4 (&acc)[2][2][4][2], const Unit& u, int wr, int wc, int fr, int fq) const {
        const int row0 = u.pm * BM + wr * 64 + fr;
        const int s = u.pn >> 2; bf16_t* base = seg + (size_t)s * ((size_t)kT * 1024);
        const int col0 = (u.pn & 3) * BM + wc * 32 + 8 * fq;
#pragma unroll
        for (int ai = 0; ai < 2; ++ai)
#pragma unroll
            for (int m = 0; m < 4; ++m) { bf16_t* rowp = base + (size_t)(row0 + ai * HALF + m * 16) * 1024 + col0;
#pragma unroll
                for (int bj = 0; bj < 2; ++bj) *(u32x4*)(rowp + bj * HALF) = pack8(acc[ai][bj][m][0], acc[ai][bj][m][1]); }
    }
};
struct EpiOutProj {
    static constexpr bool PERM = true, AFTER_DRAIN = false;
    const float* x; bf16_t* x1;
    __device__ __forceinline__ void operator()(const f32x4 (&acc)[2][2][4][2], const Unit& u, int wr, int wc, int fr, int fq) const {
        const int col0 = u.pn * BM + wc * 32 + 8 * fq;
#pragma unroll
        for (int ai = 0; ai < 2; ++ai)
#pragma unroll
            for (int m = 0; m < 4; ++m) { const size_t off = (size_t)(u.pm * BM + ai * HALF + wr * 64 + m * 16 + fr) * 2048 + col0;
#pragma unroll
                for (int bj = 0; bj < 2; ++bj) { const f32x4 x0 = *(const f32x4*)(x + off + bj * HALF), x1v = *(const f32x4*)(x + off + bj * HALF + 4);
                    *(u32x4*)(x1 + off + bj * HALF) = pack8(acc[ai][bj][m][0] + x0, acc[ai][bj][m][1] + x1v); } }
    }
};
__device__ __forceinline__ float silu_f(float g) { return g / (1.f + __expf(-g)); }
__device__ __forceinline__ float clamp8(float v) { return __builtin_fminf(__builtin_fmaxf(v, -448.f), 448.f); }
__device__ __forceinline__ unsigned pk4_fp8(float a, float b, float c, float d) { int w = 0; w = __builtin_amdgcn_cvt_pk_fp8_f32(clamp8(a), clamp8(b), w, false); w = __builtin_amdgcn_cvt_pk_fp8_f32(clamp8(c), clamp8(d), w, true); return (unsigned)w; }
constexpr float W8_GU = 32.f, W8_D = 16.f, H8 = 16.f;
struct EpiGU {
    static constexpr bool PERM = true, AFTER_DRAIN = false;
    unsigned char* hid; const float* listw;
    __device__ __forceinline__ void operator()(const f32x4 (&acc)[2][2][4][2], const Unit& u, int wr, int wc, int fr, int fq) const {
        const int pnl = u.pn & 3, row0 = u.pm * BM + wr * 64 + fr, col0 = pnl * 128 + wc * 32 + 8 * fq; constexpr float ws = 1.f / W8_GU;
        const __amdgpu_buffer_rsrc_t rsrc = __builtin_amdgcn_make_buffer_rsrc(hid, 0, 24576 * 512, 0x00020000);
#pragma unroll
        for (int ai = 0; ai < 2; ++ai)
#pragma unroll
            for (int m = 0; m < 4; ++m) { const int r = row0 + ai * HALF + m * 16; const float w = H8 * ws; f32x4 h0, h1;
#pragma unroll
                for (int q = 0; q < 4; ++q) { h0[q] = silu_f(acc[ai][0][m][0][q] * ws) * acc[ai][1][m][0][q] * w; h1[q] = silu_f(acc[ai][0][m][1][q] * ws) * acc[ai][1][m][1][q] * w; }
                typedef unsigned u32x2 __attribute__((ext_vector_type(2)));
                __builtin_amdgcn_raw_buffer_store_b64((u32x2){pk4_fp8(h0[0], h0[1], h0[2], h0[3]), pk4_fp8(h1[0], h1[1], h1[2], h1[3])}, rsrc, (unsigned)(r * 512 + col0), 0, 16); }
    }
};
struct EpiDown {
    static constexpr bool PERM = true, AFTER_DRAIN = false;
    bf16_t* y;
    __device__ __forceinline__ void operator()(const f32x4 (&acc)[2][2][4][2], const Unit& u, int wr, int wc, int fr, int fq) const {
        const int pnl = u.pn & 7, row0 = u.pm * BM + wr * 64 + fr, col0 = pnl * BM + wc * 32 + 8 * fq;
#pragma unroll
        for (int ai = 0; ai < 2; ++ai)
#pragma unroll
            for (int m = 0; m < 4; ++m) { bf16_t* dst = y + (size_t)(row0 + ai * HALF + m * 16) * 2048 + col0;
#pragma unroll
                for (int bj = 0; bj < 2; ++bj) *(u32x4*)(dst + bj * HALF) = pack8(acc[ai][bj][m][0], acc[ai][bj][m][1]); }
    }
};
template <class Epi, class Sched, bool ALIGN_EPI = false, bool SP2 = false>
__device__ __forceinline__ void gemm_phase(PG8_LAS unsigned char* lds, const Gemm g, const Sched& S, const Epi& E, const int tid) {
    const int wid = __builtin_amdgcn_readfirstlane(tid >> 6), lane = tid & 63, wr = wid >> 2, wc = wid & 3, fr = lane & 15, fq = lane >> 4;
    const int K = g.K, nt = K / BK;
    unsigned voffA[2], voffB[2];
#pragma unroll
    for (int i = 0; i < 2; ++i) { int R, C; stage_rc(tid * 16 + i * 8192, R, C); const int Rb = Epi::PERM ? ((R & ~31) + perm32(R & 31)) : R;
        voffA[i] = (unsigned)(R * g.ld + C) * 2u; voffB[i] = (unsigned)(Rb * g.ld + C) * 2u; }
    const size_t kstep = (size_t)(BK * 2);
    const size_t hstep = (size_t)HALF * g.ld * 2;
    const size_t tstep = 2 * hstep;
    const unsigned ldsw = (unsigned)wid * 1024u;
    const int aoff = lds_byte(wr * 64 + fr, fq * 8), boff = lds_byte(wc * 32 + fr, fq * 8);
#define PG8_SA(b, h) (((b) * 2 + (h)) * HTB)
#define PG8_SB(b, h) ((4 + (b) * 2 + (h)) * HTB)
#define PG8_STAGE(bufoff, gbase, voff) do { _Pragma("unroll") for (int _i = 0; _i < 2; ++_i) \
        __builtin_amdgcn_global_load_lds((const unsigned*)((const char*)(gbase) + (voff)[_i]), (PG8_LAS unsigned*)(lds + (bufoff) + ldsw + _i * 8192), 16, 0, 0); } while (0)
#define PG8_LDA(dst, b, h) do { _Pragma("unroll") for (int m = 0; m < 4; ++m) _Pragma("unroll") for (int k = 0; k < 2; ++k) dst[m][k] = *(const PG8_LAS bf16x8*)(lds + PG8_SA(b, h) + aoff + m * 2048 + k * 1024); } while (0)
#define PG8_LDB(dst, b, h) do { _Pragma("unroll") for (int n = 0; n < 2; ++n) _Pragma("unroll") for (int k = 0; k < 2; ++k) dst[n][k] = *(const PG8_LAS bf16x8*)(lds + PG8_SB(b, h) + boff + n * 2048 + k * 1024); } while (0)
#define PG8_MMA(ai, bj, At, Bt) do { __builtin_amdgcn_s_setprio(1); _Pragma("unroll") for (int m = 0; m < 4; ++m) _Pragma("unroll") for (int n = 0; n < 2; ++n) _Pragma("unroll") for (int k = 0; k < 2; ++k) \
        acc[ai][bj][m][n] = __builtin_amdgcn_mfma_f32_16x16x32_bf16(Bt[n][k], At[m][k], acc[ai][bj][m][n], 0, 0, 0); __builtin_amdgcn_s_setprio(0); } while (0)
#define PG8_WAIT_V(n) asm volatile("s_waitcnt vmcnt(" #n ")" ::: "memory")
#define PG8_WAIT_L(n) asm volatile("s_waitcnt lgkmcnt(" #n ")" ::: "memory")
#define PG8_BAR __builtin_amdgcn_s_barrier()
#define PG8_SCHED __builtin_amdgcn_sched_barrier(0)
    Unit cur, nxt; int ui = 0;
    if (!S.next(0, cur)) return;
    f32x4 acc[2][2][4][2];
#pragma unroll
    for (int a = 0; a < 2; ++a)
#pragma unroll
        for (int b = 0; b < 2; ++b)
#pragma unroll
            for (int m = 0; m < 4; ++m)
#pragma unroll
                for (int n = 0; n < 2; ++n) acc[a][b][m][n] = (f32x4){0.f, 0.f, 0.f, 0.f};
    bf16x8 At[4][2], B0[2][2], B1[2][2];
    const char* cA = (const char*)g.A + (size_t)cur.pm * tstep; const char* cB = (const char*)g.Bt + (size_t)cur.pn * tstep;
    S.a_ready(cur, wid, lane);
    if constexpr (SP2) {
        PG8_STAGE(PG8_SB(0, 0), cB, voffB); PG8_STAGE(PG8_SB(0, 1), cB + hstep, voffB); PG8_STAGE(PG8_SA(0, 0), cA, voffA); PG8_STAGE(PG8_SA(0, 1), cA + hstep, voffA);
        if (wr == 1) PG8_BAR;
        PG8_WAIT_V(2); PG8_BAR;
        PG8_STAGE(PG8_SB(1, 0), cB + kstep, voffB); PG8_STAGE(PG8_SA(1, 0), cA + kstep, voffA); PG8_STAGE(PG8_SB(1, 1), cB + hstep + kstep, voffB);
        PG8_WAIT_V(6); PG8_BAR;
    } else {
        PG8_STAGE(PG8_SB(0, 0), cB, voffB); PG8_STAGE(PG8_SA(0, 0), cA, voffA); PG8_STAGE(PG8_SB(0, 1), cB + hstep, voffB); PG8_STAGE(PG8_SA(0, 1), cA + hstep, voffA);
        if (wr == 1) PG8_BAR;
        PG8_WAIT_V(4); PG8_BAR;
        PG8_STAGE(PG8_SB(1, 0), cB + kstep, voffB); PG8_STAGE(PG8_SA(1, 0), cA + kstep, voffA); PG8_STAGE(PG8_SB(1, 1), cB + hstep + kstep, voffB);
        PG8_WAIT_V(6); PG8_BAR;
    }
    for (;;) {
        const bool has_next = S.next(ui + 1, nxt);
        const char* nA = has_next ? (const char*)g.A + (size_t)nxt.pm * tstep : cA; const char* nB = has_next ? (const char*)g.Bt + (size_t)nxt.pn * tstep : cB;
        for (int t = 0; t < nt; t += 2) {
            const bool last = (t == nt - 2);
            const char* a1 = cA + (size_t)(t + 1) * kstep;
            const char* a2 = last ? nA : cA + (size_t)(t + 2) * kstep; const char* b2 = last ? nB : cB + (size_t)(t + 2) * kstep;
            const char* a3 = a2 + kstep; const char* b3 = b2 + kstep;
            if (last && has_next) S.a_ready(nxt, wid, lane);
            if constexpr (SP2) {
            PG8_LDB(B0, 0, 0); PG8_LDB(B1, 0, 1); PG8_SCHED; PG8_LDA(At, 0, 0); PG8_STAGE(PG8_SA(1, 1), a1 + hstep, voffA);
            PG8_WAIT_V(8); PG8_WAIT_L(0); PG8_BAR; PG8_MMA(0, 0, At, B0); PG8_MMA(0, 1, At, B1); PG8_BAR; PG8_SCHED;
            PG8_LDA(At, 0, 1); PG8_STAGE(PG8_SB(0, 0), b2, voffB); PG8_STAGE(PG8_SB(0, 1), b2 + hstep, voffB); PG8_STAGE(PG8_SA(0, 0), a2, voffA);
            PG8_WAIT_V(8); PG8_WAIT_L(0); PG8_BAR; PG8_MMA(1, 0, At, B0); PG8_MMA(1, 1, At, B1); PG8_BAR; PG8_SCHED;
            PG8_LDB(B0, 1, 0); PG8_LDB(B1, 1, 1); PG8_SCHED; PG8_LDA(At, 1, 0); PG8_STAGE(PG8_SA(0, 1), a2 + hstep, voffA);
            PG8_WAIT_V(8); PG8_WAIT_L(0); PG8_BAR; PG8_MMA(0, 0, At, B0); PG8_MMA(0, 1, At, B1); PG8_BAR; PG8_SCHED;
            PG8_LDA(At, 1, 1); PG8_STAGE(PG8_SB(1, 0), b3, voffB); PG8_STAGE(PG8_SB(1, 1), b3 + hstep, voffB); PG8_STAGE(PG8_SA(1, 0), a3, voffA);
            PG8_WAIT_V(8); PG8_WAIT_L(0); PG8_BAR; PG8_MMA(1, 0, At, B0); PG8_MMA(1, 1, At, B1); PG8_BAR; PG8_SCHED;
            } else {
            PG8_LDB(B0, 0, 0); PG8_SCHED; PG8_LDA(At, 0, 0); PG8_STAGE(PG8_SA(1, 1), a1 + hstep, voffA);
            PG8_WAIT_L(8); PG8_BAR; PG8_WAIT_L(0); PG8_MMA(0, 0, At, B0); PG8_BAR; PG8_SCHED;
            PG8_LDB(B1, 0, 1); PG8_STAGE(PG8_SB(0, 0), b2, voffB);
            PG8_BAR; PG8_WAIT_L(0); PG8_MMA(0, 1, At, B1); PG8_BAR;
            PG8_LDA(At, 0, 1); PG8_STAGE(PG8_SA(0, 0), a2, voffA);
            PG8_BAR; PG8_WAIT_L(0); PG8_MMA(1, 0, At, B0); PG8_BAR; PG8_SCHED;
            PG8_STAGE(PG8_SB(0, 1), b2 + hstep, voffB);
            PG8_WAIT_V(6); PG8_BAR; PG8_MMA(1, 1, At, B1); PG8_BAR;
            PG8_LDB(B0, 1, 0); PG8_SCHED; PG8_LDA(At, 1, 0); PG8_STAGE(PG8_SA(0, 1), a2 + hstep, voffA);
            PG8_WAIT_L(8); PG8_BAR; PG8_WAIT_L(0); PG8_MMA(0, 0, At, B0); PG8_BAR; PG8_SCHED;
            PG8_LDB(B1, 1, 1); PG8_STAGE(PG8_SB(1, 0), b3, voffB);
            PG8_BAR; PG8_WAIT_L(0); PG8_MMA(0, 1, At, B1); PG8_BAR;
            PG8_LDA(At, 1, 1); PG8_STAGE(PG8_SA(1, 0), a3, voffA);
            PG8_BAR; PG8_WAIT_L(0); PG8_MMA(1, 0, At, B0); PG8_BAR; PG8_SCHED;
            PG8_STAGE(PG8_SB(1, 1), b3 + hstep, voffB);
            PG8_WAIT_V(6); PG8_BAR; PG8_MMA(1, 1, At, B1); PG8_BAR;
            }
        }
        if constexpr (ALIGN_EPI) { if (wr == 0) PG8_BAR; }
        if constexpr (!Epi::AFTER_DRAIN) { E(acc, cur, wr, wc, fr, fq); S.done(cur, lane); }
        if (!has_next) break;
#pragma unroll
        for (int a = 0; a < 2; ++a)
#pragma unroll
            for (int b = 0; b < 2; ++b)
#pragma unroll
                for (int m = 0; m < 4; ++m)
#pragma unroll
                    for (int n = 0; n < 2; ++n) acc[a][b][m][n] = (f32x4){0.f, 0.f, 0.f, 0.f};
        cur = nxt; cA = nA; cB = nB; ++ui;
        if constexpr (ALIGN_EPI) { if (wr == 1) PG8_BAR; }
    }
    PG8_WAIT_V(0);
    if constexpr (!ALIGN_EPI) { if (wr == 0) PG8_BAR; }
    PG8_BAR;
    if constexpr (Epi::AFTER_DRAIN) { E.fused(acc, cur, wr, wc, fr, fq, lds, wid, lane); S.done(cur, lane); }
#undef PG8_SA
#undef PG8_SB
#undef PG8_STAGE
#undef PG8_LDA
#undef PG8_LDB
#undef PG8_MMA
#undef PG8_WAIT_V
#undef PG8_WAIT_L
#undef PG8_BAR
#undef PG8_SCHED
}
typedef int i32x4g __attribute__((ext_vector_type(4))); typedef int i32x8g __attribute__((ext_vector_type(8)));
__device__ __forceinline__ i32x8g cat8(bf16x8 a, bf16x8 b) { const i32x4g x = __builtin_bit_cast(i32x4g, a), y = __builtin_bit_cast(i32x4g, b); return __builtin_shufflevector(x, y, 0, 1, 2, 3, 4, 5, 6, 7); }
template <class Epi, class Sched, bool FP8 = false>
__device__ __forceinline__ void gemm_phase_g(PG8_LAS unsigned char* lds, const Gemm g, const Sched& S, const Epi& E, const int tid) {
    const int wid = __builtin_amdgcn_readfirstlane(tid >> 6), lane = tid & 63, wr = wid >> 2, wc = wid & 3, fr = lane & 15, fq = lane >> 4;
    constexpr bool GATHER = Sched::GATHER;
    constexpr int ESZ = FP8 ? 1 : 2;
    const int K = g.K, nt = K * ESZ / (BK * 2);
    unsigned voffB[2]; int RA[2], CA[2];
#pragma unroll
    for (int i = 0; i < 2; ++i) { int R, C; stage_rc(tid * 16 + i * 8192, R, C); const int Rb = Epi::PERM ? ((R & ~31) + perm32(R & 31)) : R; RA[i] = R; CA[i] = C; voffB[i] = (unsigned)(Rb * g.ld * ESZ) + (unsigned)C * 2u; }
    const size_t kstep = (size_t)(BK * 2);
    const size_t hstep = (size_t)HALF * g.ld * ESZ;
    const size_t tstep = 2 * hstep;
    const unsigned ldsw = (unsigned)wid * 1024u;
    const int aoff = lds_byte(wr * 64 + fr, fq * 8), boff = lds_byte(wc * 32 + fr, fq * 8);
#define PG8_SA(b, h) (((b) * 2 + (h)) * HTB)
#define PG8_SB(b, h) ((4 + (b) * 2 + (h)) * HTB)
#define PG8_STAGE(bufoff, gbase, voff) do { _Pragma("unroll") for (int _i = 0; _i < 2; ++_i) { unsigned o_ = (voff)[_i]; asm volatile("" : "+v"(o_));     \
        __builtin_amdgcn_global_load_lds((const unsigned*)((const char*)(gbase) + o_), (PG8_LAS unsigned*)(lds + (bufoff) + ldsw + _i * 8192), 16, 0, 0); } } while (0)
#define PG8_GOFF(V0, V1, U) do { _Pragma("unroll") for (int _i = 0; _i < 2; ++_i) { \
        V0[_i] = (unsigned)S.rowidx(U, RA[_i]) * (unsigned)(g.ld * ESZ) + (unsigned)CA[_i] * 2u; V1[_i] = (unsigned)S.rowidx(U, HALF + RA[_i]) * (unsigned)(g.ld * ESZ) + (unsigned)CA[_i] * 2u; } } while (0)
#define PG8_LD8(p_) __builtin_shufflevector(*(const PG8_LAS i32x4g*)(p_), *(const PG8_LAS i32x4g*)((p_) + 1024), 0, 1, 2, 3, 4, 5, 6, 7)
#define PG8_LDA(dst, b, h) do { _Pragma("unroll") for (int m = 0; m < 4; ++m) dst[m] = PG8_LD8(lds + PG8_SA(b, h) + aoff + m * 2048); } while (0)
#define PG8_LDB(dst, b, h) do { _Pragma("unroll") for (int n = 0; n < 2; ++n) dst[n] = PG8_LD8(lds + PG8_SB(b, h) + boff + n * 2048); } while (0)
#define PG8_LO(v) __builtin_bit_cast(bf16x8, __builtin_shufflevector(v, v, 0, 1, 2, 3))
#define PG8_HI(v) __builtin_bit_cast(bf16x8, __builtin_shufflevector(v, v, 4, 5, 6, 7))
#define PG8_MMA(ai, bj, At, Bt) do { __builtin_amdgcn_s_setprio(1); if constexpr (FP8) { \
          \
        asm volatile("s_nop 1\n\tv_mfma_f32_16x16x128_f8f6f4 %0, %8, %12, %0\n\tv_mfma_f32_16x16x128_f8f6f4 %1, %9, %12, %1\n\tv_mfma_f32_16x16x128_f8f6f4 %2, %8, %13, %2\n\tv_mfma_f32_16x16x128_f8f6f4 %3, %9, %13, %3\n\t" \
                     "v_mfma_f32_16x16x128_f8f6f4 %4, %8, %14, %4\n\tv_mfma_f32_16x16x128_f8f6f4 %5, %9, %14, %5\n\tv_mfma_f32_16x16x128_f8f6f4 %6, %8, %15, %6\n\tv_mfma_f32_16x16x128_f8f6f4 %7, %9, %15, %7" \
                     : "+v"(acc[ai][bj][0][0]), "+v"(acc[ai][bj][0][1]), "+v"(acc[ai][bj][1][0]), "+v"(acc[ai][bj][1][1]), "+v"(acc[ai][bj][2][0]), "+v"(acc[ai][bj][2][1]), "+v"(acc[ai][bj][3][0]), "+v"(acc[ai][bj][3][1]) \
                     : "v"(Bt[0]), "v"(Bt[1]), "v"(Bt[0]), "v"(Bt[1]), "v"(At[0]), "v"(At[1]), "v"(At[2]), "v"(At[3])); } else { \
        _Pragma("unroll") for (int m = 0; m < 4; ++m) _Pragma("unroll") for (int n = 0; n < 2; ++n) { \
        acc[ai][bj][m][n] = __builtin_amdgcn_mfma_f32_16x16x32_bf16(PG8_LO(Bt[n]), PG8_LO(At[m]), acc[ai][bj][m][n], 0, 0, 0); \
        acc[ai][bj][m][n] = __builtin_amdgcn_mfma_f32_16x16x32_bf16(PG8_HI(Bt[n]), PG8_HI(At[m]), acc[ai][bj][m][n], 0, 0, 0); } } __builtin_amdgcn_s_setprio(0); } while (0)
#define PG8_WAIT_V(n) asm volatile("s_waitcnt vmcnt(" #n ")" ::: "memory")
#define PG8_WAIT_L(n) asm volatile("s_waitcnt lgkmcnt(" #n ")" ::: "memory")
#define PG8_BAR __builtin_amdgcn_s_barrier()
#define PG8_SCHED __builtin_amdgcn_sched_barrier(0)
    Unit cur, nxt; int ui = 0;
    if (!S.next(0, cur)) return;
    f32x4 acc[2][2][4][2];
#pragma unroll
    for (int a = 0; a < 2; ++a)
#pragma unroll
        for (int b = 0; b < 2; ++b)
#pragma unroll
            for (int m = 0; m < 4; ++m)
#pragma unroll
                for (int n = 0; n < 2; ++n) acc[a][b][m][n] = (f32x4){0.f, 0.f, 0.f, 0.f};
    i32x8g At[4], B0[2], B1[2];
    unsigned vo0[2], vo1[2];
    if constexpr (GATHER) { PG8_GOFF(vo0, vo1, cur); } else {
#pragma unroll
        for (int _i = 0; _i < 2; ++_i) { vo0[_i] = (unsigned)(RA[_i] * g.ld * ESZ) + (unsigned)CA[_i] * 2u; vo1[_i] = vo0[_i]; } }
    const size_t ah = GATHER ? 0 : hstep;
    const char* cA = GATHER ? (const char*)g.A : (const char*)g.A + (size_t)cur.pm * tstep; const char* cB = (const char*)g.Bt + (size_t)cur.pn * tstep;
    S.a_ready(cur, wid, lane);
    PG8_STAGE(PG8_SB(0, 0), cB, voffB); PG8_STAGE(PG8_SB(0, 1), cB + hstep, voffB); PG8_STAGE(PG8_SA(0, 0), cA, vo0); PG8_STAGE(PG8_SA(0, 1), cA + ah, vo1);
    if (wr == 1) PG8_BAR;
    PG8_WAIT_V(2); PG8_BAR;
    PG8_STAGE(PG8_SB(1, 0), cB + kstep, voffB); PG8_STAGE(PG8_SA(1, 0), cA + kstep, vo0); PG8_STAGE(PG8_SB(1, 1), cB + hstep + kstep, voffB);
    PG8_WAIT_V(6); PG8_BAR;
    for (;;) {
        const bool has_next = S.next(ui + 1, nxt);
        const char* nB = has_next ? (const char*)g.Bt + (size_t)nxt.pn * tstep : cB;
        const char* nA = (GATHER || !has_next) ? cA : (const char*)g.A + (size_t)nxt.pm * tstep;
#pragma unroll 1
        for (int t = 0; t < nt; t += 2) {
            const bool last = (t == nt - 2);
            const char* a1 = cA + (size_t)(t + 1) * kstep;
            const char* a2 = last ? nA : cA + (size_t)(t + 2) * kstep; const char* b2 = last ? nB : cB + (size_t)(t + 2) * kstep;
            const char* a3 = a2 + kstep; const char* b3 = b2 + kstep;
            if (last && has_next) S.a_ready(nxt, wid, lane);
            PG8_LDB(B0, 0, 0); PG8_LDB(B1, 0, 1); PG8_SCHED; PG8_LDA(At, 0, 0); PG8_STAGE(PG8_SA(1, 1), a1 + ah, vo1);
            PG8_WAIT_V(8); PG8_WAIT_L(0); PG8_BAR; PG8_MMA(0, 0, At, B0); PG8_MMA(0, 1, At, B1); PG8_BAR; PG8_SCHED;
            if constexpr (GATHER) if (last && has_next) { PG8_GOFF(vo0, vo1, nxt); }
            PG8_LDA(At, 0, 1); PG8_STAGE(PG8_SB(0, 0), b2, voffB); PG8_STAGE(PG8_SB(0, 1), b2 + hstep, voffB); PG8_STAGE(PG8_SA(0, 0), a2, vo0);
            PG8_WAIT_V(8); PG8_WAIT_L(0); PG8_BAR; PG8_MMA(1, 0, At, B0); PG8_MMA(1, 1, At, B1); PG8_BAR; PG8_SCHED;
            PG8_LDB(B0, 1, 0); PG8_LDB(B1, 1, 1); PG8_SCHED; PG8_LDA(At, 1, 0); PG8_STAGE(PG8_SA(0, 1), a2 + ah, vo1);
            PG8_WAIT_V(8); PG8_WAIT_L(0); PG8_BAR; PG8_MMA(0, 0, At, B0); PG8_MMA(0, 1, At, B1); PG8_BAR; PG8_SCHED;
            PG8_LDA(At, 1, 1); PG8_STAGE(PG8_SB(1, 0), b3, voffB); PG8_STAGE(PG8_SB(1, 1), b3 + hstep, voffB); PG8_STAGE(PG8_SA(1, 0), a3, vo0);
            PG8_WAIT_V(8); PG8_WAIT_L(0); PG8_BAR; PG8_MMA(1, 0, At, B0); PG8_MMA(1, 1, At, B1); PG8_BAR; PG8_SCHED;
        }
        if (wr == 0) PG8_BAR;
        if constexpr (FP8) asm volatile("s_nop 15\n\ts_nop 3" ::: "memory");
        E(acc, cur, wr, wc, fr, fq); S.done(cur, lane);
        if (!has_next) break;
#pragma unroll
        for (int a = 0; a < 2; ++a)
#pragma unroll
            for (int b = 0; b < 2; ++b)
#pragma unroll
                for (int m = 0; m < 4; ++m)
#pragma unroll
                    for (int n = 0; n < 2; ++n) acc[a][b][m][n] = (f32x4){0.f, 0.f, 0.f, 0.f};
        cur = nxt; cB = nB; cA = nA; ++ui;
        if (wr == 1) PG8_BAR;
    }
    PG8_WAIT_V(0);
    PG8_BAR;
#undef PG8_SA
#undef PG8_SB
#undef PG8_STAGE
#undef PG8_GOFF
#undef PG8_LDA
#undef PG8_LD8
#undef PG8_LO
#undef PG8_HI
#undef PG8_LDB
#undef PG8_MMA
#undef PG8_WAIT_V
#undef PG8_WAIT_L
#undef PG8_BAR
#undef PG8_SCHED
}
}
#define GAS __attribute__((address_space(1)))
#define LAS __attribute__((address_space(3)))
typedef unsigned short bf16;
typedef unsigned v4u __attribute__((ext_vector_type(4)));
typedef float f32x4 __attribute__((ext_vector_type(4)));
typedef short bf16x8 __attribute__((ext_vector_type(8)));
typedef GAS unsigned gu32;
typedef GAS unsigned long long gu64;
#define RLX_AGENT __ATOMIC_RELAXED, __HIP_MEMORY_SCOPE_AGENT
#define LDS_WAIT() asm volatile("s_waitcnt lgkmcnt(0)" ::: "memory")
#define VM_WAIT() asm volatile("s_waitcnt vmcnt(0)" ::: "memory")
__device__ __forceinline__ unsigned long long rt() { return __builtin_amdgcn_s_memrealtime(); }
__device__ __forceinline__ unsigned f2bf(float f) { unsigned u = __builtin_bit_cast(unsigned, f); return (u + 0x7fffu + ((u >> 16) & 1u)) >> 16; }
__device__ __forceinline__ unsigned pk2(float lo, float hi) { return f2bf(lo) | (f2bf(hi) << 16); }

#define XB_TMO      128
#define XB_XCNT(j)  (256  + 64 * (j))
#define XB_XSUB(j)  (1280 + 64 * (j))
#define XB_XGEN(j)  (2304 + 64 * (j))
#define XB_TOP      3328
#define XB_TOPGEN   3392
#define XCD_BAR_WORDS 3456
#define XB_SPIN_CAP (1u << 18)

__device__ __forceinline__ unsigned xb_ld(unsigned* p)              { return __hip_atomic_load(p, __ATOMIC_RELAXED, __HIP_MEMORY_SCOPE_AGENT); }
__device__ __forceinline__ unsigned xb_add(unsigned* p, unsigned v) { return __hip_atomic_fetch_add(p, v, __ATOMIC_RELAXED, __HIP_MEMORY_SCOPE_AGENT); }
__device__ __forceinline__ unsigned xb_xcc_id() { return (unsigned)__builtin_amdgcn_s_getreg((3 << 11) | 20) & 0xFu; }
#define XB_SPIN(cond, bar) do { unsigned _sp = 0; while (cond) { __builtin_amdgcn_s_sleep(1); \
    if ((++_sp & 255u) == 0u) { if (xb_ld(&(bar)[XB_TMO])) break; if (_sp > XB_SPIN_CAP) { atomicAdd(&(bar)[XB_TMO], 1u); break; } } } } while (0)

struct XcdBarrier {
    unsigned* bar; unsigned x;
    volatile LAS unsigned* st;
};

__device__ __forceinline__ XcdBarrier xcd_barrier_post(unsigned* bar, volatile LAS unsigned* st, const int tid) {
    XcdBarrier b; b.bar = bar; b.x = xb_xcc_id(); b.st = st;
    if (tid == 0) (void)xb_add(&bar[XB_XCNT(b.x)], 1u);
    return b;
}
__device__ __forceinline__ void xcd_barrier_complete(unsigned* bar, unsigned x, unsigned& nloc, unsigned& nx) {
    const unsigned G = gridDim.x * gridDim.y * gridDim.z;
    unsigned sum, cnt, mine, sp = 0u;
    for (;;) {
        sum = 0u; cnt = 0u; mine = 0u;
#pragma unroll
        for (unsigned j = 0; j < 16; ++j) { const unsigned c = xb_ld(&bar[XB_XCNT(j)]); sum += c; cnt += (c > 0u) ? 1u : 0u; mine = (j == x) ? c : mine; }
        if (sum == G) break;
        __builtin_amdgcn_s_sleep(1);
        if ((++sp & 255u) == 0u) { if (xb_ld(&bar[XB_TMO])) break; if (sp > XB_SPIN_CAP) { atomicAdd(&bar[XB_TMO], 1u); break; } }
    }
    nloc = mine > 0u ? mine : 1u; nx = cnt > 0u ? cnt : 1u;
}

__device__ __forceinline__ void xcd_barrier(const XcdBarrier& b, const int tid) {
    asm volatile("s_waitcnt vmcnt(0)" ::: "memory");
    __syncthreads();
    if (tid == 0) {
        unsigned* bar = b.bar;
        __builtin_amdgcn_s_waitcnt(0);
        unsigned nloc = b.st[0], nx = b.st[1];
        if (nloc == 0u) { xcd_barrier_complete(bar, b.x, nloc, nx); b.st[0] = nloc; b.st[1] = nx; }
        const unsigned old = xb_add(&bar[XB_XSUB(b.x)], 1u);
        const unsigned gen = old / nloc;
        if (old + 1u == (gen + 1u) * nloc) {
            __builtin_amdgcn_fence(__ATOMIC_RELEASE, "agent");
            asm volatile("s_waitcnt vmcnt(0)" ::: "memory");
            const unsigned og = xb_add(&bar[XB_TOP], 1u);
            const unsigned tg = og / nx;
            if (og + 1u == (tg + 1u) * nx) xb_add(&bar[XB_TOPGEN], 1u);
            else XB_SPIN(xb_ld(&bar[XB_TOPGEN]) == tg, bar);
            __builtin_amdgcn_fence(__ATOMIC_ACQUIRE, "agent");
            xb_add(&bar[XB_XGEN(b.x)], 1u);
            asm volatile("s_waitcnt vmcnt(0)" ::: "memory");
        } else {
            XB_SPIN(xb_ld(&bar[XB_XGEN(b.x)]) == gen, bar);
            __builtin_amdgcn_fence(__ATOMIC_ACQUIRE, "agent");
            asm volatile("s_waitcnt vmcnt(0)" ::: "memory");
        }
    }
    __syncthreads();
}
#include <hip/hip_bf16.h>
#include <cmath>
namespace attn_body {
using bf16=__hip_bfloat16;
using bf16x8=__attribute__((ext_vector_type(8)))short;
using s16x4=__attribute__((ext_vector_type(4)))short;
using f32x16=__attribute__((ext_vector_type(16)))float;
using u32x4=__attribute__((ext_vector_type(4)))unsigned;
constexpr int BATCH=2,SEQ=4096,D=64,DM=1024,OP=2048;
constexpr int NW=8,QBLK=32,QB=QBLK*NW,KVBLK=64,NQB=SEQ/QB;
constexpr int ATTN_PITCH=DM, ATTN_UNIT_ROWS=QB;
__device__ __forceinline__ int crow(int r,int hi){return (r&3)+8*(r>>2)+4*hi;}
#define SBAR() __builtin_amdgcn_sched_barrier(0)
__device__ __forceinline__ void cmask(f32x16&p0,f32x16&p1,int t,int NT,int wid,int qw,int r32,int hi,const __attribute__((address_space(3))) float*tab){
  const float NEG=-INFINITY; const int jb=t-(NT-4);
  if(jb>(wid>>1)){
    #pragma unroll
    for(int r=0;r<16;++r){p0[r]=NEG;p1[r]=NEG;}
  } else if(64*t>qw-154){
    const __attribute__((address_space(3))) float*tb=tab+(64*t+4*hi-(qw+r32)+191);
    #pragma unroll
    for(int g=0;g<4;++g){
      #pragma unroll
      for(int q=0;q<4;++q){const int r=4*g+q; p0[r]+=tb[(r&3)+8*(r>>2)];p1[r]+=tb[(r&3)+8*(r>>2)+32];}
      asm volatile("":"+v"(p0),"+v"(p1)); }
  }
}

constexpr int NSLOT=3, SLOTB=8192;
constexpr int LDS_K=0, LDS_V=NSLOT*SLOTB, LDS_WS=LDS_V+NSLOT*2*SLOTB, LDS_OST=LDS_WS+NW*64*4, LDS_BYTES=LDS_OST+NW*8192;
constexpr float C2=0.125f*1.4426950408889634f;
__device__ __forceinline__ void glds16(const void*gsrc,unsigned lds_dst){unsigned keep;
  asm volatile("s_mov_b32 %0, m0\n\ts_mov_b32 m0, %2\n\ts_nop 0\n\tglobal_load_lds_dwordx4 %1, off\n\ts_mov_b32 m0, %0":"=&s"(keep):"v"(gsrc),"s"(lds_dst):"memory");}
__device__ __forceinline__ float max3f(float a,float b,float c){float r;asm("v_max3_f32 %0, %1, %2, %3":"=v"(r):"v"(a),"v"(b),"v"(c));return r;}
__device__ __forceinline__ float max2f(float a,float b){float r;asm("v_max_f32_e32 %0, %1, %2":"=v"(r):"v"(a),"v"(b));return r;}
__device__ __forceinline__ float fadd_s(float a,float b){float r;asm("v_add_f32_e32 %0, %1, %2":"=v"(r):"v"(a),"v"(b));return r;}
__device__ __forceinline__ float fsub_s(float a,float b){float r;asm("v_sub_f32_e32 %0, %1, %2":"=v"(r):"v"(a),"v"(b));return r;}
typedef float f32x2_t __attribute__((ext_vector_type(2))); typedef __bf16 bf16x2_t __attribute__((ext_vector_type(2)));
__device__ __forceinline__ unsigned cvtpk_s(float lo,float hi){f32x2_t v={lo,hi};bf16x2_t b=__builtin_convertvector(v,bf16x2_t);return __builtin_bit_cast(unsigned,b);}
#define WAIT_BAR(N) asm volatile("s_waitcnt vmcnt(" #N ") lgkmcnt(0)\n\ts_barrier":::"memory")

__device__ __forceinline__ void qkt(f32x16&p0,f32x16&p1,const char*Kslot,const bf16x8*qr,int r32,int hi){
  const f32x16 negm={};
  const char*kb=Kslot+hi*1024+r32*16;
  #pragma unroll
  for(int d0=0;d0<4;++d0){
    const bf16x8 b0=*reinterpret_cast<const bf16x8*>(kb+d0*2048);
    const bf16x8 b1=*reinterpret_cast<const bf16x8*>(kb+d0*2048+512);
    if(d0==0){p0=__builtin_amdgcn_mfma_f32_32x32x16_bf16(b0,qr[0],negm,0,0,0);p1=__builtin_amdgcn_mfma_f32_32x32x16_bf16(b1,qr[0],negm,0,0,0);}
    else{p0=__builtin_amdgcn_mfma_f32_32x32x16_bf16(b0,qr[d0],p0,0,0,0);p1=__builtin_amdgcn_mfma_f32_32x32x16_bf16(b1,qr[d0],p1,0,0,0);}}
}
typedef __attribute__((address_space(3))) const char* lds_cptr;
typedef short v4i16_t __attribute__((ext_vector_type(4)));
__device__ __forceinline__ void kload8(bf16x8*kf,lds_cptr kp){
  kf[0]=*(const __attribute__((address_space(3))) bf16x8*)(kp);      kf[1]=*(const __attribute__((address_space(3))) bf16x8*)(kp+512);
  kf[2]=*(const __attribute__((address_space(3))) bf16x8*)(kp+2048); kf[3]=*(const __attribute__((address_space(3))) bf16x8*)(kp+2560);
  kf[4]=*(const __attribute__((address_space(3))) bf16x8*)(kp+4096); kf[5]=*(const __attribute__((address_space(3))) bf16x8*)(kp+4608);
  kf[6]=*(const __attribute__((address_space(3))) bf16x8*)(kp+6144); kf[7]=*(const __attribute__((address_space(3))) bf16x8*)(kp+6656);
}
__device__ __forceinline__ void kload2(bf16x8*kf,lds_cptr kp,int j){ kf[2*j]=*(const __attribute__((address_space(3))) bf16x8*)(kp+j*2048); kf[2*j+1]=*(const __attribute__((address_space(3))) bf16x8*)(kp+j*2048+512); }
__device__ __forceinline__ s16x4 vtr(lds_cptr p){ return __builtin_bit_cast(s16x4,__builtin_amdgcn_ds_read_tr16_b64_v4i16((__attribute__((address_space(3))) v4i16_t*)p)); }
__device__ __forceinline__ float rowmax(const f32x16&p0,const f32x16&p1){
  float a=max3f(p0[0],p0[1],p1[0]),b=max3f(p0[2],p0[3],p1[1]);a=max3f(a,p1[2],p1[3]);
  #pragma unroll
  for(int r=4;r<16;r+=4){a=max3f(a,p0[r],p0[r+1]);b=max3f(b,p0[r+2],p0[r+3]);a=max3f(a,p1[r],p1[r+1]);b=max3f(b,p1[r+2],p1[r+3]);}
  const float m=max2f(a,b);
  auto rr=__builtin_amdgcn_permlane32_swap(__float_as_uint(m),__float_as_uint(m),false,false);
  return max2f(__uint_as_float(rr[0]),__uint_as_float(rr[1]));
}
__device__ __forceinline__ void pv(f32x16*o,int vb,bf16x8 pa0,bf16x8 pa1,bf16x8 pa2,bf16x8 pa3){
  #pragma unroll
  for(int d0=0;d0<4;++d0){s16x4 lo[4],hi[4];
    #pragma unroll
    for(int ks=0;ks<4;++ks){
      asm volatile("ds_read_b64_tr_b16 %0,%1 offset:%c2":"=&v"(lo[ks]):"v"(vb),"i"(d0*4096+ks*1024):"memory");
      asm volatile("ds_read_b64_tr_b16 %0,%1 offset:%c2":"=&v"(hi[ks]):"v"(vb),"i"(d0*4096+ks*1024+512):"memory");}
    asm volatile("s_waitcnt lgkmcnt(0)":::"memory");SBAR();
    #define PK(k) (bf16x8){lo[k][0],lo[k][1],lo[k][2],lo[k][3],hi[k][0],hi[k][1],hi[k][2],hi[k][3]}
    o[d0]=__builtin_amdgcn_mfma_f32_32x32x16_bf16(pa0,PK(0),o[d0],0,0,0);
    o[d0]=__builtin_amdgcn_mfma_f32_32x32x16_bf16(pa1,PK(1),o[d0],0,0,0);
    o[d0]=__builtin_amdgcn_mfma_f32_32x32x16_bf16(pa2,PK(2),o[d0],0,0,0);
    o[d0]=__builtin_amdgcn_mfma_f32_32x32x16_bf16(pa3,PK(3),o[d0],0,0,0);
    #undef PK
  }
}

#ifndef ATTN_STORE16
#define ATTN_STORE16(p,v) (*(u32x4*)(p)=(v))
#endif
template<int THRL> __device__ __forceinline__ void attn_unit(int b,int qcol,int vcol,int ocol,int qb,const bf16*Q,const bf16*__restrict__ K,const bf16*__restrict__ V,bf16*O,char*shm,const __attribute__((address_space(3))) float*tab,const int tid){
  const int lane=tid&63,r32=lane&31,hi=lane>>5; const int wid=__builtin_amdgcn_readfirstlane(tid>>6);
  const long rowbase=(long)b*SEQ; const int q0=qb*QB;
  const bf16*Qw=Q+(rowbase+q0+wid*QBLK)*DM+qcol;
  const bf16*Kh=K+rowbase*DM+qcol,*Vh=V+rowbase*DM+vcol;
  const unsigned lds0=(unsigned)(uintptr_t)shm;
  float*wsf=(float*)(shm+LDS_WS)+wid*64;
  const bf16*ksrc=Kh+(long)lane*DM+wid*8;
  const bf16*vsrc=Vh+(long)(16*(wid&3)+(lane>>2))*DM+(wid>>2)*32+(lane&3)*8;
  const unsigned kdst=lds0+LDS_K+wid*1024, vdst=lds0+LDS_V+wid*1024;
  #define DMA_K(t,slot) glds16(ksrc+(long)(t)*KVBLK*DM,(unsigned)__builtin_amdgcn_readfirstlane(kdst+(slot)))
  #define DMA_V(t,slot) do{ glds16(vsrc+(long)(t)*KVBLK*DM,(unsigned)__builtin_amdgcn_readfirstlane(vdst+2*(slot))); glds16(vsrc+64+(long)(t)*KVBLK*DM,(unsigned)__builtin_amdgcn_readfirstlane(vdst+8192+2*(slot))); }while(0)
  const int vb0=(int)(lds0+LDS_V)+((lane>>4)&1)*32+(lane&3)*8+(4*hi+((lane&15)>>2))*64;
  const char*Kbase=shm+LDS_K; bf16x8 kf[8];
  const lds_cptr shm3=(lds_cptr)shm; const lds_cptr kp0=shm3+LDS_K+hi*1024+r32*16; const lds_cptr vp0=shm3+LDS_V+((lane>>4)&1)*32+(lane&3)*8+(4*hi+((lane&15)>>2))*64;
  const int NT=(q0+QB)/KVBLK;
  DMA_K(0,0);DMA_V(0,0);DMA_K(1,SLOTB);
  bf16x8 qr[4];
  #pragma unroll
  for(int d0=0;d0<4;++d0)qr[d0]=*reinterpret_cast<const bf16x8*>(&Qw[(long)r32*DM+d0*16+hi*8]);
  float mhat=0.f,l_reg=0.f;f32x16 o[4];
  const int qw=q0+wid*QBLK;
  #define CMASK(P0,P1,t) cmask(P0,P1,(t),NT,wid,qw,r32,hi,tab)
  bool resc=false;
  #define START(P0,P1) do{ const float rm=rowmax(P0,P1); resc=false; mhat=rm; \
      _Pragma("unroll") for(int r=0;r<16;++r){P0[r]=fsub_s(P0[r],rm);P1[r]=fsub_s(P1[r],rm);} \
    _Pragma("unroll") for(int r=0;r<16;++r)P0[r]=__builtin_amdgcn_exp2f(P0[r]); }while(0)
  #define RESC() do{ if(resc){ asm volatile("s_waitcnt lgkmcnt(0)":::"memory"); \
      _Pragma("unroll") for(int r=0;r<16;++r){ const float f_=wsf[crow(r,hi)]; o[0][r]*=f_; o[1][r]*=f_; o[2][r]*=f_; o[3][r]*=f_; } } }while(0)
  f32x16 pA0,pA1,pB0,pB1;
  int sl_prev=0,sl_cur=0,sl_next=SLOTB;
  #define ROT() do{sl_prev=sl_cur;sl_cur=sl_next;sl_next=(sl_next==(NSLOT-1)*SLOTB)?0:sl_next+SLOTB;}while(0)
  DMA_K(2,2*SLOTB);
  WAIT_BAR(4);
  qkt(pA0,pA1,Kbase,qr,r32,hi);asm volatile("s_nop 15\n\ts_nop 7":"+v"(pA0),"+v"(pA1));CMASK(pA0,pA1,0);
  START(pA0,pA1);
  _Pragma("unroll") for(int r=0;r<16;++r)pA1[r]=__builtin_amdgcn_exp2f(pA1[r]);
  WAIT_BAR(0);
  DMA_K(3,0);DMA_V(1,SLOTB);
  ROT();
  kload8(kf,kp0+sl_cur);
  WAIT_BAR(3);
  { float z_; asm volatile("v_mov_b32 %0, 0":"=v"(z_)); _Pragma("unroll") for(int r=0;r<16;++r){o[0][r]=z_;o[1][r]=z_;o[2][r]=z_;o[3][r]=z_;} }
  s16x4 vlo[8],vhi[8]; u32x4 pw0,pw1,pw2,pw3;
  #define PKW(P,B) cvtpk_s(P[B],P[B+1])
  #define PAF(k) __builtin_bit_cast(bf16x8,pw##k)
  #define VFR(i) (bf16x8){vlo[i][0],vlo[i][1],vlo[i][2],vlo[i][3],vhi[i][0],vhi[i][1],vhi[i][2],vhi[i][3]}
  #define PIN(x) asm volatile("":"+v"(x))
  #define MX3(a,b,c) __builtin_fmaxf(__builtin_fmaxf((a),(b)),(c))
  #define GAPA(MF,A0,A1,A2,A3,W0,W1,PW) do{ MF; sacc+=A0; sacc+=A1; sacc+=A2; sacc+=A3; PIN(sacc); W0; W1; PIN(PW); SBAR(); }while(0)
  #define EX(v) __builtin_amdgcn_exp2f(v)
  #define GAPB(MF,X,B) do{ MF; X[B]=EX(X[B]); X[B+1]=EX(X[B+1]); PIN(X); SBAR(); }while(0)
  #define VRD(s,f) do{ vlo[s]=vtr(vp_+(((f)>>2)*4096+((f)&3)*1024)); vhi[s]=vtr(vp_+(((f)>>2)*4096+((f)&3)*1024+512)); }while(0)
  #define KRD(G,j) do{ if(G){ kload2(kf,kp0+sl_next,j); SBAR(); } }while(0)
  #define ZC (f32x16){}
  #define STEP(C0,C1,P0,P1,t,GK,GV,GL) do{ SBAR(); \
    const lds_cptr vp_=vp0+2*sl_prev; \
    VRD(0,0); SBAR(); float sacc=(P0[0]+P0[1]); \
    GAPA(C0=__builtin_amdgcn_mfma_f32_32x32x16_bf16(kf[0],qr[0],ZC,0,0,0), P0[2],P0[3],P0[4],P0[5],     pw0[0]=PKW(P0,0), pw0[1]=PKW(P0,2), pw0); \
    VRD(1,4); SBAR(); GAPA(C1=__builtin_amdgcn_mfma_f32_32x32x16_bf16(kf[1],qr[0],ZC,0,0,0), P0[6],P0[7],P0[8],P0[9],     pw0[2]=PKW(P0,4), pw0[3]=PKW(P0,6), pw0); \
    VRD(2,1); SBAR(); GAPA(C0=__builtin_amdgcn_mfma_f32_32x32x16_bf16(kf[2],qr[1],C0,0,0,0),   P0[10],P0[11],P0[12],P0[13], pw1[0]=PKW(P0,8), pw1[1]=PKW(P0,10), pw1); \
    VRD(3,5); SBAR(); GAPA(C1=__builtin_amdgcn_mfma_f32_32x32x16_bf16(kf[3],qr[1],C1,0,0,0),   P0[14],P0[15],P1[0],P1[1],   pw1[2]=PKW(P0,12),pw1[3]=PKW(P0,14), pw1); \
    GAPA(C0=__builtin_amdgcn_mfma_f32_32x32x16_bf16(kf[4],qr[2],C0,0,0,0),   P1[2],P1[3],P1[4],P1[5],     pw2[0]=PKW(P1,0), pw2[1]=PKW(P1,2), pw2); \
    GAPA(C1=__builtin_amdgcn_mfma_f32_32x32x16_bf16(kf[5],qr[2],C1,0,0,0),   P1[6],P1[7],P1[8],P1[9],     pw2[2]=PKW(P1,4), pw2[3]=PKW(P1,6), pw2); \
    GAPA(C0=__builtin_amdgcn_mfma_f32_32x32x16_bf16(kf[6],qr[3],C0,0,0,0),   P1[10],P1[11],P1[12],P1[13], pw3[0]=PKW(P1,8), pw3[1]=PKW(P1,10), pw3); \
    GAPA(C1=__builtin_amdgcn_mfma_f32_32x32x16_bf16(kf[7],qr[3],C1,0,0,0),   P1[14],P1[15],0.f,0.f,       pw3[2]=PKW(P1,12),pw3[3]=PKW(P1,14), pw3); \
    l_reg+=sacc; \
    if(GK){DMA_K((t)+3,sl_cur);} if(GV){DMA_V((t)+1,sl_next);} \
    CMASK(C0,C1,t); \
    { float a=MX3(C0[0],C0[1],C1[0]),b_=MX3(C0[2],C0[3],C1[1]); a=MX3(a,C1[2],C1[3]); \
      _Pragma("unroll") for(int r=4;r<16;r+=4){a=MX3(a,C0[r],C0[r+1]);b_=MX3(b_,C0[r+2],C0[r+3]);a=MX3(a,C1[r],C1[r+1]);b_=MX3(b_,C1[r+2],C1[r+3]);} \
      float rm=__builtin_fmaxf(a,b_); { auto rr=__builtin_amdgcn_permlane32_swap(__float_as_uint(rm),__float_as_uint(rm),false,false); rm=__builtin_fmaxf(__uint_as_float(rr[0]),__uint_as_float(rr[1])); } \
      rm-=mhat; resc=false; \
      if(__builtin_expect(__any(rm>(float)THRL),0)){ const float dl=__builtin_fmaxf(rm,0.f); mhat+=dl; \
        const float f=__builtin_amdgcn_exp2f(-dl); l_reg*=f; if(hi==0)wsf[r32]=f; resc=true; } \
      _Pragma("unroll") for(int r=0;r<16;++r){C0[r]-=mhat;C1[r]-=mhat;} } \
    SBAR(); \
    GAPB(o[0]=__builtin_amdgcn_mfma_f32_32x32x16_bf16(PAF(0),VFR(0),o[0],0,0,0), C0,0);  VRD(4,2); SBAR(); \
    GAPB(o[1]=__builtin_amdgcn_mfma_f32_32x32x16_bf16(PAF(0),VFR(1),o[1],0,0,0), C0,2);  VRD(5,6); SBAR(); \
    KRD(GL,0); GAPB(o[0]=__builtin_amdgcn_mfma_f32_32x32x16_bf16(PAF(1),VFR(2),o[0],0,0,0), C0,4);  VRD(6,3); SBAR(); \
    KRD(GL,1); GAPB(o[1]=__builtin_amdgcn_mfma_f32_32x32x16_bf16(PAF(1),VFR(3),o[1],0,0,0), C0,6);  VRD(7,7); SBAR(); \
    KRD(GL,2); GAPB(o[0]=__builtin_amdgcn_mfma_f32_32x32x16_bf16(PAF(2),VFR(4),o[0],0,0,0), C0,8);  VRD(0,8); SBAR(); \
    KRD(GL,3); GAPB(o[1]=__builtin_amdgcn_mfma_f32_32x32x16_bf16(PAF(2),VFR(5),o[1],0,0,0), C0,10); VRD(1,12); SBAR(); \
    GAPB(o[0]=__builtin_amdgcn_mfma_f32_32x32x16_bf16(PAF(3),VFR(6),o[0],0,0,0), C0,12); VRD(2,9); SBAR(); \
    GAPB(o[1]=__builtin_amdgcn_mfma_f32_32x32x16_bf16(PAF(3),VFR(7),o[1],0,0,0), C0,14); VRD(3,13); SBAR(); \
    GAPB(o[2]=__builtin_amdgcn_mfma_f32_32x32x16_bf16(PAF(0),VFR(0),o[2],0,0,0), C1,0);  VRD(4,10); SBAR(); \
    GAPB(o[3]=__builtin_amdgcn_mfma_f32_32x32x16_bf16(PAF(0),VFR(1),o[3],0,0,0), C1,2);  VRD(5,14); SBAR(); \
    GAPB(o[2]=__builtin_amdgcn_mfma_f32_32x32x16_bf16(PAF(1),VFR(2),o[2],0,0,0), C1,4);  VRD(6,11); SBAR(); \
    GAPB(o[3]=__builtin_amdgcn_mfma_f32_32x32x16_bf16(PAF(1),VFR(3),o[3],0,0,0), C1,6);  VRD(7,15); SBAR(); \
    GAPB(o[2]=__builtin_amdgcn_mfma_f32_32x32x16_bf16(PAF(2),VFR(4),o[2],0,0,0), C1,8); \
    GAPB(o[3]=__builtin_amdgcn_mfma_f32_32x32x16_bf16(PAF(2),VFR(5),o[3],0,0,0), C1,10); \
    GAPB(o[2]=__builtin_amdgcn_mfma_f32_32x32x16_bf16(PAF(3),VFR(6),o[2],0,0,0), C1,12); \
    GAPB(o[3]=__builtin_amdgcn_mfma_f32_32x32x16_bf16(PAF(3),VFR(7),o[3],0,0,0), C1,14); \
    }while(0)
  int t=1;
  #undef CMASK
  #define CMASK(P0,P1,t) do{}while(0)
  for(;t+7<NT;t+=2){
    STEP(pB0,pB1,pA0,pA1,t,true,true,true);     WAIT_BAR(3); RESC(); ROT();
    STEP(pA0,pA1,pB0,pB1,t+1,true,true,true);   WAIT_BAR(3); RESC(); ROT();
  }
  #undef CMASK
  #define CMASK(P0,P1,t) cmask(P0,P1,(t),NT,wid,qw,r32,hi,tab)
  #define ENDW(tt) do{ if((tt)+3<NT){WAIT_BAR(3);} else if((tt)+2<NT){WAIT_BAR(2);} else {WAIT_BAR(0);} }while(0)
  for(;t+1<NT;t+=2){
    STEP(pB0,pB1,pA0,pA1,t,(t+3<NT),(t+1<NT),(t+1<NT));       ENDW(t);   RESC(); ROT();
    STEP(pA0,pA1,pB0,pB1,t+1,(t+4<NT),(t+2<NT),(t+2<NT));     ENDW(t+1); RESC(); ROT();
  }
  STEP(pB0,pB1,pA0,pA1,NT-1,false,false,false); RESC();
  { float sacc=pB0[0]+pB0[1]; _Pragma("unroll") for(int r=2;r<16;++r)sacc+=pB0[r]; _Pragma("unroll") for(int r=0;r<16;++r)sacc+=pB1[r]; l_reg+=sacc;
    pw0=(u32x4){PKW(pB0,0),PKW(pB0,2),PKW(pB0,4),PKW(pB0,6)};pw1=(u32x4){PKW(pB0,8),PKW(pB0,10),PKW(pB0,12),PKW(pB0,14)};pw2=(u32x4){PKW(pB1,0),PKW(pB1,2),PKW(pB1,4),PKW(pB1,6)};pw3=(u32x4){PKW(pB1,8),PKW(pB1,10),PKW(pB1,12),PKW(pB1,14)};
    SBAR(); pv(o,vb0+2*sl_cur,PAF(0),PAF(1),PAF(2),PAF(3)); }
  #undef PKW
  #undef PAF
  #undef VFR
  #undef PIN
  #undef MX3
  #undef GAPA
  #undef GAPB
  #undef EX
  #undef VRD
  #undef KRD
  #undef ZC
  #undef STEP
  #undef ENDW
  {auto rr=__builtin_amdgcn_permlane32_swap(__float_as_uint(l_reg),__float_as_uint(l_reg),false,false);l_reg=__uint_as_float(rr[0])+__uint_as_float(rr[1]);}
  if(hi==0)wsf[32+r32]=l_reg;asm volatile("s_waitcnt lgkmcnt(0)":::"memory");
  float rli[16];
  #pragma unroll
  for(int r=0;r<16;++r)rli[r]=__builtin_amdgcn_rcpf(wsf[32+crow(r,hi)]);
  bf16*Ow=O+(rowbase+q0+wid*QBLK)*OP+ocol;
  { bf16*stg=(bf16*)(shm+LDS_OST)+wid*4096;
    #pragma unroll
    for(int r=0;r<16;++r){const int orow=crow(r,hi);
      #pragma unroll
      for(int d0=0;d0<4;++d0)stg[orow*128+d0*32+r32]=__float2bfloat16(o[d0][r]*rli[r]);}
    asm volatile("s_waitcnt lgkmcnt(0)":::"memory");
    const bf16*sp=stg+(lane>>4)*128+(lane&15)*8; __attribute__((address_space(1))) bf16*gp=(__attribute__((address_space(1))) bf16*)(Ow+(long)(lane>>4)*OP+(lane&15)*8);
    #pragma unroll
    for(int i=0;i<8;++i){ const u32x4 v=*(const u32x4*)(sp+i*512); *(__attribute__((address_space(1))) u32x4*)gp=v; gp+=4*OP; asm volatile("":"+v"(gp)); } }
  asm volatile("s_waitcnt lgkmcnt(0)\n\ts_barrier":::"memory");
  #undef DMA_K
  #undef DMA_V
  #undef CMASK
  #undef START
  #undef RESC
  #undef ROT
}
constexpr int ATTN_LDS_BYTES=LDS_BYTES;
struct AttnTensors { const bf16* Q; const bf16* K; const bf16* V; bf16* O; };
template<int THRL=8> __device__ __forceinline__ void attn_phase(char*lds,const AttnTensors&T,int vcu,const float*rel_bias,const int tid){
  const int hc=vcu>>3,s=vcu&7,map=hc&1,h=(hc>>1)&7,b=hc>>4;
  __attribute__((address_space(3))) float*tab=(__attribute__((address_space(3))) float*)(lds+LDS_BYTES);
  { const float c15=rel_bias[15*8+h];
    for(int i=tid;i<256;i+=512){ const int rel=i-191; const int n=rel<0?-rel:rel;
      int bk=n<8?n:n<12?8:n<16?9:n<23?10:n<32?11:n<46?12:n<64?13:n<91?14:15; if(rel>0)bk+=16;
      tab[i]=(rel_bias[bk*8+h]-c15)*1.4426950408889634f; } }
  asm volatile("s_waitcnt lgkmcnt(0)\n\ts_barrier":::"memory");
  #pragma unroll 1
  for(int i=0;i<2;++i){ const int qb=(i==0)?s:15-s;
    attn_unit<THRL>(b,h*128+map*64,h*128,h*256+map*128,qb,T.Q,T.K,T.V,T.O,lds,tab,tid); }
}
#undef SBAR
#undef WAIT_BAR
}

constexpr int BATCH = 2, SEQ = 4096, T = BATCH * SEQ, D = 2048;
constexpr int NPROJ = 7184, NPROJ_PAD = 7424, SEGW = 1024;
constexpr int NH = 8, CH = 64, NCH = SEQ / CH;
constexpr int NEXP = 32, FE = 512;
constexpr float EPS = 1e-6f, LOG2E = 1.4426950408889634f;
constexpr float QSCALE = 0.125f * LOG2E;
static_assert(T == pg8::kT, "token count");

constexpr size_t MiB = 1u << 20;
constexpr size_t WS_CTL = 0, CTL_ZERO_BYTES = 1 * MiB;
constexpr size_t WS_WIN = 1 * MiB, WS_WOUT = 30 * MiB, WS_WGU = 38 * MiB, WS_WD = 166 * MiB;
constexpr size_t WS_XN = 230 * MiB, WS_SEG = 262 * MiB, WS_GATES = 374 * MiB, WS_OA = 375 * MiB, WS_QC = 407 * MiB, WS_KC = 423 * MiB, WS_CLOC = 439 * MiB, WS_MISC = 503 * MiB, WS_END = 505 * MiB;
constexpr size_t SEG_BYTES = (size_t)T * SEGW * 2;
constexpr size_t WS_QD = WS_SEG, WS_KD = WS_SEG + SEG_BYTES, WS_VD = WS_SEG + 2 * SEG_BYTES, WS_QM = WS_SEG + 3 * SEG_BYTES, WS_KM = WS_SEG + 4 * SEG_BYTES, WS_VM = WS_SEG + 5 * SEG_BYTES, WS_OM = WS_SEG + 6 * SEG_BYTES;
constexpr size_t WS_BCUM = WS_MISC, WS_NLOC = WS_MISC + 256 * 1024, WS_G = WS_MISC + MiB, WS_MLOC = WS_G + 4096, WS_MPREV = WS_G + 8192;
constexpr size_t WS_A2 = WS_XN, WS_X1 = 262 * MiB, WS_H2 = 326 * MiB, WS_LIST = 358 * MiB, WS_LISTW = 359 * MiB, WS_ROWTOK = 360 * MiB, WS_ROWW = 360 * MiB + 512 * 1024, WS_TAB = 361 * MiB;
constexpr size_t WS_HS = 375 * MiB, WS_HID = 471 * MiB, WS_Y0 = 230 * MiB, WS_Y1 = 326 * MiB;
constexpr int LDP = 2112;
constexpr size_t WS_XNP = WS_CLOC;
constexpr int MAXROWS = 24576;
constexpr int CW_CNT = 32768;

struct Params {
    const float *x, *rel_bias, *ln_mix_g, *w_in, *conv_w, *conv_b, *b_i, *b_f, *lam_q1, *lam_k1, *lam_q2, *lam_k2, *diff_norm_g, *mlstm_norm_g, *w_out, *ln_ffn_g,
                *w_group, *b_group, *w_router, *b_router, *w_gate, *w_up, *w_down, *ln_f_g;
    float* out; unsigned char* ws;
    int ph_lo, ph_hi, li, pad;
};

__device__ __forceinline__ float bf2f(unsigned short v) { return __uint_as_float((unsigned)v << 16); }
__device__ __forceinline__ float wave_sum(float v) {
#pragma unroll
    for (int o = 1; o < 64; o <<= 1) v += __shfl_xor(v, o);
    return v;
}
__device__ __forceinline__ float wave_max(float v) {
#pragma unroll
    for (int o = 1; o < 64; o <<= 1) v = fmaxf(v, __shfl_xor(v, o));
    return v;
}
__device__ __forceinline__ int t5_bucket(int rel) {
    const int n = rel < 0 ? -rel : rel;
    int b = n < 8 ? n : n < 12 ? 8 : n < 16 ? 9 : n < 23 ? 10 : n < 32 ? 11 : n < 46 ? 12 : n < 64 ? 13 : n < 91 ? 14 : 15;
    return b + (rel > 0 ? 16 : 0);
}

__device__ __forceinline__ unsigned cvtpk_rne(float lo, float hi) { typedef float f2_t __attribute__((ext_vector_type(2))); typedef __bf16 b2_t __attribute__((ext_vector_type(2))); f2_t v = {lo, hi}; b2_t b = __builtin_convertvector(v, b2_t); return __builtin_bit_cast(unsigned, b); }
__device__ __forceinline__ void conv_block64(const float* src, size_t ld, bf16* dst, size_t kd, int lane, int nvalid, float sc, LAS unsigned char* scr  ) {
    if (lane < nvalid) {
        const GAS float* s = (const GAS float*)src + lane; float v[64];
#pragma unroll
        for (int i = 0; i < 64; ++i) v[i] = s[(size_t)i * ld];
        LAS v4u* w = (LAS v4u*)(scr + lane * 144);
#pragma unroll
        for (int g = 0; g < 8; ++g) { v4u o; o.x = cvtpk_rne(v[8 * g] * sc, v[8 * g + 1] * sc); o.y = cvtpk_rne(v[8 * g + 2] * sc, v[8 * g + 3] * sc); o.z = cvtpk_rne(v[8 * g + 4] * sc, v[8 * g + 5] * sc); o.w = cvtpk_rne(v[8 * g + 6] * sc, v[8 * g + 7] * sc); w[g] = o; }
    }
    LDS_WAIT(); asm volatile("" ::: "memory");
    const int c = lane & 7;
#pragma unroll
    for (int j = 0; j < 8; ++j) { const int n = (lane >> 3) + 8 * j; if (n < nvalid) { const v4u o = *(const LAS v4u*)(scr + n * 144 + c * 16); *(GAS v4u*)(dst + (size_t)n * kd + 8 * c) = o; } }
    LDS_WAIT(); asm volatile("" ::: "memory");
}
__device__ __forceinline__ void rms_row_to_bf16(const float* xrow, const float* g, bf16* orow, int lane) {
    const GAS f32x4* xr = (const GAS f32x4*)xrow + lane; const GAS f32x4* gr = (const GAS f32x4*)g + lane;
    f32x4 v[8]; float s = 0.f;
#pragma unroll
    for (int j = 0; j < 8; ++j) { v[j] = xr[64 * j]; s += (v[j].x * v[j].x + v[j].y * v[j].y) + (v[j].z * v[j].z + v[j].w * v[j].w); }
    const float rstd = rsqrtf(wave_sum(s) * (1.f / D) + EPS);
    GAS unsigned long long* o8 = (GAS unsigned long long*)orow + lane;
#pragma unroll
    for (int j = 0; j < 8; ++j) { const f32x4 gv = gr[64 * j];
        o8[64 * j] = (unsigned long long)pk2(v[j].x * rstd * gv.x, v[j].y * rstd * gv.y) | ((unsigned long long)pk2(v[j].z * rstd * gv.z, v[j].w * rstd * gv.w) << 32); }
}
__device__ __forceinline__ void prologue_body(const Params& p, int gw, int NGW, int lane, LAS unsigned char* scr) {
    bf16* Win = (bf16*)(p.ws + WS_WIN); bf16* XN = (bf16*)(p.ws + WS_XNP);
    constexpr int I_IN = 32 * 112, I_ING = 32;
    for (int it = gw; it < I_IN + I_ING; it += NGW) {
        if (it < I_IN) { const int kb = it / 112, nb = it % 112; conv_block64(p.w_in + (size_t)(64 * kb) * NPROJ + 64 * nb, NPROJ, Win + (size_t)(64 * nb) * LDP + 64 * kb, LDP, lane, 64, nb < 16 ? QSCALE : 1.f, scr); }
        else { const int kb = it - I_IN; conv_block64(p.w_in + (size_t)(64 * kb) * NPROJ + 7168, NPROJ, Win + (size_t)7168 * LDP + 64 * kb, LDP, lane, 16, 1.f, scr); }
    }
    for (int m = gw; m < T; m += NGW) rms_row_to_bf16(p.x + (size_t)m * D, p.ln_mix_g, XN + (size_t)m * LDP, lane);
}
constexpr int CW_Q = 40960;
struct CvItem { const float* src; unsigned char* dst; int ld, kd; float sc; int k0; };
__device__ __forceinline__ CvItem cv_decode(const Params& p, int r) {
    constexpr int I_OUT = 32 * 32, I_G = NEXP * 32 * 8;
    CvItem it;
    if (r < I_OUT) { const int kb = r >> 5, nb = r & 31; it.src = p.w_out + (size_t)(64 * kb) * D + 64 * nb; it.ld = D; it.dst = p.ws + WS_WOUT + ((size_t)(64 * nb) * D + 64 * kb) * 2; it.kd = D * 2; it.sc = 0.f; it.k0 = 0; return it; } r -= I_OUT;
    if (r < 2 * I_G) { const int up = (r >= I_G) ? 1 : 0; if (up) r -= I_G; const int e = r >> 8, qq = r & 255, kb = qq >> 3, nb = qq & 7;
        it.src = (up ? p.w_up : p.w_gate) + (size_t)e * D * FE + (size_t)(64 * kb) * FE + 64 * nb; it.ld = FE;
        const int f0 = 64 * nb, rowb = e * 1024 + (f0 >> 7) * 256 + up * 128 + (f0 & 127);
        it.dst = p.ws + WS_WGU + (size_t)rowb * D + 64 * kb; it.kd = D; it.sc = 32.f; it.k0 = 64 * kb; return it; } r -= 2 * I_G;
    { const int e = r >> 8, qq = r & 255, kb = qq >> 5, nb = qq & 31;
      it.src = p.w_down + (size_t)e * FE * D + (size_t)(64 * kb) * D + 64 * nb; it.ld = D; it.dst = p.ws + WS_WD + ((size_t)e * 2048 + 64 * nb) * FE + 64 * kb; it.kd = FE; it.sc = 16.f; it.k0 = -1; return it; }
}
__device__ __forceinline__ void cv_load(const CvItem& it, int lane, float (&v)[64]) {
    const GAS float* s = (const GAS float*)it.src + lane;
#pragma unroll
    for (int i = 0; i < 64; ++i) v[i] = __builtin_nontemporal_load(s + (size_t)i * it.ld);
}
__device__ __forceinline__ void cv_finish(const Params& p, const CvItem& it, int lane, const float (&v)[64], LAS unsigned char* scr) {
    if (it.sc == 0.f) {
        LAS v4u* w = (LAS v4u*)(scr + lane * 144);
#pragma unroll
        for (int g = 0; g < 8; ++g) { v4u o; o.x = cvtpk_rne(v[8 * g], v[8 * g + 1]); o.y = cvtpk_rne(v[8 * g + 2], v[8 * g + 3]); o.z = cvtpk_rne(v[8 * g + 4], v[8 * g + 5]); o.w = cvtpk_rne(v[8 * g + 6], v[8 * g + 7]); w[g] = o; }
        LDS_WAIT(); asm volatile("" ::: "memory");
        const int c = lane & 7;
#pragma unroll
        for (int j = 0; j < 8; ++j) { const int n = (lane >> 3) + 8 * j; const v4u o = *(const LAS v4u*)(scr + n * 144 + c * 16); __builtin_nontemporal_store(o, (GAS v4u*)(it.dst + (size_t)n * it.kd + 16 * c)); }
    } else {
        LAS v4u* w = (LAS v4u*)(scr + lane * 80); const float sc = it.sc; const bool hasg = it.k0 >= 0; const float* gk = p.ln_ffn_g + (hasg ? it.k0 : 0);
#pragma unroll
        for (int g = 0; g < 4; ++g) { v4u o; unsigned tt[4];
#pragma unroll
            for (int q = 0; q < 4; ++q) { const int i0 = 16 * g + 4 * q; int t_ = 0;
                const float g0 = hasg ? gk[i0] : 1.f, g1 = hasg ? gk[i0 + 1] : 1.f, g2 = hasg ? gk[i0 + 2] : 1.f, g3 = hasg ? gk[i0 + 3] : 1.f;
                t_ = __builtin_amdgcn_cvt_pk_fp8_f32(v[i0] * (sc * g0), v[i0 + 1] * (sc * g1), t_, false); t_ = __builtin_amdgcn_cvt_pk_fp8_f32(v[i0 + 2] * (sc * g2), v[i0 + 3] * (sc * g3), t_, true); tt[q] = (unsigned)t_; }
            o.x = tt[0]; o.y = tt[1]; o.z = tt[2]; o.w = tt[3]; w[g] = o; }
        LDS_WAIT(); asm volatile("" ::: "memory");
        const int c = lane & 3;
#pragma unroll
        for (int j = 0; j < 4; ++j) { const int n = (lane >> 2) + 16 * j; const v4u o = *(const LAS v4u*)(scr + n * 80 + c * 16); __builtin_nontemporal_store(o, (GAS v4u*)(it.dst + (size_t)n * it.kd + 16 * c)); }
    }
    LDS_WAIT(); asm volatile("" ::: "memory");
}
constexpr int CVB = 4;
__device__ __forceinline__ void cv_load2(const CvItem& ia, const CvItem& ib, int lane, float (&va)[64], float (&vb)[64]) {
    const GAS float* sa = (const GAS float*)ia.src + lane; const GAS float* sb = (const GAS float*)ib.src + lane;
#pragma unroll
    for (int i = 0; i < 64; ++i) { va[i] = __builtin_nontemporal_load(sa + (size_t)i * ia.ld); vb[i] = __builtin_nontemporal_load(sb + (size_t)i * ib.ld); }
}
__device__ __forceinline__ void convert_queue(const Params& p, int lane, LAS unsigned char* scr) {
    unsigned* q = (unsigned*)(p.ws + WS_CTL) + CW_Q;
    constexpr int NITEMS = 32 * 32 + 2 * NEXP * 32 * 8 + NEXP * 8 * 32, PERQ = NITEMS / 8;
    static_assert(NITEMS % 16 == 0, "whole pairs per queue");
    int xq = blockIdx.x & 7;
    for (int tries = 0; tries < 8;) {
        int r0 = 0; if (lane == 0) r0 = (int)__hip_atomic_fetch_add(q + 64 * xq, 2u, RLX_AGENT);
        r0 = __builtin_amdgcn_readfirstlane(r0);
        if (r0 >= PERQ) { xq = (xq + 1) & 7; ++tries; continue; }
        r0 += PERQ * xq;
        float va[64], vb[64];
        const CvItem ia = cv_decode(p, r0), ib = cv_decode(p, r0 + 1);
        cv_load2(ia, ib, lane, va, vb);
        cv_finish(p, ia, lane, va, scr);
        cv_finish(p, ib, lane, vb, scr);
    }
}
#define ATTN_IN_MEGA 1

constexpr int LDS_BYTES = 147456;
constexpr int LDSCTL_OFF = 146432;
#ifndef G1W
#define G1W 180
#endif
constexpr int GEMM1_WGS = G1W;
constexpr int CW_HC = 49152, CW_TMO = 2048;
constexpr int CW_BAR = 4096;

namespace mls {
typedef short bf16x8 __attribute__((ext_vector_type(8)));
typedef float f32x16 __attribute__((ext_vector_type(16)));
typedef float f32x2_t __attribute__((ext_vector_type(2))); typedef __bf16 bf16x2_t __attribute__((ext_vector_type(2)));
__device__ __forceinline__ unsigned cvtpk(float lo, float hi) { f32x2_t v = {lo, hi}; bf16x2_t b = __builtin_convertvector(v, bf16x2_t); return __builtin_bit_cast(unsigned, b); }
__device__ __forceinline__ int crow(int r, int hi) { return (r & 3) + 8 * (r >> 2) + 4 * hi; }
__device__ __forceinline__ bf16x8 pack8(float a0, float a1, float a2, float a3, float a4, float a5, float a6, float a7) {
    v4u w; w.x = cvtpk(a0, a1); w.y = cvtpk(a2, a3); w.z = cvtpk(a4, a5); w.w = cvtpk(a6, a7); return __builtin_bit_cast(bf16x8, w); }
#define MLS_MFMA(a, b, c) __builtin_amdgcn_mfma_f32_32x32x16_bf16((a), (b), (c), 0, 0, 0)
}
constexpr int MO_HT = 132;
constexpr int MO_UNIT_LDS = 64 * MO_HT * 4 + 4 * 1024;
__device__ __forceinline__ void ph_mlstm_out(const Params& p, LAS unsigned char* lds, int tid) {
    using namespace mls;
    const int lane = tid & 63, wid = __builtin_amdgcn_readfirstlane(tid >> 6), half = wid >> 2, lw = wid & 3, ltid = tid & 255, r32 = lane & 31, hi = lane >> 5, tb = lw & 1, dp = lw >> 1;
    LAS float* Ht = (LAS float*)(lds + half * MO_UNIT_LDS);
    LAS float* wsc = (LAS float*)(lds + half * MO_UNIT_LDS + 64 * MO_HT * 4) + lw * 256;
    const float* GATES = (const float*)(p.ws + WS_GATES); const bf16* VM = (const bf16*)(p.ws + WS_VM); const bf16* KC = (const bf16*)(p.ws + WS_KC); const bf16* QC = (const bf16*)(p.ws + WS_QC); const bf16* OM = (const bf16*)(p.ws + WS_OM);
    const float* BCUM = (const float*)(p.ws + WS_BCUM); const float* MPREV = (const float*)(p.ws + WS_MPREV);
    bf16* A2 = (bf16*)(p.ws + WS_A2);
    const float lam = expf(wave_sum(p.lam_q1[lane] * p.lam_k1[lane])) - expf(wave_sum(p.lam_q2[lane] * p.lam_k2[lane])) + 0.2f;
    for (int base = 0; base < 1024; base += 2 * gridDim.x) {
        const int bx = base + half * gridDim.x + blockIdx.x;
        const int bh = bx >> 6, c = bx & 63, b = bh >> 3, h = bh & 7, hc = h * 128; const size_t row0 = (size_t)b * SEQ + c * 64;
        const bf16* CPREV = (const bf16*)(p.ws + WS_CLOC) + (size_t)bx * 16384; const float* NPREV = (const float*)(p.ws + WS_NLOC) + (size_t)bx * 128;
        const float mprev = MPREV[bx];
        const int ctt = ltid >> 2, cdg = ltid & 3;
        v4u co1[4], co2[4];
        { const bf16* oa = (const bf16*)(p.ws + WS_OA) + (row0 + ctt) * 2048 + h * 256 + 32 * cdg;
#pragma unroll
          for (int q = 0; q < 4; ++q) { co1[q] = *(const v4u*)(oa + 8 * q); co2[q] = *(const v4u*)(oa + 128 + 8 * q); } }
        { const float bl = BCUM[(size_t)bx * 64 + lane], al = GATES[(row0 + lane) * 16 + h] + p.b_i[h] - bl;
          float pm = al;
#pragma unroll
          for (int off = 1; off < 64; off <<= 1) { const float o = __shfl_up(pm, off); if (lane >= off) pm = fmaxf(pm, o); }
          wsc[lane] = al; wsc[64 + lane] = fmaxf(pm, mprev); wsc[128 + lane] = bl; }
        const int t = 32 * tb + r32;
        bf16x8 qf[8];
        { const bf16* qp = QC + (row0 + t) * 1024 + hc + 8 * hi;
#pragma unroll
          for (int k = 0; k < 8; ++k) qf[k] = *(const bf16x8*)(qp + 16 * k); }
        f32x16 X[2];
#pragma unroll
        for (int sb = 0; sb < 2; ++sb) {
#pragma unroll
            for (int i = 0; i < 16; ++i) X[sb][i] = 0.f;
            if (sb <= tb) { const bf16* kp = KC + (row0 + 32 * sb + r32) * 1024 + hc + 8 * hi;
                bf16x8 kf[8];
#pragma unroll
                for (int k = 0; k < 8; ++k) kf[k] = *(const bf16x8*)(kp + 16 * k);
#pragma unroll
                for (int k = 0; k < 8; ++k) X[sb] = MLS_MFMA(kf[k], qf[k], X[sb]); } }
        v4u vfr[2][2][2];
#pragma unroll
        for (int sb = 0; sb < 2; ++sb) if (sb <= tb) {
#pragma unroll
            for (int st = 0; st < 2; ++st)
#pragma unroll
                for (int dj = 0; dj < 2; ++dj) { const bf16* vp = VM + (row0 + 32 * sb + 16 * st + 4 * hi) * 1024 + hc + 64 * dp + 32 * dj + r32;
                    unsigned short v[8];
#pragma unroll
                    for (int j = 0; j < 8; ++j) v[j] = vp[(size_t)(8 * (j >> 2) + (j & 3)) * 1024];
                    vfr[sb][st][dj] = (v4u){v[0] | ((unsigned)v[1] << 16), v[2] | ((unsigned)v[3] << 16), v[4] | ((unsigned)v[5] << 16), v[6] | ((unsigned)v[7] << 16)}; } }
        else { vfr[sb][0][0] = vfr[sb][0][1] = vfr[sb][1][0] = vfr[sb][1][1] = (v4u){0u, 0u, 0u, 0u}; }
        f32x16 acc[2];
#pragma unroll
        for (int dj = 0; dj < 2; ++dj) {
#pragma unroll
            for (int i = 0; i < 16; ++i) acc[dj][i] = 0.f;
            const bf16* cp = CPREV + (64 * dp + 32 * dj + r32) * 128 + 8 * hi;
#pragma unroll
            for (int k = 0; k < 8; ++k) acc[dj] = MLS_MFMA(qf[k], *(const bf16x8*)(cp + 16 * k), acc[dj]); }
        float qn = 0.f;
        { const float* np = NPREV + 8 * hi;
#pragma unroll
          for (int k = 0; k < 8; ++k) { const f32x4 n0 = *(const f32x4*)(np + 16 * k), n1 = *(const f32x4*)(np + 16 * k + 4);
              qn += bf2f((unsigned short)qf[k][0]) * n0.x + bf2f((unsigned short)qf[k][1]) * n0.y + bf2f((unsigned short)qf[k][2]) * n0.z + bf2f((unsigned short)qf[k][3]) * n0.w
                  + bf2f((unsigned short)qf[k][4]) * n1.x + bf2f((unsigned short)qf[k][5]) * n1.y + bf2f((unsigned short)qf[k][6]) * n1.z + bf2f((unsigned short)qf[k][7]) * n1.w; } }
        qn += __shfl_xor(qn, 32);
        LDS_WAIT(); asm volatile("" ::: "memory");
        const float Mt = wsc[64 + t], bt = wsc[128 + t];
        float den1 = 0.f;
#pragma unroll
        for (int sb = 0; sb < 2; ++sb)
#pragma unroll
            for (int i = 0; i < 16; ++i) { const int s = 32 * sb + crow(i, hi); const float w = (s <= t) ? __expf(wsc[s] - Mt) : 0.f; X[sb][i] *= w; den1 += X[sb][i]; }
        den1 += __shfl_xor(den1, 32);
        const float inter_t = __expf(mprev - Mt);
        const float rd = 1.f / fmaxf(fabsf(den1 + inter_t * qn), __expf(-(bt + Mt)));
        if (hi == 0) wsc[192 + t] = rd;
#pragma unroll
        for (int i = 0; i < 16; ++i) { const float it_ = __expf(mprev - wsc[64 + 32 * tb + crow(i, hi)]); acc[0][i] *= it_; acc[1][i] *= it_; }
#pragma unroll
        for (int sb = 0; sb < 2; ++sb) if (sb <= tb) {
#pragma unroll
            for (int st = 0; st < 2; ++st) {
                const bf16x8 xa = pack8(X[sb][8 * st], X[sb][8 * st + 1], X[sb][8 * st + 2], X[sb][8 * st + 3], X[sb][8 * st + 4], X[sb][8 * st + 5], X[sb][8 * st + 6], X[sb][8 * st + 7]);
#pragma unroll
                for (int dj = 0; dj < 2; ++dj) acc[dj] = MLS_MFMA(xa, __builtin_bit_cast(bf16x8, vfr[sb][st][dj]), acc[dj]); } }
        LDS_WAIT(); asm volatile("" ::: "memory");
#pragma unroll
        for (int dj = 0; dj < 2; ++dj)
#pragma unroll
            for (int i = 0; i < 16; ++i) { const int tr = 32 * tb + crow(i, hi); Ht[tr * MO_HT + 64 * dp + 32 * dj + r32] = acc[dj][i] * wsc[192 + tr]; }
        __syncthreads();
        { const int tt = ltid >> 2, dg = ltid & 3; const LAS float* hp = Ht + tt * MO_HT + 32 * dg;
          f32x4 hv[8]; float ss = 0.f;
#pragma unroll
          for (int j = 0; j < 8; ++j) { hv[j] = *(const LAS f32x4*)(hp + 4 * j); ss += (hv[j].x * hv[j].x + hv[j].y * hv[j].y) + (hv[j].z * hv[j].z + hv[j].w * hv[j].w); }
          ss += __shfl_xor(ss, 1); ss += __shfl_xor(ss, 2);
          const float rstd = rsqrtf(ss * (1.f / 128.f) + EPS);
          const float* gp = p.mlstm_norm_g + hc + 32 * dg; const bf16* op_ = OM + (row0 + tt) * 1024 + hc + 32 * dg; bf16* dst = A2 + (row0 + tt) * 2048 + 1024 + hc + 32 * dg;
#pragma unroll
          for (int q = 0; q < 4; ++q) { const v4u o = *(const v4u*)(op_ + 8 * q); const f32x4 g0 = *(const f32x4*)(gp + 8 * q), g1 = *(const f32x4*)(gp + 8 * q + 4); const f32x4 a = hv[2 * q], bq = hv[2 * q + 1];
              const unsigned ow[4] = {o.x, o.y, o.z, o.w}; const float y[8] = {a.x * rstd * g0.x, a.y * rstd * g0.y, a.z * rstd * g0.z, a.w * rstd * g0.w, bq.x * rstd * g1.x, bq.y * rstd * g1.y, bq.z * rstd * g1.z, bq.w * rstd * g1.w};
              unsigned res[4];
#pragma unroll
              for (int j = 0; j < 4; ++j) { const float s0 = __uint_as_float(ow[j] << 16), s1 = __uint_as_float(ow[j] & 0xffff0000u); res[j] = pk2(y[2 * j] / (1.f + __expf(-s0)), y[2 * j + 1] / (1.f + __expf(-s1))); }
              *(v4u*)(dst + 8 * q) = (v4u){res[0], res[1], res[2], res[3]}; }
          float cv[32]; float css = 0.f;
#pragma unroll
          for (int q = 0; q < 4; ++q) { const unsigned w1[4] = {co1[q].x, co1[q].y, co1[q].z, co1[q].w}, w2[4] = {co2[q].x, co2[q].y, co2[q].z, co2[q].w};
#pragma unroll
              for (int j = 0; j < 4; ++j) { const float a0 = __uint_as_float(w1[j] << 16) - lam * __uint_as_float(w2[j] << 16), a1 = __uint_as_float(w1[j] & 0xffff0000u) - lam * __uint_as_float(w2[j] & 0xffff0000u);
                  cv[8 * q + 2 * j] = a0; cv[8 * q + 2 * j + 1] = a1; css += a0 * a0 + a1 * a1; } }
          css += __shfl_xor(css, 1); css += __shfl_xor(css, 2);
          const float crs = rsqrtf(css * (1.f / 128.f) + EPS) * 0.8f; const float* cg = p.diff_norm_g + hc + 32 * dg; bf16* cdst = A2 + (row0 + tt) * 2048 + hc + 32 * dg;
#pragma unroll
          for (int q = 0; q < 4; ++q) { const f32x4 g0 = *(const f32x4*)(cg + 8 * q), g1 = *(const f32x4*)(cg + 8 * q + 4);
              *(v4u*)(cdst + 8 * q) = (v4u){pk2(cv[8 * q] * crs * g0.x, cv[8 * q + 1] * crs * g0.y), pk2(cv[8 * q + 2] * crs * g0.z, cv[8 * q + 3] * crs * g0.w), pk2(cv[8 * q + 4] * crs * g1.x, cv[8 * q + 5] * crs * g1.y), pk2(cv[8 * q + 6] * crs * g1.z, cv[8 * q + 7] * crs * g1.w)}; } }
        __syncthreads();
    }
}
constexpr int ML_S = 144;
constexpr int ML_CS = 272;
__device__ __forceinline__ void ml_conv8r(const Params& p, const v4u (&rw)[4], int cwoff, float (&a)[8]) {
#pragma unroll
    for (int i = 0; i < 8; ++i) a[i] = p.conv_b[cwoff + i];
#pragma unroll
    for (int j = 0; j < 4; ++j) { const v4u w = rw[j]; const float* cw = p.conv_w + j * 2048 + cwoff;
        a[0] += cw[0] * __uint_as_float(w.x << 16); a[1] += cw[1] * __uint_as_float(w.x & 0xffff0000u); a[2] += cw[2] * __uint_as_float(w.y << 16); a[3] += cw[3] * __uint_as_float(w.y & 0xffff0000u);
        a[4] += cw[4] * __uint_as_float(w.z << 16); a[5] += cw[5] * __uint_as_float(w.z & 0xffff0000u); a[6] += cw[6] * __uint_as_float(w.w << 16); a[7] += cw[7] * __uint_as_float(w.w & 0xffff0000u); }
#pragma unroll
    for (int i = 0; i < 8; ++i) a[i] = a[i] / (1.f + __expf(-a[i]));
}
__device__ __forceinline__ int ml_sw(int r, int lg) { return r * ML_S + 16 * (lg ^ ((r >> 3) & 7)); }
struct MlRaw { v4u q[2][4], k[2][4], v[2]; float gf, gi; };
__device__ __forceinline__ void ml_load(const Params& p, int bx, int tid, MlRaw& R) {
    const int lane = tid & 63, eg = tid & 15, bh = bx >> 6, c = bx & 63, b = bh >> 3, h = bh & 7, ch = h * 128 + 8 * eg; const size_t row0 = (size_t)b * SEQ + c * 64;
    const float* GATES = (const float*)(p.ws + WS_GATES); const bf16* VM = (const bf16*)(p.ws + WS_VM); const bf16* KM = (const bf16*)(p.ws + WS_KM); const bf16* QM = (const bf16*)(p.ws + WS_QM);
    R.gf = GATES[(row0 + lane) * 16 + 8 + h]; R.gi = GATES[(row0 + lane) * 16 + h];
#pragma unroll
    for (int j = 0; j < 2; ++j) { const int l = (tid >> 4) + 32 * j, ts = c * 64 + l; const size_t row = row0 + l;
#pragma unroll
        for (int i = 0; i < 4; ++i) { const bool ok = ts - 3 + i >= 0; const v4u z = {0u, 0u, 0u, 0u};
            R.q[j][i] = ok ? *(const v4u*)(QM + (row - 3 + i) * 1024 + ch) : z; R.k[j][i] = ok ? *(const v4u*)(KM + (row - 3 + i) * 1024 + ch) : z; }
        R.v[j] = *(const v4u*)(VM + row * 1024 + ch); }
}
__device__ __forceinline__ void ph_mlstm_local(const Params& p, LAS unsigned char* lds, int tid) {
    using namespace mls;
    const int lane = tid & 63, wid = __builtin_amdgcn_readfirstlane(tid >> 6), r32 = lane & 31, hi = lane >> 5, we = wid & 3, wd = wid >> 2;
    LAS unsigned char* KwT = lds; LAS unsigned char* VT = lds + 128 * ML_S; LAS unsigned char* Ct = lds + 2 * 128 * ML_S;
    bf16* KC = (bf16*)(p.ws + WS_KC); bf16* QC = (bf16*)(p.ws + WS_QC);
    float* BCUM = (float*)(p.ws + WS_BCUM); float* Gc = (float*)(p.ws + WS_G); float* MLOC = (float*)(p.ws + WS_MLOC); bf16* CLOC = (bf16*)(p.ws + WS_CLOC); float* NLOC = (float*)(p.ws + WS_NLOC);
    const int eg = tid & 15;
    MlRaw R; if ((int)blockIdx.x < 1024) ml_load(p, blockIdx.x, tid, R);
    for (int bx = blockIdx.x; bx < 1024; bx += gridDim.x) {
        const int bh = bx >> 6, c = bx & 63, b = bh >> 3, h = bh & 7, hc = h * 128, ch = hc + 8 * eg; const size_t row0 = (size_t)b * SEQ + c * 64;
        float wt;
        { const float f = R.gf + p.b_f[h]; float bc = fminf(f, 0.f) - log1pf(__expf(-fabsf(f)));
#pragma unroll
          for (int off = 1; off < 64; off <<= 1) { const float o = __shfl_up(bc, off); if (lane >= off) bc += o; }
          const float g = __shfl(bc, 63), w = g - bc + R.gi + p.b_i[h]; const float mx = wave_max(w); wt = __expf(w - mx);
          if (wid == 0) { BCUM[(size_t)bx * 64 + lane] = bc; if (lane == 0) { Gc[bx] = g; MLOC[bx] = mx; } } }
#pragma unroll
        for (int j = 0; j < 2; ++j) { const int l = (tid >> 4) + 32 * j; const size_t row = row0 + l; const float wl = __shfl(wt, l);
            float a[8];
            ml_conv8r(p, R.q[j], ch, a);
            { v4u o; o.x = cvtpk(a[0], a[1]); o.y = cvtpk(a[2], a[3]); o.z = cvtpk(a[4], a[5]); o.w = cvtpk(a[6], a[7]); *(v4u*)(QC + row * 1024 + ch) = o; }
            ml_conv8r(p, R.k[j], 1024 + ch, a);
#pragma unroll
            for (int i = 0; i < 8; ++i) a[i] *= 0.08838834764831845f;
            { v4u o; o.x = cvtpk(a[0], a[1]); o.y = cvtpk(a[2], a[3]); o.z = cvtpk(a[4], a[5]); o.w = cvtpk(a[6], a[7]); *(v4u*)(KC + row * 1024 + ch) = o;
              const unsigned kk[4] = {o.x, o.y, o.z, o.w};
#pragma unroll
              for (int i = 0; i < 8; ++i) { const float kv = (i & 1) ? __uint_as_float(kk[i >> 1] & 0xffff0000u) : __uint_as_float(kk[i >> 1] << 16);
                  *(LAS unsigned short*)(KwT + ml_sw(8 * eg + i, l >> 3) + 2 * (l & 7)) = (unsigned short)(cvtpk(kv * wl, 0.f) & 0xffffu); } }
            { const v4u w = R.v[j]; const unsigned vv[4] = {w.x, w.y, w.z, w.w};
#pragma unroll
              for (int i = 0; i < 8; ++i) *(LAS unsigned short*)(VT + ml_sw(8 * eg + i, l >> 3) + 2 * (l & 7)) = (unsigned short)((i & 1) ? (vv[i >> 1] >> 16) : (vv[i >> 1] & 0xffffu)); }
        }
        __syncthreads();
        if (bx + (int)gridDim.x < 1024) ml_load(p, bx + gridDim.x, tid, R);
        f32x16 acc[2];
#pragma unroll
        for (int j = 0; j < 2; ++j)
#pragma unroll
            for (int i = 0; i < 16; ++i) acc[j][i] = 0.f;
#pragma unroll
        for (int ks = 0; ks < 4; ++ks) { const bf16x8 af = *(const LAS bf16x8*)(KwT + ml_sw(32 * we + r32, 2 * ks + hi));
#pragma unroll
            for (int j = 0; j < 2; ++j) { const bf16x8 bfr = *(const LAS bf16x8*)(VT + ml_sw(64 * wd + 32 * j + r32, 2 * ks + hi)); acc[j] = MLS_MFMA(af, bfr, acc[j]); } }
        if (tid < 128) { float n = 0.f;
#pragma unroll
            for (int q = 0; q < 8; ++q) { const v4u w = *(const LAS v4u*)(KwT + tid * ML_S + 16 * q);
                n += __uint_as_float(w.x << 16) + __uint_as_float(w.x & 0xffff0000u) + __uint_as_float(w.y << 16) + __uint_as_float(w.y & 0xffff0000u) + __uint_as_float(w.z << 16) + __uint_as_float(w.z & 0xffff0000u) + __uint_as_float(w.w << 16) + __uint_as_float(w.w & 0xffff0000u); }
            NLOC[(size_t)bx * 128 + tid] = n; }
#pragma unroll
        for (int j = 0; j < 2; ++j)
#pragma unroll
            for (int g = 0; g < 4; ++g) { const int d = 64 * wd + 32 * j + r32, e = 32 * we + 8 * g + 4 * hi;
                *(LAS unsigned long long*)(Ct + d * ML_CS + e * 2) = (unsigned long long)cvtpk(acc[j][4 * g], acc[j][4 * g + 1]) | ((unsigned long long)cvtpk(acc[j][4 * g + 2], acc[j][4 * g + 3]) << 32); }
        __syncthreads();
        { bf16* co = CLOC + (size_t)bx * 16384;
#pragma unroll
          for (int q = 0; q < 4; ++q) { const int pi = tid + 512 * q, d = pi >> 4, ck = pi & 15; *(v4u*)(co + d * 128 + 8 * ck) = *(const LAS v4u*)(Ct + d * ML_CS + 16 * ck); } }
        __syncthreads();
    }
}
__device__ __forceinline__ void ph_mlstm_scan(const Params& p, LAS unsigned char* lds, int tid) {
    LAS float* dec = (LAS float*)lds; LAS float* scl = dec + 64;
    const float* Gc = (const float*)(p.ws + WS_G); const float* MLOC = (const float*)(p.ws + WS_MLOC); float* MPREV = (float*)(p.ws + WS_MPREV);
    for (int blk = blockIdx.x; blk < 256; blk += gridDim.x) {
        const int bh = blk >> 4;
        __syncthreads();
        if (tid < 64) { const float gv = Gc[bh * 64 + tid], mlv = MLOC[bh * 64 + tid]; float m = 0.f, myd = 0.f, mys = 0.f, mym = 0.f;
#pragma unroll
            for (int c = 0; c < 64; ++c) { const float g = __shfl(gv, c), ml = __shfl(mlv, c); const float mn = fmaxf(g + m, ml);
                if (tid == c) { mym = m; myd = __expf(g + m - mn); mys = __expf(ml - mn); } m = mn; }
            dec[tid] = myd; scl[tid] = mys; if ((blk & 15) == 0) MPREV[bh * 64 + tid] = mym; }
        __syncthreads();
        { unsigned* base = (unsigned*)((bf16*)(p.ws + WS_CLOC) + (size_t)bh * 64 * 16384) + (blk & 15) * 512 + tid;
          float v0 = 0.f, v1 = 0.f;
#pragma unroll 1
          for (int c0 = 0; c0 < 64; c0 += 32) { unsigned w[32];
#pragma unroll
              for (int i = 0; i < 32; ++i) w[i] = base[(size_t)(c0 + i) * 8192];
#pragma unroll
              for (int i = 0; i < 32; ++i) { base[(size_t)(c0 + i) * 8192] = cvtpk_rne(v0, v1); const float d = dec[c0 + i], s = scl[c0 + i];
                  v0 = d * v0 + s * __uint_as_float(w[i] << 16); v1 = d * v1 + s * __uint_as_float(w[i] & 0xffff0000u); } } }
        if ((blk & 15) == 0 && tid < 128) { float* nb = (float*)(p.ws + WS_NLOC) + (size_t)bh * 64 * 128 + tid; float v = 0.f;
#pragma unroll 1
            for (int c0 = 0; c0 < 64; c0 += 16) { float w[16];
#pragma unroll
                for (int i = 0; i < 16; ++i) w[i] = nb[(c0 + i) * 128];
#pragma unroll
                for (int i = 0; i < 16; ++i) { nb[(c0 + i) * 128] = v; v = dec[c0 + i] * v + scl[c0 + i] * w[i]; } } }
    }
}
__device__ __forceinline__ void ph_diff_combine(const Params& p, int tid) {
    const int lane = tid & 63;
    const float lam = expf(wave_sum(p.lam_q1[lane] * p.lam_k1[lane])) - expf(wave_sum(p.lam_q2[lane] * p.lam_k2[lane])) + 0.2f;
    const bf16* OA = (const bf16*)(p.ws + WS_OA); bf16* A2 = (bf16*)(p.ws + WS_A2);
    for (int gw = blockIdx.x * 8 + (tid >> 6); gw < T * NH; gw += gridDim.x * 8) { const int row = gw >> 3, h = gw & 7;
        const unsigned w1 = *(const unsigned*)(OA + (size_t)row * 2048 + h * 256 + 2 * lane), w2 = *(const unsigned*)(OA + (size_t)row * 2048 + h * 256 + 128 + 2 * lane);
        const float v0 = __uint_as_float(w1 << 16) - lam * __uint_as_float(w2 << 16), v1 = __uint_as_float(w1 & 0xffff0000u) - lam * __uint_as_float(w2 & 0xffff0000u);
        const float rstd = rsqrtf(wave_sum(v0 * v0 + v1 * v1) * (1.f / 128.f) + EPS);
        *(unsigned*)(A2 + (size_t)row * 2048 + h * 128 + 2 * lane) = pk2(v0 * rstd * p.diff_norm_g[h * 128 + 2 * lane] * 0.8f, v1 * rstd * p.diff_norm_g[h * 128 + 2 * lane + 1] * 0.8f); }
}
constexpr size_t WS_WR = WS_MISC + MiB + 65536;
__device__ __forceinline__ void router_weights(const Params& p, int gtid, int nthreads) {
    bf16* WR = (bf16*)(p.ws + WS_WR);
    for (int idx = gtid; idx < 48 * 2048; idx += nthreads) { const int n = idx >> 11, k = idx & 2047;
        float v = 0.f; if (n < 4) v = p.w_group[k * 4 + n]; else if (n < 36) v = p.w_router[((size_t)((n - 4) >> 3) * D + k) * 8 + ((n - 4) & 7)];
        v *= p.ln_ffn_g[k]; const unsigned hi = f2bf(v); const float r = v - __uint_as_float(hi << 16);
        WR[idx] = (bf16)hi; WR[48 * 2048 + idx] = (bf16)f2bf(r); }
}
typedef float f32x4r __attribute__((ext_vector_type(4)));
__device__ __forceinline__ void ph_router(const Params& p, LAS unsigned char* lds, int tid) {
    using namespace mls;
    const int lane = tid & 63, wid = __builtin_amdgcn_readfirstlane(tid >> 6), fr = lane & 15, fq = lane >> 4;
    LAS float* part = (LAS float*)lds;
    LAS float* ssq = part + 8 * 32 * 48;
    LAS float* lg = ssq + 8 * 32;
    LAS float* rs = lg + 32 * 48;
    const bf16* X1 = (const bf16*)(p.ws + WS_X1); const bf16* WR = (const bf16*)(p.ws + WS_WR);
    for (int rb = blockIdx.x; rb < T / 32; rb += gridDim.x) {
        const int row0 = rb * 32, k0 = 256 * wid;
        f32x4r acc[2][3];
#pragma unroll
        for (int rg = 0; rg < 2; ++rg)
#pragma unroll
            for (int nt = 0; nt < 3; ++nt) acc[rg][nt] = (f32x4r){0.f, 0.f, 0.f, 0.f};
        float sq[2] = {0.f, 0.f}; bf16x8 xv[2][8];
#pragma unroll
        for (int rg = 0; rg < 2; ++rg) { const bf16* xp = X1 + (size_t)(row0 + 16 * rg + fr) * D + k0 + 8 * fq;
#pragma unroll
            for (int ks = 0; ks < 8; ++ks) xv[rg][ks] = *(const bf16x8*)(xp + 32 * ks); }
#pragma unroll
        for (int ks = 0; ks < 8; ++ks) {
            bf16x8 bh[3];
#pragma unroll
            for (int nt = 0; nt < 3; ++nt) bh[nt] = *(const bf16x8*)(WR + (size_t)(16 * nt + fr) * D + k0 + 32 * ks + 8 * fq);
#pragma unroll
            for (int rg = 0; rg < 2; ++rg) {
#pragma unroll
                for (int j = 0; j < 8; ++j) { const float xf = bf2f((unsigned short)xv[rg][ks][j]); sq[rg] += xf * xf; }
#pragma unroll
                for (int nt = 0; nt < 3; ++nt) acc[rg][nt] = __builtin_amdgcn_mfma_f32_16x16x32_bf16(xv[rg][ks], bh[nt], acc[rg][nt], 0, 0, 0); }
            if (ks & 1) asm volatile("" ::: "memory"); }
#pragma unroll
        for (int rg = 0; rg < 2; ++rg) { float s = sq[rg]; s += __shfl_xor(s, 16); s += __shfl_xor(s, 32); if (fq == 0) ssq[wid * 32 + 16 * rg + fr] = s;
#pragma unroll
            for (int nt = 0; nt < 3; ++nt)
#pragma unroll
                for (int i = 0; i < 4; ++i) part[(wid * 32 + 16 * rg + 4 * fq + i) * 48 + 16 * nt + fr] = acc[rg][nt][i]; }
        __syncthreads();
        if (tid < 32) { float s = 0.f;
#pragma unroll
            for (int w = 0; w < 8; ++w) s += ssq[w * 32 + tid];
            rs[tid] = rsqrtf(s * (1.f / D) + EPS); }
#pragma unroll
        for (int q = 0; q < 3; ++q) { const int o = tid + 512 * q; float s = 0.f;
#pragma unroll
            for (int w = 0; w < 8; ++w) s += part[w * 1536 + o];
            lg[o] = s; }
        __syncthreads();
#pragma unroll
        for (int rg = 0; rg < 2; ++rg) { const int r = 16 * rg + fr; const float rstd = rs[r]; unsigned char* hp = (unsigned char*)(p.ws + WS_H2) + (size_t)(row0 + r) * D + k0 + 8 * fq;
#pragma unroll
            for (int ks = 0; ks < 8; ++ks) { const v4u xw = __builtin_bit_cast(v4u, xv[rg][ks]);
                typedef unsigned u32x2r __attribute__((ext_vector_type(2)));
                *(u32x2r*)(hp + 32 * ks) = (u32x2r){pg8::pk4_fp8(__uint_as_float(xw.x << 16) * rstd, __uint_as_float(xw.x & 0xffff0000u) * rstd, __uint_as_float(xw.y << 16) * rstd, __uint_as_float(xw.y & 0xffff0000u) * rstd),
                                                   pg8::pk4_fp8(__uint_as_float(xw.z << 16) * rstd, __uint_as_float(xw.z & 0xffff0000u) * rstd, __uint_as_float(xw.w << 16) * rstd, __uint_as_float(xw.w & 0xffff0000u) * rstd)}; } }
        LAS int* se = (LAS int*)(rs + 32);
        LAS int* sbase = se + 64;
        if (tid < 32) { const int row = row0 + tid; const float rstd = rs[tid]; const LAS float* l = lg + tid * 48;
            float ag[4];
#pragma unroll
            for (int g = 0; g < 4; ++g) ag[g] = l[g] * rstd + p.b_group[g];
            int gs = 0; float gm = ag[0];
#pragma unroll
            for (int g = 1; g < 4; ++g) if (ag[g] > gm) { gm = ag[g]; gs = g; }
            float se_ = 0.f;
#pragma unroll
            for (int g = 0; g < 4; ++g) se_ += expf(ag[g] - gm);
            const float gw = 1.f / se_;
            float el[8];
#pragma unroll
            for (int e = 0; e < 8; ++e) el[e] = l[4 + gs * 8 + e] * rstd + p.b_router[gs * 8 + e];
            int i0 = 0; float v0 = el[0];
#pragma unroll
            for (int e = 1; e < 8; ++e) if (el[e] > v0) { v0 = el[e]; i0 = e; }
            int i1 = -1; float v1 = -INFINITY;
#pragma unroll
            for (int e = 0; e < 8; ++e) if (e != i0 && el[e] > v1) { v1 = el[e]; i1 = e; }
            const float w0 = 1.f / (1.f + expf(v1 - v0)), w1 = 1.f - w0;
            float* LISTW = (float*)(p.ws + WS_LISTW); LISTW[row * 2] = gw * w0; LISTW[row * 2 + 1] = gw * w1;
            se[2 * tid] = gs * 8 + i0; se[2 * tid + 1] = gs * 8 + i1;
            LDS_WAIT(); asm volatile("" ::: "memory");
            const int me = tid; int n = 0;
#pragma unroll 8
            for (int q = 0; q < 64; ++q) n += (se[q] == me) ? 1 : 0;
            unsigned base = 0; unsigned* cnt = (unsigned*)(p.ws + WS_CTL) + CW_CNT;
            if (n > 0) base = atomicAdd(cnt + me, (unsigned)n);
            int* LIST = (int*)(p.ws + WS_LIST); int* TOKEP = (int*)(p.ws + WS_ROWTOK);
            if (n > 0) { int k = 0;
#pragma unroll 8
                for (int q = 0; q < 64; ++q) if (se[q] == me) { const int ts = (row0 + (q >> 1)) * 2 + (q & 1); LIST[me * 8192 + (int)base + k] = ts; TOKEP[ts] = me * 8192 + (int)base + k; ++k; } }
            (void)sbase; }
        __syncthreads();
    }
}
__device__ __forceinline__ void ph_final(const Params& p, const LAS int* s_tb, int tid) {
    const int lane = tid & 63;
    for (int row = blockIdx.x * 8 + (tid >> 6); row < T; row += gridDim.x * 8) {
        const GAS unsigned long long* xr = (const GAS unsigned long long*)((const bf16*)(p.ws + WS_X1) + (size_t)row * D) + lane; const GAS f32x4* gr = (const GAS f32x4*)p.ln_f_g + lane;
        const int* TOKEP = (const int*)(p.ws + WS_ROWTOK); const int v0 = TOKEP[row * 2], v1 = TOKEP[row * 2 + 1];
        const float* TOKW = (const float*)(p.ws + WS_LISTW); const float cw0 = TOKW[row * 2] * (1.f / (pg8::H8 * pg8::W8_D)), cw1 = TOKW[row * 2 + 1] * (1.f / (pg8::H8 * pg8::W8_D));
        const size_t r0 = (size_t)s_tb[v0 >> 13] * 256 + (v0 & 8191), r1 = (size_t)s_tb[v1 >> 13] * 256 + (v1 & 8191);
        const GAS unsigned long long* y0 = (const GAS unsigned long long*)((const bf16*)(p.ws + WS_HS) + r0 * D) + lane; const GAS unsigned long long* y1 = (const GAS unsigned long long*)((const bf16*)(p.ws + WS_HS) + r1 * D) + lane;
        f32x4 v[8]; float s = 0.f;
#pragma unroll
        for (int j = 0; j < 8; ++j) { const unsigned long long xw = xr[64 * j]; v[j] = (f32x4){__uint_as_float((unsigned)xw << 16), __uint_as_float((unsigned)xw & 0xffff0000u), __uint_as_float((unsigned)(xw >> 32) << 16), __uint_as_float((unsigned)(xw >> 32) & 0xffff0000u)};
            const unsigned long long a = y0[64 * j], b = y1[64 * j];
            v[j].x += __uint_as_float((unsigned)a << 16) * cw0 + __uint_as_float((unsigned)b << 16) * cw1; v[j].y += __uint_as_float((unsigned)a & 0xffff0000u) * cw0 + __uint_as_float((unsigned)b & 0xffff0000u) * cw1;
            v[j].z += __uint_as_float((unsigned)(a >> 32) << 16) * cw0 + __uint_as_float((unsigned)(b >> 32) << 16) * cw1; v[j].w += __uint_as_float((unsigned)(a >> 32) & 0xffff0000u) * cw0 + __uint_as_float((unsigned)(b >> 32) & 0xffff0000u) * cw1;
            s += (v[j].x * v[j].x + v[j].y * v[j].y) + (v[j].z * v[j].z + v[j].w * v[j].w); }
        const float rstd = rsqrtf(wave_sum(s) * (1.f / D) + EPS);
        GAS f32x4* o = (GAS f32x4*)(p.out + (size_t)row * D) + lane;
#pragma unroll
        for (int j = 0; j < 8; ++j) { const f32x4 gv = gr[64 * j]; o[64 * j] = (f32x4){v[j].x * rstd * gv.x, v[j].y * rstd * gv.y, v[j].z * rstd * gv.z, v[j].w * rstd * gv.w}; }
    }
}

__device__ __forceinline__ void gate_gemm(const Params& p, int slab, int tid) {
    using namespace mls;
    const int lane = tid & 63, wid = tid >> 6, fr = lane & 15, fq = lane >> 4;
    const bf16* XN = (const bf16*)(p.ws + WS_XNP); const bf16* Wg = (const bf16*)(p.ws + WS_WIN) + (size_t)7168 * LDP; float* GATES = (float*)(p.ws + WS_GATES);
    const int row0 = slab * 256 + wid * 32;
    typedef float f32x4g __attribute__((ext_vector_type(4)));
    f32x4g acc[2] = {(f32x4g){0.f, 0.f, 0.f, 0.f}, (f32x4g){0.f, 0.f, 0.f, 0.f}};
    const bf16* a0 = XN + (size_t)(row0 + fr) * LDP + 8 * fq; const bf16* a1 = a0 + (size_t)16 * LDP; const bf16* bp = Wg + (size_t)fr * LDP + 8 * fq;
#pragma unroll 1
    for (int k0 = 0; k0 < D; k0 += 256) {
        bf16x8 af[2][8], bfv[8];
#pragma unroll
        for (int j = 0; j < 8; ++j) { af[0][j] = *(const bf16x8*)(a0 + k0 + 32 * j); af[1][j] = *(const bf16x8*)(a1 + k0 + 32 * j); bfv[j] = *(const bf16x8*)(bp + k0 + 32 * j); }
#pragma unroll
        for (int j = 0; j < 8; ++j) { acc[0] = __builtin_amdgcn_mfma_f32_16x16x32_bf16(af[0][j], bfv[j], acc[0], 0, 0, 0); acc[1] = __builtin_amdgcn_mfma_f32_16x16x32_bf16(af[1][j], bfv[j], acc[1], 0, 0, 0); }
    }
#pragma unroll
    for (int rg = 0; rg < 2; ++rg)
#pragma unroll
        for (int i = 0; i < 4; ++i) GATES[(size_t)(row0 + 16 * rg + 4 * fq + i) * 16 + fr] = acc[rg][i];
}
__device__ __forceinline__ int k_lane() { int l; asm volatile("v_mbcnt_lo_u32_b32 %0, -1, 0\n\tv_mbcnt_hi_u32_b32 %0, -1, %0" : "=v"(l)); return l; }
__global__ void __launch_bounds__(512, 2) mega_fwd(Params p) {
    extern __shared__ __attribute__((aligned(16))) unsigned char lds[];
    const int wave = __builtin_amdgcn_readfirstlane((int)threadIdx.x >> 6);
#define lane k_lane()
#define tid (wave * 64 + lane)
    LAS unsigned char* l3 = (LAS unsigned char*)lds;
    for (int u = tid; u < (LDS_BYTES - LDSCTL_OFF) / 4; u += 512) ((LAS unsigned*)(l3 + LDSCTL_OFF))[u] = 0u;
    __syncthreads();
    XcdBarrier bar = xcd_barrier_post((unsigned*)(p.ws + WS_CTL) + CW_BAR + p.li * XCD_BAR_WORDS, (volatile LAS unsigned*)(l3 + LDSCTL_OFF + 64), tid);
    const int lo = p.ph_lo, hi = p.ph_hi;
#define IN(k) (lo <= (k) && (k) < hi)
#define SEAM(k) do { if (IN(k) && IN((k) + 1)) xcd_barrier(bar, tid); } while (0)
#ifndef REP0
#define REP0 1
#endif
#ifndef REP1
#define REP1 1
#endif
#ifndef REP2
#define REP2 1
#endif
#ifndef REP3A
#define REP3A 1
#endif
#ifndef REP3B
#define REP3B 1
#endif
#ifndef REP5A
#define REP5A 1
#endif
#ifndef REP5B
#define REP5B 1
#endif
#ifndef REP6
#define REP6 1
#endif
#ifndef REP8
#define REP8 1
#endif
#ifndef REP9
#define REP9 1
#endif
#ifndef REP10
#define REP10 1
#endif
#ifndef REP11
#define REP11 1
#endif
#define PH(R, ...) do { __VA_ARGS__; if (R > 1) { __syncthreads(); __VA_ARGS__; } } while (0)
    if (IN(0)) { PH(REP0, prologue_body(p, blockIdx.x * 8 + wave, gridDim.x * 8, lane, l3 + wave * 9216)); router_weights(p, blockIdx.x * 512 + tid, gridDim.x * 512); }
    SEAM(0);
    if (IN(1)) { if (blockIdx.x < GEMM1_WGS) PH(REP1, { pg8::Gemm g{(const pg8::bf16_t*)(p.ws + WS_XNP), (const pg8::bf16_t*)(p.ws + WS_WIN), T, 7168, D, LDP};
      pg8::StaticOrder S; S.init(T, 7168, GEMM1_WGS, blockIdx.x);
      pg8::EpiInProj E{(pg8::bf16_t*)(p.ws + WS_SEG)};
      pg8::gemm_phase<pg8::EpiInProj, pg8::StaticOrder, true, true>(l3, g, S, E, tid); });
      else if ((int)blockIdx.x - GEMM1_WGS < 32) gate_gemm(p, (int)blockIdx.x - GEMM1_WGS, tid);
      convert_queue(p, lane, l3 + wave * 9216); }
    if (IN(1) && IN(3)) xcd_barrier(bar, tid);
    if (IN(3)) {
        PH(REP3A, { const attn_body::AttnTensors AT{(const attn_body::bf16*)(p.ws + WS_QD), (const attn_body::bf16*)(p.ws + WS_KD), (const attn_body::bf16*)(p.ws + WS_VD), (attn_body::bf16*)(p.ws + WS_OA)};
          const int G = gridDim.x, bx = blockIdx.x; attn_body::attn_phase<8>((char*)lds, AT, (bx % 8) * (G / 8) + bx / 8, p.rel_bias, tid); });
        PH(REP3B, ph_mlstm_local(p, l3, tid)); }
    SEAM(3);
    if (IN(4)) ph_mlstm_scan(p, l3, tid);
    SEAM(4);
    if (IN(5)) { PH(REP5A, ph_mlstm_out(p, l3, tid)); }
    SEAM(5);
    if (IN(6)) PH(REP6, { pg8::Gemm g{(const pg8::bf16_t*)(p.ws + WS_A2), (const pg8::bf16_t*)(p.ws + WS_WOUT), T, D, D, D};
      pg8::StaticOrder S; S.init(T, D, gridDim.x, blockIdx.x);
      pg8::EpiOutProj E{p.x, (pg8::bf16_t*)(p.ws + WS_X1)};
      pg8::gemm_phase<pg8::EpiOutProj, pg8::StaticOrder, true, true>(l3, g, S, E, tid); });
    SEAM(6);
    if (IN(7)) ph_router(p, l3, tid);
    if (IN(7) && IN(9)) xcd_barrier(bar, tid);
    if (IN(9)) {
        LAS int* s_tb = (LAS int*)(l3 + LDSCTL_OFF + 256); LAS int* s_cn = (LAS int*)(l3 + LDSCTL_OFF + 512);
        if (tid < 32) s_cn[tid] = (int)__hip_atomic_load((unsigned*)(p.ws + WS_CTL) + CW_CNT + tid, RLX_AGENT);
        __syncthreads();
        if (tid == 0) { int tb = 0; for (int e = 0; e < 32; ++e) { s_tb[e] = tb; tb += (s_cn[e] + 255) >> 8; } s_tb[32] = tb; }
        __syncthreads();
        PH(REP9, { pg8::Gemm g{(const pg8::bf16_t*)(p.ws + WS_H2), (const pg8::bf16_t*)(p.ws + WS_WGU), T, NEXP * 1024, D, D};
          static_assert(pg8::MoeSched::TB_ADDR == LDSCTL_OFF + 256 && pg8::MoeSched::CN_ADDR == LDSCTL_OFF + 512, "MoE tables");
          pg8::MoeSched S{(const int*)(p.ws + WS_LIST), (unsigned*)(p.ws + WS_CTL) + CW_HC, (int)gridDim.x, (int)((blockIdx.x & 7) * (gridDim.x >> 3) + (blockIdx.x >> 3))};
          pg8::EpiGU E{(unsigned char*)(p.ws + WS_HID), (const float*)(p.ws + WS_LISTW)};
          pg8::gemm_phase_g<pg8::EpiGU, pg8::MoeSched, true>(l3, g, S, E, tid); }); }
    if (IN(10)) PH(REP10, { pg8::Gemm g{(const pg8::bf16_t*)(p.ws + WS_HID), (const pg8::bf16_t*)(p.ws + WS_WD), MAXROWS, NEXP * 2048, FE, FE};
      pg8::MoeSchedD S{(const unsigned*)(p.ws + WS_CTL) + CW_HC, (unsigned*)(p.ws + WS_CTL) + CW_TMO, (int)gridDim.x, (int)((blockIdx.x & 7) * (gridDim.x >> 3) + (blockIdx.x >> 3))};
      pg8::EpiDown E{(pg8::bf16_t*)(p.ws + WS_HS)};
      pg8::gemm_phase_g<pg8::EpiDown, pg8::MoeSchedD, true>(l3, g, S, E, tid); });
    SEAM(10);
    if (IN(11)) PH(REP11, ph_final(p, (const LAS int*)(l3 + LDSCTL_OFF + 256), tid));
#undef PH
#undef IN
#undef SEAM
#undef lane
#undef tid
}

extern "C" void kernel_launch(void* const* d_in, const int* in_sizes, int n_in, void* d_out, int out_size, void* d_ws, size_t ws_size, hipStream_t stream) {
    static int grid = 0;
    if (grid == 0) {
        if (n_in != 24 || in_sizes[0] != T * D || out_size != T * D || ws_size < WS_END) { fprintf(stderr, "kernel_launch: unexpected shapes (n_in %d, in0 %d, out %d, ws %zu)\n", n_in, n_in > 0 ? in_sizes[0] : -1, out_size, ws_size); grid = -1; return; }
        int dev = 0, cus = 0, per_cu = 0;
        if (hipGetDevice(&dev) != hipSuccess || hipDeviceGetAttribute(&cus, hipDeviceAttributeMultiprocessorCount, dev) != hipSuccess) { grid = -1; return; }
        if (hipFuncSetAttribute((const void*)mega_fwd, hipFuncAttributeMaxDynamicSharedMemorySize, LDS_BYTES) != hipSuccess) { fprintf(stderr, "kernel_launch: hipFuncSetAttribute failed\n"); grid = -1; return; }
        if (hipOccupancyMaxActiveBlocksPerMultiprocessor(&per_cu, (const void*)mega_fwd, 512, LDS_BYTES) != hipSuccess || per_cu < 1) { fprintf(stderr, "kernel_launch: occupancy query reports %d workgroups per CU\n", per_cu); }
        (void)hipGetLastError();
        grid = 256;
        if (cus < 256) { fprintf(stderr, "kernel_launch: %d CUs < 256: the persistent grid would not be resident\n", cus); grid = -1; return; }
    }
    if (grid < 0) return;
    if (hipMemsetAsync((char*)d_ws + WS_CTL, 0, CTL_ZERO_BYTES, stream) != hipSuccess) return;
    Params p{};
    const float** pf = (const float**)&p;
    for (int i = 0; i < 24; ++i) pf[i] = (const float*)d_in[i];
    p.out = (float*)d_out; p.ws = (unsigned char*)d_ws;
    p.ph_lo = 0; p.ph_hi = 12; p.li = 0;
    hipLaunchKernelGGL(mega_fwd, dim3(grid), dim3(512), LDS_BYTES, stream, p);
}
```
